# Optimizing an MI355X kernel written in HIP

```python
import jax, jax.numpy as jnp
from jax import lax
import numpy as np

D_MODEL = 1024
BATCH = 8
SEQ = 4096
DEPTH = 1

GRID_W = 64
CTX_LEN = 256
EPS = 1e-6
ROPE_THETA = 10000.0
V_HEAD_DIM = 128
QK_NOPE_DIM = 128
QK_ROPE_DIM = 64
Q_LORA_RANK = 256
KV_LORA_RANK = 256
MLA_HEADS = D_MODEL // (2 * V_HEAD_DIM)
MLA_WIDTH = MLA_HEADS * V_HEAD_DIM
QK_HEAD_DIM = QK_NOPE_DIM + QK_ROPE_DIM
Q_BLOCK = 128
HGRN_KEY_DIM = 128
HGRN_VAL_DIM = 128
HGRN_HEADS = D_MODEL // (2 * HGRN_VAL_DIM)
HGRN_WIDTH = HGRN_HEADS * HGRN_KEY_DIM
CHUNK = 64
MIX_WIDTH = MLA_WIDTH + HGRN_HEADS * HGRN_VAL_DIM
IN_SIZES = (Q_LORA_RANK, KV_LORA_RANK, QK_ROPE_DIM,
            HGRN_WIDTH, HGRN_WIDTH, HGRN_WIDTH, HGRN_WIDTH, HGRN_WIDTH)
IN_COLS = sum(IN_SIZES)
D_FF = -(-8 * D_MODEL // (3 * 256)) * 256

kernel_name = "hymba_mla_hgrn2_dit_block"


def rmsnorm(x, g):
    x32 = x.astype(jnp.float32)
    y = x32 * lax.rsqrt(jnp.mean(x32 * x32, axis=-1, keepdims=True) + EPS)
    return (y * g.astype(jnp.float32)).astype(x.dtype)


def modulate(h, shift, scale):
    return h * (1.0 + scale) + shift


def axial_rope_2d(n):
    rows = n // GRID_W
    row = jnp.broadcast_to(jnp.arange(rows)[:, None], (rows, GRID_W)).reshape(n)
    col = jnp.broadcast_to(jnp.arange(GRID_W)[None, :], (rows, GRID_W)).reshape(n)
    axis_dim = QK_ROPE_DIM // 2
    inv = 1.0 / (ROPE_THETA ** (jnp.arange(0, axis_dim, 2, dtype=jnp.float32) / axis_dim))
    ang = jnp.concatenate([row.astype(jnp.float32)[:, None] * inv,
                           col.astype(jnp.float32)[:, None] * inv], axis=-1)
    return jnp.cos(ang), jnp.sin(ang)


def apply_rope(x, cos, sin):
    if x.ndim == 4:
        cos, sin = cos[:, None, :], sin[:, None, :]
    nf = QK_ROPE_DIM // 4
    x32 = x.astype(jnp.float32)
    outs = []
    for a in range(2):
        xa = x32[..., a * 2 * nf:(a + 1) * 2 * nf]
        c, s = cos[..., a * nf:(a + 1) * nf], sin[..., a * nf:(a + 1) * nf]
        x1, x2 = xa[..., :nf], xa[..., nf:]
        outs.append(jnp.concatenate([x1 * c - x2 * s, x2 * c + x1 * s], axis=-1))
    return jnp.concatenate(outs, axis=-1).astype(x.dtype)


def attend_blocks(q, k, v):
    B, N, H, dq = q.shape
    nb = N // Q_BLOCK
    scale = 1.0 / float(np.sqrt(dq))
    qb = jnp.moveaxis(q.reshape(B, nb, Q_BLOCK, H, dq), 1, 0)

    def one(qblk):
        s = jnp.einsum('bqhd,bkhd->bhqk', qblk, k).astype(jnp.float32) * scale
        p = jax.nn.softmax(s, axis=-1).astype(v.dtype)
        return jnp.einsum('bhqk,bkhd->bqhd', p, v)

    o = lax.map(one, qb)
    return jnp.moveaxis(o, 0, 1).reshape(B, N, H, v.shape[-1])


def gla_chunked(q, k, v, log_f, s0):
    B, T, H, dk = q.shape
    dv = v.shape[-1]
    nc = T // CHUNK

    def to_chunks(t):
        return jnp.moveaxis(t.reshape(B, nc, CHUNK, H, t.shape[-1]), 1, 0)

    mask = jnp.tril(jnp.ones((CHUNK, CHUNK), dtype=bool))

    def step(S, inp):
        qc, kc, vc, gc = inp
        b = jnp.cumsum(gc, axis=1)
        b_ref = b[:, CHUNK // 2 - 1][:, None]
        b_last = b[:, -1]
        o_inter = jnp.einsum('bchk,bhkv->bchv', qc * jnp.exp(b), S)
        A = jnp.einsum('bthk,bshk->bhts', qc * jnp.exp(b - b_ref), kc * jnp.exp(b_ref - b))
        A = jnp.where(mask, A, 0.0)
        o_intra = jnp.einsum('bhts,bshv->bthv', A, vc)
        S_new = jnp.exp(b_last)[..., None] * S + jnp.einsum(
            'bshk,bshv->bhkv', kc * jnp.exp(b_last[:, None] - b), vc)
        return S_new, o_inter + o_intra

    s_fin, o = lax.scan(step, s0, (to_chunks(q), to_chunks(k), to_chunks(v), to_chunks(log_f)))
    return s_fin, jnp.moveaxis(o, 0, 1).reshape(B, T, H, dv)


def scan_direction(q, k, v, log_f, s0, reverse):
    if reverse:
        q, k, v, log_f = (jnp.flip(t, axis=1) for t in (q, k, v, log_f))
    s_fin, o = gla_chunked(q, k, v, log_f, s0)
    if reverse:
        o = jnp.flip(o, axis=1)
    return s_fin, o


def token_mixer(h_lat, h_ctx, cos, sin, layer, w_in, g_qn, w_uq, g_kvn, w_ukv,
                lb_fwd, lb_bwd, g_on, w_out, with_ctx_out):
    B, N, _ = h_lat.shape
    L = h_ctx.shape[1]
    offs = [int(v) for v in np.cumsum(IN_SIZES)[:-1]]
    cq_l, ckv_l, kpe_l, hq_l, hi_l, hg_l, ff_l, fb_l = jnp.split(h_lat @ w_in, offs, axis=-1)
    cq_c, ckv_c, kpe_c, hq_c, hi_c, hg_c, ff_c, fb_c = jnp.split(h_ctx @ w_in, offs, axis=-1)

    def mla_q(cq, n):
        q = (rmsnorm(cq, g_qn) @ w_uq).reshape(B, n, MLA_HEADS, QK_HEAD_DIM)
        return q[..., :QK_NOPE_DIM], q[..., QK_NOPE_DIM:]

    def mla_kv(ckv, n):
        kv = (rmsnorm(ckv, g_kvn) @ w_ukv).reshape(B, n, MLA_HEADS, QK_NOPE_DIM + V_HEAD_DIM)
        return kv[..., :QK_NOPE_DIM], kv[..., QK_NOPE_DIM:]

    def full_k(k_nope, k_pe, n):
        k_pe = jnp.broadcast_to(k_pe[:, :, None, :], (B, n, MLA_HEADS, QK_ROPE_DIM))
        return jnp.concatenate([k_nope, k_pe], axis=-1)

    qn_l, qr_l = mla_q(cq_l, N)
    q_lat = jnp.concatenate([qn_l, apply_rope(qr_l, cos, sin)], axis=-1)
    kn_l, v_l = mla_kv(ckv_l, N)
    k_lat = full_k(kn_l, apply_rope(kpe_l, cos, sin), N)
    kn_c, v_c = mla_kv(ckv_c, L)
    k_ctx = full_k(kn_c, kpe_c, L)
    K = jnp.concatenate([k_ctx, k_lat], axis=1)
    V = jnp.concatenate([v_c, v_l], axis=1)
    o_mla_lat = attend_blocks(q_lat, K, V).reshape(B, N, MLA_WIDTH)

    def heads(t, n):
        return t.astype(jnp.float32).reshape(B, n, HGRN_HEADS, HGRN_KEY_DIM)

    def gates(fraw, lb_tab, n):
        lb = jnp.cumsum(jax.nn.softmax(lb_tab.astype(jnp.float32), axis=0), axis=0)[layer]
        f = lb + (1.0 - lb) * jax.nn.sigmoid(fraw.astype(jnp.float32))
        return heads(1.0 - f, n), heads(jnp.log(f), n)

    s0 = jnp.zeros((B, HGRN_HEADS, HGRN_KEY_DIM, HGRN_VAL_DIM), jnp.float32)
    q_hl, v_hl = heads(hq_l, N), heads(hi_l, N)
    q_hc, v_hc = heads(hq_c, L), heads(hi_c, L)
    o_h_lat = 0.0
    o_h_ctx = 0.0
    for fr_l, fr_c, lb_tab, rev in ((ff_l, ff_c, lb_fwd, False), (fb_l, fb_c, lb_bwd, True)):
        k_c, lf_c = gates(fr_c, lb_tab, L)
        s_ctx, o_c = scan_direction(q_hc, k_c, v_hc, lf_c, s0, rev)
        k_l, lf_l = gates(fr_l, lb_tab, N)
        _, o_l = scan_direction(q_hl, k_l, v_hl, lf_l, s_ctx, rev)
        o_h_lat = o_h_lat + o_l
        o_h_ctx = o_h_ctx + o_c

    def hgrn_out(o, hg, n):
        o = rmsnorm(o, g_on).astype(hg.dtype).reshape(B, n, HGRN_HEADS * HGRN_VAL_DIM)
        return o * jax.nn.silu(hg)

    lat_out = jnp.concatenate([o_mla_lat, hgrn_out(o_h_lat, hg_l, N)], axis=-1) @ w_out
    if not with_ctx_out:
        return lat_out, None
    qn_c, qr_c = mla_q(cq_c, L)
    q_ctx = jnp.concatenate([qn_c, qr_c], axis=-1)
    o_mla_ctx = attend_blocks(q_ctx, k_ctx, v_c).reshape(B, L, MLA_WIDTH)
    ctx_out = jnp.concatenate([o_mla_ctx, hgrn_out(o_h_ctx, hg_c, L)], axis=-1) @ w_out
    return lat_out, ctx_out


def swiglu(h, w_gate, w_up, w_down):
    return (jax.nn.silu(h @ w_gate) * (h @ w_up)) @ w_down


def setup_inputs(seed: int = 0) -> dict:
    key = jax.random.key(seed)
    ks = jax.random.split(key, 24)

    def nrm(k, shape, scale):
        return jax.random.normal(k, shape, jnp.float32) * scale

    def gain(k, shape):
        return 1.0 + nrm(k, shape, 0.05)

    return {
        "x": nrm(ks[0], (BATCH, SEQ, D_MODEL), 1.0),
        "c": nrm(ks[1], (BATCH, D_MODEL), 1.0),
        "ctx": nrm(ks[2], (BATCH, CTX_LEN, D_MODEL), 1.0),
        "c_ctx": nrm(ks[3], (D_MODEL,), 1.0),
        "w_mod": nrm(ks[4], (DEPTH, D_MODEL, 6 * D_MODEL), 0.5 * D_MODEL ** -0.5),
        "b_mod": nrm(ks[5], (DEPTH, 6 * D_MODEL), 0.02),
        "g_norm_mix": gain(ks[6], (DEPTH, D_MODEL)),
        "g_norm_ffn": gain(ks[7], (DEPTH, D_MODEL)),
        "w_in": nrm(ks[8], (DEPTH, D_MODEL, IN_COLS), D_MODEL ** -0.5),
        "g_q_norm": gain(ks[9], (DEPTH, Q_LORA_RANK)),
        "w_uq": nrm(ks[10], (DEPTH, Q_LORA_RANK, MLA_HEADS * QK_HEAD_DIM), Q_LORA_RANK ** -0.5),
        "g_kv_norm": gain(ks[11], (DEPTH, KV_LORA_RANK)),
        "w_ukv": nrm(ks[12], (DEPTH, KV_LORA_RANK, MLA_HEADS * (QK_NOPE_DIM + V_HEAD_DIM)), KV_LORA_RANK ** -0.5),
        "lb_fwd": nrm(ks[13], (DEPTH + 1, HGRN_WIDTH), 0.1),
        "lb_bwd": nrm(ks[14], (DEPTH + 1, HGRN_WIDTH), 0.1),
        "g_hgrn_norm": gain(ks[15], (DEPTH, HGRN_VAL_DIM)),
        "w_out": nrm(ks[16], (DEPTH, MIX_WIDTH, D_MODEL), MIX_WIDTH ** -0.5),
        "w_gate": nrm(ks[17], (DEPTH, D_MODEL, D_FF), D_MODEL ** -0.5),
        "w_up": nrm(ks[18], (DEPTH, D_MODEL, D_FF), D_MODEL ** -0.5),
        "w_down": nrm(ks[19], (DEPTH, D_FF, D_MODEL), D_FF ** -0.5),
        "g_final": gain(ks[20], (D_MODEL,)),
    }


def reference(x, c, ctx, c_ctx, w_mod, b_mod, g_norm_mix, g_norm_ffn, w_in, g_q_norm, w_uq,
              g_kv_norm, w_ukv, lb_fwd, lb_bwd, g_hgrn_norm, w_out, w_gate, w_up, w_down, g_final):
    N = x.shape[1]
    cos, sin = axial_rope_2d(N)
    for layer in range(DEPTH):
        mod = jax.nn.silu(c) @ w_mod[layer] + b_mod[layer]
        sh1, sc1, gt1, sh2, sc2, gt2 = jnp.split(mod[:, None, :], 6, axis=-1)
        mod_c = jax.nn.silu(c_ctx) @ w_mod[layer] + b_mod[layer]
        csh1, csc1, cgt1, csh2, csc2, cgt2 = jnp.split(mod_c, 6, axis=-1)
        update_ctx = layer < DEPTH - 1

        h = modulate(rmsnorm(x, g_norm_mix[layer]), sh1, sc1)
        hc = modulate(rmsnorm(ctx, g_norm_mix[layer]), csh1, csc1)
        mix_lat, mix_ctx = token_mixer(h, hc, cos, sin, layer, w_in[layer], g_q_norm[layer],
                                       w_uq[layer], g_kv_norm[layer], w_ukv[layer],
                                       lb_fwd, lb_bwd, g_hgrn_norm[layer], w_out[layer], update_ctx)
        x = x + gt1 * mix_lat
        h2 = modulate(rmsnorm(x, g_norm_ffn[layer]), sh2, sc2)
        x = x + gt2 * swiglu(h2, w_gate[layer], w_up[layer], w_down[layer])
        if update_ctx:
            ctx = ctx + cgt1 * mix_ctx
            hc2 = modulate(rmsnorm(ctx, g_norm_ffn[layer]), csh2, csc2)
            ctx = ctx + cgt2 * swiglu(hc2, w_gate[layer], w_up[layer], w_down[layer])
    return rmsnorm(x, g_final)
```

```cpp
#include <hip/hip_runtime.h>
#include <hip/hip_cooperative_groups.h>
#include <hip/hip_bf16.h>
#include <cstdio>
#include <cstdint>
namespace cg = cooperative_groups;
namespace pg8 {
#define PG8_LAS __attribute__((address_space(3)))
typedef unsigned short bf16_t;
typedef short bf16x8 __attribute__((ext_vector_type(8)));
typedef float f32x4 __attribute__((ext_vector_type(4)));
typedef unsigned u32x4 __attribute__((ext_vector_type(4)));
constexpr int BM = 256, BK = 64, HALF = 128, HTB = HALF * BK * 2  , STAGE_BYTES = 8 * HTB, NXCD = 8, WGM = 8;

__host__ __device__ __forceinline__ int lds_byte(int r, int c) { const int st = (r >> 4) * 2 + (c >> 5), rr = r & 15, cc = c & 31, ob = rr * 64 + cc * 2; return st * 1024 + (ob ^ (((ob >> 9) & 1) << 5)); }
__host__ __device__ __forceinline__ void stage_rc(int b, int& R, int& C) { const int st = b / 1024, sb = b % 1024, swz = sb ^ (((sb >> 9) & 1) << 5); R = (st >> 1) * 16 + swz / 64; C = (st & 1) * 32 + (swz % 64) / 2; }
__host__ __device__ __forceinline__ int perm32(int rho) { const int n = rho >> 4, i = rho & 15; return 8 * (i >> 2) + 4 * n + (i & 3); }

struct Unit { int pm, pn; };
struct Gemm { const bf16_t* A; const bf16_t* Bt; int M, N, K; };

struct StaticOrder {
    int nM, nN, nwg, G, c;
    __host__ __device__ void init(int M, int N, int G_, int c_) { nM = M / BM; nN = N / BM; nwg = nM * nN; G = G_; c = c_; }
    __host__ __device__ bool next(int i, Unit& u) const {
        const long L = (long)i * G + c; if (L >= nwg) return false;
        int wgid = (int)L; { const int q = nwg / NXCD, r = nwg % NXCD, xcd = wgid % NXCD, off = wgid / NXCD; wgid = (xcd < r ? xcd * (q + 1) : r * (q + 1) + (xcd - r) * q) + off; }
        const int nig = WGM * nN, gid = wgid / nig, fm = gid * WGM, gsz = (nM - fm) < WGM ? (nM - fm) : WGM;
        u.pm = fm + ((wgid % nig) % gsz); u.pn = (wgid % nig) / gsz; return true;
    }
    __device__ __forceinline__ void a_ready(const Unit&) const {}
    __device__ __forceinline__ void done(const Unit&) const {}
};

__device__ __forceinline__ unsigned cvt_pk_bf16(float lo, float hi) { unsigned r; asm volatile("v_cvt_pk_bf16_f32 %0, %1, %2" : "=v"(r) : "v"(lo), "v"(hi)); return r; }
typedef float f32x2 __attribute__((ext_vector_type(2)));
template <class Epi, class Sched, bool ALIGN_EPI = false, bool SP2 = false>
__device__ __forceinline__ void gemm_phase(PG8_LAS unsigned char* lds, const Gemm g, const Sched& S, const Epi& E) {
    const int tid = threadIdx.x, wid = __builtin_amdgcn_readfirstlane(tid >> 6), lane = tid & 63, wr = wid >> 2, wc = wid & 3, fr = lane & 15, fq = lane >> 4;
    const int K = g.K, nt = K / BK;
    unsigned voffA[2], voffB[2];
#pragma unroll
    for (int i = 0; i < 2; ++i) { int R, C; stage_rc(tid * 16 + i * 8192, R, C); const int Rb = Epi::PERM ? ((R & ~31) + perm32(R & 31)) : R;
        voffA[i] = (unsigned)(R * K + C) * 2u; voffB[i] = (unsigned)(Rb * K + C) * 2u; }
    const size_t kstep = (size_t)(BK * 2);
    const size_t hstep = (size_t)HALF * K * 2;
    const size_t tstep = 2 * hstep;
    const unsigned ldsw = (unsigned)wid * 1024u;
    const int aoff = lds_byte(wr * 64 + fr, fq * 8), boff = lds_byte(wc * 32 + fr, fq * 8);
#define PG8_SA(b, h) (((b) * 2 + (h)) * HTB)
#define PG8_SB(b, h) ((4 + (b) * 2 + (h)) * HTB)
#define PG8_STAGE(bufoff, gbase, voff) do { _Pragma("unroll") for (int _i = 0; _i < 2; ++_i) \
        __builtin_amdgcn_global_load_lds((const unsigned*)((const char*)(gbase) + (voff)[_i]), (PG8_LAS unsigned*)(lds + (bufoff) + ldsw + _i * 8192), 16, 0, 0); } while (0)
#define PG8_LDA(dst, b, h) do { _Pragma("unroll") for (int m = 0; m < 4; ++m) _Pragma("unroll") for (int k = 0; k < 2; ++k) dst[m][k] = *(const PG8_LAS bf16x8*)(lds + PG8_SA(b, h) + aoff + m * 2048 + k * 1024); } while (0)
#define PG8_LDB(dst, b, h) do { _Pragma("unroll") for (int n = 0; n < 2; ++n) _Pragma("unroll") for (int k = 0; k < 2; ++k) dst[n][k] = *(const PG8_LAS bf16x8*)(lds + PG8_SB(b, h) + boff + n * 2048 + k * 1024); } while (0)
#define PG8_MMA(ai, bj, At, Bt) do { __builtin_amdgcn_s_setprio(1); _Pragma("unroll") for (int m = 0; m < 4; ++m) _Pragma("unroll") for (int n = 0; n < 2; ++n) _Pragma("unroll") for (int k = 0; k < 2; ++k) \
        acc[ai][bj][m][n] = __builtin_amdgcn_mfma_f32_16x16x32_bf16(Bt[n][k], At[m][k], acc[ai][bj][m][n], 0, 0, 0); __builtin_amdgcn_s_setprio(0); } while (0)
#define PG8_WAIT_V(n) asm volatile("s_waitcnt vmcnt(" #n ")" ::: "memory")
#define PG8_WAIT_L(n) asm volatile("s_waitcnt lgkmcnt(" #n ")" ::: "memory")
#define PG8_BAR __builtin_amdgcn_s_barrier()
#define PG8_SCHED __builtin_amdgcn_sched_barrier(0)
    Unit cur, nxt; int ui = 0;
    if (!S.next(0, cur)) return;
    f32x4 acc[2][2][4][2];
#pragma unroll
    for (int a = 0; a < 2; ++a)
#pragma unroll
        for (int b = 0; b < 2; ++b)
#pragma unroll
            for (int m = 0; m < 4; ++m)
#pragma unroll
                for (int n = 0; n < 2; ++n) acc[a][b][m][n] = (f32x4){0.f, 0.f, 0.f, 0.f};
    bf16x8 At[4][2], B0[2][2], B1[2][2];
    const char* cA = (const char*)g.A + (size_t)cur.pm * tstep; const char* cB = (const char*)g.Bt + (size_t)cur.pn * tstep;
    S.a_ready(cur);
    if constexpr (SP2) {
        PG8_STAGE(PG8_SB(0, 0), cB, voffB); PG8_STAGE(PG8_SB(0, 1), cB + hstep, voffB); PG8_STAGE(PG8_SA(0, 0), cA, voffA); PG8_STAGE(PG8_SA(0, 1), cA + hstep, voffA);
        if (wr == 1) PG8_BAR;
        PG8_WAIT_V(2); PG8_BAR;
        PG8_STAGE(PG8_SB(1, 0), cB + kstep, voffB); PG8_STAGE(PG8_SA(1, 0), cA + kstep, voffA); PG8_STAGE(PG8_SB(1, 1), cB + hstep + kstep, voffB);
        PG8_WAIT_V(6); PG8_BAR;
    } else {
        PG8_STAGE(PG8_SB(0, 0), cB, voffB); PG8_STAGE(PG8_SA(0, 0), cA, voffA); PG8_STAGE(PG8_SB(0, 1), cB + hstep, voffB); PG8_STAGE(PG8_SA(0, 1), cA + hstep, voffA);
        if (wr == 1) PG8_BAR;
        PG8_WAIT_V(4); PG8_BAR;
        PG8_STAGE(PG8_SB(1, 0), cB + kstep, voffB); PG8_STAGE(PG8_SA(1, 0), cA + kstep, voffA); PG8_STAGE(PG8_SB(1, 1), cB + hstep + kstep, voffB);
        PG8_WAIT_V(6); PG8_BAR;
    }
    for (;;) {
        const bool has_next = S.next(ui + 1, nxt);
        const char* nA = has_next ? (const char*)g.A + (size_t)nxt.pm * tstep : cA; const char* nB = has_next ? (const char*)g.Bt + (size_t)nxt.pn * tstep : cB;
#pragma unroll 1
        for (int t = 0; t < nt; t += 2) {
            const bool last = (t == nt - 2);
            const char* a1 = cA + (size_t)(t + 1) * kstep;
            const char* a2 = last ? nA : cA + (size_t)(t + 2) * kstep; const char* b2 = last ? nB : cB + (size_t)(t + 2) * kstep;
            const char* a3 = a2 + kstep; const char* b3 = b2 + kstep;
            if (last && has_next) S.a_ready(nxt);
            if constexpr (SP2) {
            PG8_LDB(B0, 0, 0); PG8_LDB(B1, 0, 1); PG8_SCHED; PG8_LDA(At, 0, 0); PG8_STAGE(PG8_SA(1, 1), a1 + hstep, voffA);
            PG8_WAIT_V(8); PG8_WAIT_L(0); PG8_BAR; PG8_MMA(0, 0, At, B0); PG8_MMA(0, 1, At, B1); PG8_BAR; PG8_SCHED;
            PG8_LDA(At, 0, 1); PG8_STAGE(PG8_SB(0, 0), b2, voffB); PG8_STAGE(PG8_SB(0, 1), b2 + hstep, voffB); PG8_STAGE(PG8_SA(0, 0), a2, voffA);
            PG8_WAIT_V(8); PG8_WAIT_L(0); PG8_BAR; PG8_MMA(1, 0, At, B0); PG8_MMA(1, 1, At, B1); PG8_BAR; PG8_SCHED;
            PG8_LDB(B0, 1, 0); PG8_LDB(B1, 1, 1); PG8_SCHED; PG8_LDA(At, 1, 0); PG8_STAGE(PG8_SA(0, 1), a2 + hstep, voffA);
            PG8_WAIT_V(8); PG8_WAIT_L(0); PG8_BAR; PG8_MMA(0, 0, At, B0); PG8_MMA(0, 1, At, B1); PG8_BAR; PG8_SCHED;
            PG8_LDA(At, 1, 1); PG8_STAGE(PG8_SB(1, 0), b3, voffB); PG8_STAGE(PG8_SB(1, 1), b3 + hstep, voffB); PG8_STAGE(PG8_SA(1, 0), a3, voffA);
            PG8_WAIT_V(8); PG8_WAIT_L(0); PG8_BAR; PG8_MMA(1, 0, At, B0); PG8_MMA(1, 1, At, B1); PG8_BAR; PG8_SCHED;
            } else {
            PG8_LDB(B0, 0, 0); PG8_SCHED; PG8_LDA(At, 0, 0); PG8_STAGE(PG8_SA(1, 1), a1 + hstep, voffA);
            PG8_WAIT_L(8); PG8_BAR; PG8_WAIT_L(0); PG8_MMA(0, 0, At, B0); PG8_BAR; PG8_SCHED;
            PG8_LDB(B1, 0, 1); PG8_STAGE(PG8_SB(0, 0), b2, voffB);
            PG8_BAR; PG8_WAIT_L(0); PG8_MMA(0, 1, At, B1); PG8_BAR;
            PG8_LDA(At, 0, 1); PG8_STAGE(PG8_SA(0, 0), a2, voffA);
            PG8_BAR; PG8_WAIT_L(0); PG8_MMA(1, 0, At, B0); PG8_BAR; PG8_SCHED;
            PG8_STAGE(PG8_SB(0, 1), b2 + hstep, voffB);
            PG8_WAIT_V(6); PG8_BAR; PG8_MMA(1, 1, At, B1); PG8_BAR;
            PG8_LDB(B0, 1, 0); PG8_SCHED; PG8_LDA(At, 1, 0); PG8_STAGE(PG8_SA(0, 1), a2 + hstep, voffA);
            PG8_WAIT_L(8); PG8_BAR; PG8_WAIT_L(0); PG8_MMA(0, 0, At, B0); PG8_BAR; PG8_SCHED;
            PG8_LDB(B1, 1, 1); PG8_STAGE(PG8_SB(1, 0), b3, voffB);
            PG8_BAR; PG8_WAIT_L(0); PG8_MMA(0, 1, At, B1); PG8_BAR;
            PG8_LDA(At, 1, 1); PG8_STAGE(PG8_SA(1, 0), a3, voffA);
            PG8_BAR; PG8_WAIT_L(0); PG8_MMA(1, 0, At, B0); PG8_BAR; PG8_SCHED;
            PG8_STAGE(PG8_SB(1, 1), b3 + hstep, voffB);
            PG8_WAIT_V(6); PG8_BAR; PG8_MMA(1, 1, At, B1); PG8_BAR;
            }
        }
        if constexpr (ALIGN_EPI) { if (wr == 0) PG8_BAR; }
        if constexpr (!Epi::AFTER_DRAIN) { E(acc, cur, wr, wc, fr, fq); S.done(cur); }
        if (!has_next) break;
#pragma unroll
        for (int a = 0; a < 2; ++a)
#pragma unroll
            for (int b = 0; b < 2; ++b)
#pragma unroll
                for (int m = 0; m < 4; ++m)
#pragma unroll
                    for (int n = 0; n < 2; ++n) acc[a][b][m][n] = (f32x4){0.f, 0.f, 0.f, 0.f};
        cur = nxt; cA = nA; cB = nB; ++ui;
        if constexpr (ALIGN_EPI) { if (wr == 1) PG8_BAR; }
    }
    PG8_WAIT_V(0);
    if constexpr (!ALIGN_EPI) { if (wr == 0) PG8_BAR; }
    PG8_BAR;
    if constexpr (Epi::AFTER_DRAIN) { E.fused(acc, cur, wr, wc, fr, fq, lds, wid, lane); S.done(cur); }
#undef PG8_SA
#undef PG8_SB
#undef PG8_STAGE
#undef PG8_LDA
#undef PG8_LDB
#undef PG8_MMA
#undef PG8_WAIT_V
#undef PG8_WAIT_L
#undef PG8_BAR
#undef PG8_SCHED
}
}

#define LAS __attribute__((address_space(3)))
typedef unsigned short bf16_t;
typedef short bf16x8 __attribute__((ext_vector_type(8)));
typedef short s16x4 __attribute__((ext_vector_type(4)));
typedef float f32x4 __attribute__((ext_vector_type(4)));
typedef float f32x16 __attribute__((ext_vector_type(16)));
typedef unsigned u32x4 __attribute__((ext_vector_type(4)));
typedef unsigned u32x2 __attribute__((ext_vector_type(2)));

constexpr int NB = 8, SEQ = 4096, DM = 1024, CTXL = 256;
constexpr int ML = NB * SEQ, MC = NB * CTXL, MT = ML + MC;
constexpr int NIN = 3136, NINP = 3328, DFF = 2816, KVL = CTXL + SEQ;
constexpr int NCH = 68;
constexpr float EPS = 1e-6f;
constexpr size_t MiB = 1u << 20;
constexpr size_t WS_MOD = 0, WS_LBF = 256 * 1024, WS_LBB = 258 * 1024, WS_RCOS = 260 * 1024, WS_RSIN = 264 * 1024, WS_ROWSS = 512 * 1024;
constexpr size_t WS_WIN = 1 * MiB, WS_WUQ = 8 * MiB, WS_WUKV = 8 * MiB + 512 * 1024, WS_WOUT = 9 * MiB, WS_WGU = 11 * MiB, WS_WDN = 22 * MiB, WS_DG = 28 * MiB;
constexpr size_t WS_A = 32 * MiB;
constexpr size_t WS_CQ = 169 * MiB, WS_CKV = 186 * MiB, WS_HQ = 203 * MiB, WS_HI = 237 * MiB, WS_HG = 271 * MiB, WS_GF = 305 * MiB, WS_GB = 339 * MiB;
constexpr size_t WS_V = 373 * MiB, WS_MIX = 407 * MiB, WS_ACT = 169 * MiB, WS_RSSP = 471 * MiB, WS_END = 476 * MiB;
constexpr int LDS_BYTES = 163840;

__device__ __forceinline__ unsigned f2bf(float f) { unsigned u = __builtin_bit_cast(unsigned, f); return (u + 0x7fffu + ((u >> 16) & 1u)) >> 16; }
__device__ __forceinline__ float bf2f(unsigned h) { return __builtin_bit_cast(float, h << 16); }
typedef __bf16 bf16v2_t __attribute__((ext_vector_type(2)));
__device__ __forceinline__ unsigned pk2(float lo, float hi) { bf16v2_t v; v.x = (__bf16)lo; v.y = (__bf16)hi; return __builtin_bit_cast(unsigned, v); }
__device__ __forceinline__ float wave_sum(float v) {
#pragma unroll
    for (int o = 1; o < 64; o <<= 1) v += __shfl_xor(v, o);
    return v;
}
__device__ __forceinline__ float sigmoidf_(float x) { return 1.f / (1.f + __expf(-x)); }
#define LDS_WAIT() asm volatile("s_waitcnt lgkmcnt(0)" ::: "memory")

struct Args {
    const float *x, *c, *ctx, *c_ctx, *w_mod, *b_mod, *g_mix, *g_ffn, *w_in, *g_qn, *w_uq, *g_kvn, *w_ukv, *lb_fwd, *lb_bwd, *g_on, *w_out, *w_gate, *w_up, *w_down, *g_final;
    float* out; unsigned char* ws; int ph_lo, ph_hi;
};

__device__ __forceinline__ void p0_mod_item(const Args& a, char* ldsc, int item) {
    float* sl = (float*)ldsc;
    float* red = sl + 9216;
    const int tid = threadIdx.x, wave = tid >> 6, lane = tid & 63;
    for (int i = tid; i < 9216; i += 512) { const float v = (i < 8192) ? a.c[i] : a.c_ctx[i - 8192]; sl[i] = v * sigmoidf_(v); }
    __syncthreads();
    float acc[9];
#pragma unroll
    for (int r = 0; r < 9; ++r) acc[r] = 0.f;
    const float* wp = a.w_mod + (size_t)(wave * 128) * 6144 + item * 64 + lane;
#pragma unroll 4
    for (int k = 0; k < 128; ++k) {
        const float w = wp[(size_t)k * 6144];
#pragma unroll
        for (int r = 0; r < 9; ++r) acc[r] += sl[r * 1024 + wave * 128 + k] * w;
    }
#pragma unroll
    for (int r = 0; r < 9; ++r) red[(wave * 9 + r) * 64 + lane] = acc[r];
    __syncthreads();
    float* MOD = (float*)(a.ws + WS_MOD);
    for (int i = tid; i < 576; i += 512) {
        const int r = i >> 6, l = i & 63; float s = 0.f;
#pragma unroll
        for (int w = 0; w < 8; ++w) s += red[(w * 9 + r) * 64 + l];
        MOD[r * 6144 + item * 64 + l] = s + a.b_mod[item * 64 + l];
    }
    __syncthreads();
}
__device__ __forceinline__ void p0_transpose_item(const float* W, int N, bf16_t* WT, int Kd, int drow0, const float* kscale, float* scr, int k0, int n0, int lane) {
#pragma unroll 8
    for (int i = 0; i < 32; ++i) { const int kk = 2 * i + (lane >> 5); float v = W[(size_t)(k0 + kk) * N + n0 + (lane & 31)]; if (kscale) v *= kscale[k0 + kk]; scr[kk * 33 + (lane & 31)] = v; }
    LDS_WAIT(); asm volatile("" ::: "memory");
    const int c = lane & 7;
#pragma unroll
    for (int j = 0; j < 4; ++j) { const int n = (lane >> 3) + 8 * j; const float* s = scr + (8 * c) * 33 + n;
        u32x4 o; o.x = pk2(s[0 * 33], s[1 * 33]); o.y = pk2(s[2 * 33], s[3 * 33]); o.z = pk2(s[4 * 33], s[5 * 33]); o.w = pk2(s[6 * 33], s[7 * 33]);
        *(u32x4*)(WT + (size_t)(drow0 + n) * Kd + k0 + 8 * c) = o; }
    LDS_WAIT(); asm volatile("" ::: "memory");
}
__device__ __forceinline__ void p0_prologue(const Args& a, char* ldsc, int G) {
    const int tid = threadIdx.x, wave = tid >> 6, lane = tid & 63;
    unsigned char* ws = a.ws;
    if (blockIdx.x < 96) p0_mod_item(a, ldsc, blockIdx.x);
    if ((int)blockIdx.x == G - 1) {
        float* LBF = (float*)(ws + WS_LBF); float* LBB = (float*)(ws + WS_LBB);
        LBF[tid] = 1.f / (1.f + __expf(a.lb_fwd[512 + tid] - a.lb_fwd[tid]));
        LBB[tid] = 1.f / (1.f + __expf(a.lb_bwd[512 + tid] - a.lb_bwd[tid]));
        float* RC = (float*)(ws + WS_RCOS); float* RS = (float*)(ws + WS_RSIN);
        for (int i = tid; i < 1024; i += 512) {
            const int pos = i >> 4, fi = i & 15;
            const float inv = exp2f(-(float)fi * (13.287712379549449f / 16.f));
            const float ang = (float)pos * inv;
            const float kq = rintf(ang * 0.15915494309189535f);
            float r = fmaf(-kq, 6.28125f, ang); r = fmaf(-kq, 0.0019353071795864769f, r);
            RC[i] = __cosf(r); RS[i] = __sinf(r);
        }
    }
    { u32x4* pz = (u32x4*)(ws + WS_WIN + (size_t)NIN * 1024 * 2); const u32x4 z = {0u, 0u, 0u, 0u};
      for (int i = blockIdx.x * 512 + tid; i < (NINP - NIN) * 1024 * 2 / 16; i += G * 512) pz[i] = z; }
    float* scr = (float*)(ldsc + wave * 16384);
    const int gw = blockIdx.x * 8 + wave, NGW = G * 8;
    constexpr int I_IN = 16 * 98, I_UQ = 4 * 24, I_UKV = 4 * 32, I_OUT = 16 * 32, I_G = 16 * 88, I_DN = 44 * 32;
    constexpr int NITEMS = I_IN + I_UQ + I_UKV + I_OUT + 2 * I_G + I_DN;
    for (int it = gw; it < NITEMS; it += NGW) {
        int r = it;
        if (r < I_IN) { const int kb = r / 98, nb = r % 98; p0_transpose_item(a.w_in, NIN, (bf16_t*)(ws + WS_WIN), 1024, 32 * nb, nullptr, scr, 64 * kb, 32 * nb, lane); continue; } r -= I_IN;
        if (r < I_UQ) { const int kb = r / 24, nb = r % 24; p0_transpose_item(a.w_uq, 768, (bf16_t*)(ws + WS_WUQ), 256, 32 * nb, a.g_qn, scr, 64 * kb, 32 * nb, lane); continue; } r -= I_UQ;
        if (r < I_UKV) { const int kb = r / 32, nb = r % 32; p0_transpose_item(a.w_ukv, 1024, (bf16_t*)(ws + WS_WUKV), 256, 32 * nb, a.g_kvn, scr, 64 * kb, 32 * nb, lane); continue; } r -= I_UKV;
        if (r < I_OUT) { const int kb = r / 32, nb = r % 32; p0_transpose_item(a.w_out, 1024, (bf16_t*)(ws + WS_WOUT), 1024, 32 * nb, nullptr, scr, 64 * kb, 32 * nb, lane); continue; } r -= I_OUT;
        if (r < 2 * I_G) { const int up = r >= I_G; if (up) r -= I_G; const int kb = r / 88, nb = r % 88, n0 = 32 * nb;
            const int drow = (n0 >> 7) * 256 + (n0 & 127) + (up ? 128 : 0);
            p0_transpose_item(up ? a.w_up : a.w_gate, DFF, (bf16_t*)(ws + WS_WGU), 1024, drow, nullptr, scr, 64 * kb, n0, lane); continue; } r -= 2 * I_G;
        { const int kb = r / 32, nb = r % 32; p0_transpose_item(a.w_down, 1024, (bf16_t*)(ws + WS_WDN), DFF, 32 * nb, nullptr, scr, 64 * kb, 32 * nb, lane); }
    }
}

__device__ __forceinline__ void row_norm_mod_bf16(const float* src, const float* g, const float* sh, const float* sc, bf16_t* dst, int lane) {
    const f32x4* xr = (const f32x4*)src + lane;
    f32x4 v[4]; float s = 0.f;
#pragma unroll
    for (int j = 0; j < 4; ++j) { v[j] = xr[64 * j]; s += (v[j].x * v[j].x + v[j].y * v[j].y) + (v[j].z * v[j].z + v[j].w * v[j].w); }
    const float rstd = rsqrtf(wave_sum(s) * (1.f / 1024.f) + EPS);
    u32x2* o8 = (u32x2*)dst + lane;
#pragma unroll
    for (int j = 0; j < 4; ++j) {
        const f32x4 gg = ((const f32x4*)g)[lane + 64 * j], s1 = ((const f32x4*)sc)[lane + 64 * j], s0 = ((const f32x4*)sh)[lane + 64 * j];
        const f32x4 y = v[j] * rstd * gg * (s1 + 1.f) + s0;
        u32x2 w; w.x = pk2(y.x, y.y); w.y = pk2(y.z, y.w); o8[64 * j] = w;
    }
}
__device__ __forceinline__ void row_norm_f32(float* row, const float* g, int lane) {
    f32x4* xr = (f32x4*)row + lane;
    f32x4 v[4]; float s = 0.f;
#pragma unroll
    for (int j = 0; j < 4; ++j) { v[j] = xr[64 * j]; s += (v[j].x * v[j].x + v[j].y * v[j].y) + (v[j].z * v[j].z + v[j].w * v[j].w); }
    const float rstd = rsqrtf(wave_sum(s) * (1.f / 1024.f) + EPS);
#pragma unroll
    for (int j = 0; j < 4; ++j) { f32x4 o = v[j] * rstd * ((const f32x4*)g)[lane + 64 * j];
#ifdef SANITIZE
        o.x = __builtin_isfinite(o.x) ? o.x : 1000.f; o.y = __builtin_isfinite(o.y) ? o.y : 1000.f; o.z = __builtin_isfinite(o.z) ? o.z : 1000.f; o.w = __builtin_isfinite(o.w) ? o.w : 1000.f;
#endif
        xr[64 * j] = o; }
}

__device__ __forceinline__ void rope8(float (&v)[8], int fq, const float* rc, const float* rs, int pos, bool apply) {
    const int ib = pos * 16 + 8 * (fq & 1);
#pragma unroll
    for (int e = 0; e < 8; ++e) {
        const float partner = __shfl_xor(v[e], 32);
        const float cs = rc[ib + e], sn = rs[ib + e];
        const float r = (fq < 2) ? (v[e] * cs - partner * sn) : (v[e] * cs + partner * sn);
        v[e] = apply ? r : v[e];
    }
}
__device__ __forceinline__ u32x4 pack8(const float (&v)[8]) { u32x4 w; w.x = pk2(v[0], v[1]); w.y = pk2(v[2], v[3]); w.z = pk2(v[4], v[5]); w.w = pk2(v[6], v[7]); return w; }

struct EpiInProj {
    static constexpr bool PERM = true, AFTER_DRAIN = false;
    unsigned char* ws; bf16_t* Kb;
    __device__ __forceinline__ void operator()(const pg8::f32x4 (&acc)[2][2][4][2], const pg8::Unit& u, int wr, int wc, int fr, int fq) const {
        float* RSS = (float*)(ws + WS_RSSP); const float* RC = (const float*)(ws + WS_RCOS); const float* RS = (const float*)(ws + WS_RSIN);
#pragma unroll
        for (int bj = 0; bj < 2; ++bj) {
            const int cbase = u.pn * 256 + bj * 128 + wc * 32;
            if (cbase >= NIN) continue;
            const int c0 = cbase + 8 * fq;
#pragma unroll
            for (int ai = 0; ai < 2; ++ai)
#pragma unroll
                for (int m = 0; m < 4; ++m) {
                    const int row = u.pm * 256 + ai * 128 + wr * 64 + m * 16 + fr;
                    float v[8];
#pragma unroll
                    for (int e = 0; e < 4; ++e) { v[e] = acc[ai][bj][m][0][e]; v[4 + e] = acc[ai][bj][m][1][e]; }
                    if (cbase < 512) {
                        bf16_t* dst = (bf16_t*)(ws + WS_CQ + (cbase < 256 ? (size_t)0 : (WS_CKV - WS_CQ))) + (size_t)row * 256 + (c0 & 255);
                        *(u32x4*)dst = pack8(v);
                        float ss = 0.f;
#pragma unroll
                        for (int e = 0; e < 8; ++e) ss += v[e] * v[e];
                        ss += __shfl_xor(ss, 16); ss += __shfl_xor(ss, 32);
                        if (fq == 0) RSS[((size_t)row * 2 + (cbase < 256 ? 0 : 1)) * 8 + bj * 4 + wc] = ss;
                    } else if (cbase < 576) {
                        const int axis = (cbase - 512) >> 5;
                        const bool lat = row < ML;
                        const int n = row & 4095;
                        const int pos = axis ? (n & 63) : (n >> 6);
                        rope8(v, fq, RC, RS, lat ? pos : 0, lat);
                        const int b = lat ? (row >> 12) : ((row - ML) >> 8);
                        const int kvpos = lat ? (CTXL + n) : ((row - ML) & 255);
                        const u32x4 w = pack8(v);
#pragma unroll
                        for (int h = 0; h < 4; ++h) *(u32x4*)(Kb + ((size_t)(b * 4 + h) * KVL + kvpos) * 192 + 128 + axis * 32 + 8 * fq) = w;
                    } else if (cbase < 2112) {
                        const int seg = (cbase - 576) >> 9;
                        bf16_t* base = (bf16_t*)(ws + WS_HQ + (size_t)seg * (WS_HI - WS_HQ));
                        *(u32x4*)(base + (size_t)row * 512 + (c0 - 576 - seg * 512)) = pack8(v);
                    } else {
                        const int dirn = (cbase - 2112) >> 9, j = c0 - 2112 - dirn * 512;
                        const float* lbp = (const float*)(ws + WS_LBF + (size_t)dirn * (WS_LBB - WS_LBF)) + j;
                        typedef _Float16 h8 __attribute__((ext_vector_type(8)));
                        h8 o;
#pragma unroll
                        for (int e = 0; e < 8; ++e) { const float lb = lbp[e]; const float f = lb + (1.f - lb) * sigmoidf_(v[e]); o[e] = (_Float16)__logf(f); }
                        *(h8*)((_Float16*)(ws + WS_GF + (size_t)dirn * (WS_GB - WS_GF)) + (size_t)row * 512 + j) = o;
                    }
                }
        }
    }
};
struct EpiQ {
    static constexpr bool PERM = true, AFTER_DRAIN = false;
    bf16_t* Q; const float* RSS; const float *RC, *RS;
    __device__ __forceinline__ void operator()(const pg8::f32x4 (&acc)[2][2][4][2], const pg8::Unit& u, int wr, int wc, int fr, int fq) const {
#pragma unroll
        for (int bj = 0; bj < 2; ++bj) {
            const int cbase = u.pn * 256 + bj * 128 + wc * 32;
            const int h = cbase / 192, d0 = cbase - h * 192;
            const bool rope = d0 >= 128; const int axis = (d0 - 128) >> 5;
#pragma unroll
            for (int ai = 0; ai < 2; ++ai)
#pragma unroll
                for (int m = 0; m < 4; ++m) {
                    const int row = u.pm * 256 + ai * 128 + wr * 64 + m * 16 + fr;
                    const f32x4 s0 = *(const f32x4*)(RSS + (size_t)row * 16), s1 = *(const f32x4*)(RSS + (size_t)row * 16 + 4);
                    const float rstd = rsqrtf((((s0.x + s0.y) + (s0.z + s0.w)) + ((s1.x + s1.y) + (s1.z + s1.w))) * (1.f / 256.f) + EPS);
                    float v[8];
#pragma unroll
                    for (int e = 0; e < 4; ++e) { v[e] = acc[ai][bj][m][0][e] * rstd; v[4 + e] = acc[ai][bj][m][1][e] * rstd; }
                    const int b = row >> 12, n = row & 4095;
                    if (rope) { const int pos = axis ? (n & 63) : (n >> 6); rope8(v, fq, RC, RS, pos, true); }
                    *(u32x4*)(Q + ((size_t)(b * 4 + h) * SEQ + n) * 192 + d0 + 8 * fq) = pack8(v);
                    asm volatile("" ::: "memory");
                }
        }
    }
};
struct EpiKV {
    static constexpr bool PERM = true, AFTER_DRAIN = false;
    bf16_t *Kb, *Vb; const float* RSS;
    __device__ __forceinline__ void operator()(const pg8::f32x4 (&acc)[2][2][4][2], const pg8::Unit& u, int wr, int wc, int fr, int fq) const {
#pragma unroll
        for (int bj = 0; bj < 2; ++bj) {
            const int cbase = u.pn * 256 + bj * 128 + wc * 32;
            const int h = cbase >> 8, j0 = cbase & 255;
#pragma unroll
            for (int ai = 0; ai < 2; ++ai)
#pragma unroll
                for (int m = 0; m < 4; ++m) {
                    const int row = u.pm * 256 + ai * 128 + wr * 64 + m * 16 + fr;
                    const f32x4 s0 = *(const f32x4*)(RSS + (size_t)row * 16 + 8), s1 = *(const f32x4*)(RSS + (size_t)row * 16 + 12);
                    const float rstd = rsqrtf((((s0.x + s0.y) + (s0.z + s0.w)) + ((s1.x + s1.y) + (s1.z + s1.w))) * (1.f / 256.f) + EPS);
                    float v[8];
#pragma unroll
                    for (int e = 0; e < 4; ++e) { v[e] = acc[ai][bj][m][0][e] * rstd; v[4 + e] = acc[ai][bj][m][1][e] * rstd; }
                    const bool lat = row < ML;
                    const int b = lat ? (row >> 12) : ((row - ML) >> 8);
                    const int kvpos = lat ? (CTXL + (row & 4095)) : ((row - ML) & 255);
                    const size_t r = (size_t)(b * 4 + h) * KVL + kvpos;
                    if (j0 < 128) *(u32x4*)(Kb + r * 192 + j0 + 8 * fq) = pack8(v);
                    else          *(u32x4*)(Vb + r * 128 + (j0 - 128) + 8 * fq) = pack8(v);
                    asm volatile("" ::: "memory");
                }
        }
    }
};
struct EpiRes {
    static constexpr bool PERM = false, AFTER_DRAIN = false;
    const float* base; float* out; const float* gate;
    __device__ __forceinline__ void operator()(const pg8::f32x4 (&acc)[2][2][4][2], const pg8::Unit& u, int wr, int wc, int fr, int fq) const {
#pragma unroll
        for (int ai = 0; ai < 2; ++ai)
#pragma unroll
            for (int m = 0; m < 4; ++m) {
                const int row = u.pm * 256 + ai * 128 + wr * 64 + m * 16 + fr;
                const float* gp = gate + (size_t)(row >> 12) * 6144;
#pragma unroll
                for (int bj = 0; bj < 2; ++bj)
#pragma unroll
                    for (int n = 0; n < 2; ++n) {
                        const int c = u.pn * 256 + bj * 128 + wc * 32 + 16 * n + 4 * fq;
                        const f32x4 g = *(const f32x4*)(gp + c), bs = *(const f32x4*)(base + (size_t)row * 1024 + c);
                        const pg8::f32x4 a4 = acc[ai][bj][m][n];
                        f32x4 o; o.x = bs.x + g.x * a4[0]; o.y = bs.y + g.y * a4[1]; o.z = bs.z + g.z * a4[2]; o.w = bs.w + g.w * a4[3];
                        *(f32x4*)(out + (size_t)row * 1024 + c) = o;
                    }
            }
    }
};
struct EpiSwiglu {
    static constexpr bool PERM = true, AFTER_DRAIN = false;
    bf16_t* ACT;
    __device__ __forceinline__ void operator()(const pg8::f32x4 (&acc)[2][2][4][2], const pg8::Unit& u, int wr, int wc, int fr, int fq) const {
#pragma unroll
        for (int ai = 0; ai < 2; ++ai)
#pragma unroll
            for (int m = 0; m < 4; ++m) {
                const int row = u.pm * 256 + ai * 128 + wr * 64 + m * 16 + fr;
                float v[8];
#pragma unroll
                for (int n = 0; n < 2; ++n)
#pragma unroll
                    for (int e = 0; e < 4; ++e) { const float g = acc[ai][0][m][n][e], uu = acc[ai][1][m][n][e]; v[4 * n + e] = g * sigmoidf_(g) * uu; }
                *(u32x4*)(ACT + (size_t)row * DFF + u.pn * 128 + wc * 32 + 8 * fq) = pack8(v);
            }
    }
};

#ifndef ATT_QREG
#define ATT_QREG 2
#endif
namespace att {
constexpr int NW = 8, QBLK = 32, KVBLK = 64;
constexpr float SCALE = 0.07216878364870322f;
constexpr float THR = 8.f;
constexpr int LDQ = 192, LDK = 192, LDV = 128, LDO = 1024;
constexpr int SHM_V = KVBLK * 128 * 2, SHM_K = KVBLK * 192 * 2, SHM_Q = (12 - ATT_QREG) * 1024, SHM_ATTN = 2 * SHM_V + 2 * SHM_K + NW * SHM_Q;
static_assert(SHM_ATTN <= 163840, "attention LDS");
#define KSWZ(row, colB) ((row) * 384 + ((colB) ^ (((row) & 7) << 4)))
#define SBAR() __builtin_amdgcn_sched_barrier(0)
__device__ __forceinline__ int crow(int r, int hi) { return (r & 3) + 8 * (r >> 2) + 4 * hi; }
__device__ __forceinline__ unsigned cvtpk(float lo, float hi) { return pk2(lo, hi); }
__device__ __forceinline__ void partialSM(f32x16& p0, f32x16& p1, float& m_reg, float& mn, float& alpha) {
  constexpr float C = SCALE * 1.4426950408889634f;
  float pmax = p0[0];
#pragma unroll
  for (int r = 1; r < 16; ++r) pmax = fmaxf(pmax, p0[r]);
#pragma unroll
  for (int r = 0; r < 16; ++r) pmax = fmaxf(pmax, p1[r]);
  { auto rr = __builtin_amdgcn_permlane32_swap(__float_as_uint(pmax), __float_as_uint(pmax), false, false);
    pmax = fmaxf(__uint_as_float(rr[0]), __uint_as_float(rr[1])); }
  if (__builtin_expect(__all(pmax - m_reg <= THR / SCALE), 1)) { mn = m_reg; alpha = 1.f; }
  else { mn = fmaxf(m_reg, pmax); alpha = __builtin_amdgcn_exp2f((m_reg - mn) * C); m_reg = mn; }
  float mnC = -mn * C;
#pragma unroll
  for (int r = 0; r < 16; ++r) p0[r] = fmaf(p0[r], C, mnC);
#pragma unroll
  for (int r = 0; r < 16; ++r) p1[r] = fmaf(p1[r], C, mnC);
#pragma unroll
  for (int r = 0; r < 16; ++r) p0[r] = __builtin_amdgcn_exp2f(p0[r]);
}
__device__ __forceinline__ void finishSM(f32x16& p0, f32x16& p1, float alpha, float& l_reg, bf16x8& pa0, bf16x8& pa1, bf16x8& pa2, bf16x8& pa3) {
#pragma unroll
  for (int r = 0; r < 16; ++r) p1[r] = __builtin_amdgcn_exp2f(p1[r]);
  float ps = 0;
#pragma unroll
  for (int r = 0; r < 16; ++r) ps += p0[r];
#pragma unroll
  for (int r = 0; r < 16; ++r) ps += p1[r];
  { auto rr = __builtin_amdgcn_permlane32_swap(__float_as_uint(ps), __float_as_uint(ps), false, false);
    ps = __uint_as_float(rr[0]) + __uint_as_float(rr[1]); }
  l_reg = l_reg * alpha + ps;
#define PK4(P, BASE, OUT) do { unsigned a0 = cvtpk(P[BASE + 0], P[BASE + 1]), a1 = cvtpk(P[BASE + 2], P[BASE + 3]);   \
    unsigned b0 = cvtpk(P[BASE + 4], P[BASE + 5]), b1 = cvtpk(P[BASE + 6], P[BASE + 7]);                              \
    auto r0 = __builtin_amdgcn_permlane32_swap(a0, b0, false, false); auto r1 = __builtin_amdgcn_permlane32_swap(a1, b1, false, false); \
    u32x4 w = {r0[0], r1[0], r0[1], r1[1]}; OUT = *reinterpret_cast<bf16x8*>(&w); } while (0)
  PK4(p0, 0, pa0); PK4(p0, 8, pa1); PK4(p1, 0, pa2); PK4(p1, 8, pa3);
#undef PK4
}
constexpr int QREG = ATT_QREG;
__device__ __forceinline__ void qkt(f32x16& p0, f32x16& p1, const char* Ks, const bf16x8* qr, const char* Qs, int r32, int hi) {
  p0 = f32x16{}; p1 = f32x16{};
#pragma unroll
  for (int d0 = 0; d0 < 12; ++d0) { int cb = (d0 * 16 + hi * 8) * 2;
    bf16x8 b0 = *reinterpret_cast<const bf16x8*>(Ks + KSWZ(r32, cb));
    bf16x8 b1 = *reinterpret_cast<const bf16x8*>(Ks + KSWZ(32 + r32, cb));
    bf16x8 qf; if (d0 < QREG) qf = qr[d0]; else qf = *reinterpret_cast<const bf16x8*>(Qs + (d0 - QREG) * 1024);
    p0 = __builtin_amdgcn_mfma_f32_32x32x16_bf16(b0, qf, p0, 0, 0, 0);
    p1 = __builtin_amdgcn_mfma_f32_32x32x16_bf16(b1, qf, p1, 0, 0, 0);
#ifdef ATT_QSB
    if ((d0 % ATT_QSB) == ATT_QSB - 1) SBAR();
#endif
  }
}
__device__ __forceinline__ int v_st(int k, int c) { const int kk = (k & ~0xC) | ((k & 4) << 1) | ((k & 8) >> 1); return ((kk >> 3) * 4 + (c >> 5)) * 512 + ((kk & 7) * 32 + (c & 31)) * 2; }
__device__ __forceinline__ int v_rd_base(int lane) { return ((lane & 3) << 3) | (((lane >> 2) & 3) << 6) | (((lane >> 4) & 1) << 5) | (((lane >> 5) & 1) << 8); }
constexpr int v_rd_off(int d0, int ks, int half) { return d0 * 512 + ks * 4096 + half * 2048; }
template <int OFF> __device__ __forceinline__ s16x4 tr_read(int vb) {
  s16x4 r; asm volatile("ds_read_b64_tr_b16 %0, %1 offset:%2" : "=&v"(r) : "v"(vb), "i"(OFF) : "memory"); return r;
}
template <int D0> __device__ __forceinline__ void pv_one(f32x16& od, int vb, bf16x8 pa0, bf16x8 pa1, bf16x8 pa2, bf16x8 pa3) {
  const s16x4 l0 = tr_read<v_rd_off(D0, 0, 0)>(vb), h0 = tr_read<v_rd_off(D0, 0, 1)>(vb), l1 = tr_read<v_rd_off(D0, 1, 0)>(vb), h1 = tr_read<v_rd_off(D0, 1, 1)>(vb);
  const s16x4 l2 = tr_read<v_rd_off(D0, 2, 0)>(vb), h2 = tr_read<v_rd_off(D0, 2, 1)>(vb), l3 = tr_read<v_rd_off(D0, 3, 0)>(vb), h3 = tr_read<v_rd_off(D0, 3, 1)>(vb);
  asm volatile("s_waitcnt lgkmcnt(0)" ::: "memory"); SBAR();
#define PK(L, H) (bf16x8){L[0], L[1], L[2], L[3], H[0], H[1], H[2], H[3]}
  od = __builtin_amdgcn_mfma_f32_32x32x16_bf16(pa0, PK(l0, h0), od, 0, 0, 0);
  od = __builtin_amdgcn_mfma_f32_32x32x16_bf16(pa1, PK(l1, h1), od, 0, 0, 0);
  od = __builtin_amdgcn_mfma_f32_32x32x16_bf16(pa2, PK(l2, h2), od, 0, 0, 0);
  od = __builtin_amdgcn_mfma_f32_32x32x16_bf16(pa3, PK(l3, h3), od, 0, 0, 0);
#undef PK
}
__device__ __forceinline__ void pv_d0(f32x16* o, int vb, bf16x8 pa0, bf16x8 pa1, bf16x8 pa2, bf16x8 pa3) {
  pv_one<0>(o[0], vb, pa0, pa1, pa2, pa3); pv_one<1>(o[1], vb, pa0, pa1, pa2, pa3); pv_one<2>(o[2], vb, pa0, pa1, pa2, pa3); pv_one<3>(o[3], vb, pa0, pa1, pa2, pa3);
}
__device__ __forceinline__ void attn_body(const bf16_t* __restrict__ Qb, const bf16_t* __restrict__ Kh, const bf16_t* __restrict__ Vh, bf16_t* __restrict__ Ob, int seq, char* lds) {
  const int tid = threadIdx.x, wid = tid >> 6, lane = tid & 63, r32 = lane & 31, hi = lane >> 5;
  char* V_lds = lds; char* K_lds = lds + 2 * SHM_V;
  float m_reg = -1e30f, l_reg = 0; f32x16 o[4] = {}; bf16x8 qr[QREG];
  const bf16_t* Qw = Qb + (long)(wid * QBLK + r32) * LDQ + hi * 8;
  char* Qs = lds + 2 * SHM_V + 2 * SHM_K + wid * SHM_Q + lane * 16;
#pragma unroll
  for (int d0 = 0; d0 < QREG; ++d0) qr[d0] = *reinterpret_cast<const bf16x8*>(Qw + d0 * 16);
#pragma unroll
  for (int d0 = QREG; d0 < 12; ++d0) *reinterpret_cast<bf16x8*>(Qs + (d0 - QREG) * 1024) = *reinterpret_cast<const bf16x8*>(Qw + d0 * 16);
  const int sr = tid >> 4, sc = (tid & 15) * 8, vst0 = v_st(sr, sc), vst1 = v_st(32 + sr, sc);
  const int kid0 = tid, kid1 = tid + 512, kid2 = tid + 1024;
  const int kr0 = kid0 / 24, kc0 = kid0 % 24, kr1 = kid1 / 24, kc1 = kid1 % 24, kr2 = kid2 / 24, kc2 = kid2 % 24;
  const int kg0 = kr0 * LDK + kc0 * 8, kg1 = kr1 * LDK + kc1 * 8, kg2 = kr2 * LDK + kc2 * 8;
  const int kl0 = KSWZ(kr0, kc0 * 16), kl1 = KSWZ(kr1, kc1 * 16), kl2 = KSWZ(kr2, kc2 * 16);
  const int vb0 = (int)(uintptr_t)V_lds + v_rd_base(lane);
  bf16x8 sA_v0, sA_v1, sA_k0, sA_k1, sA_k2;
#define SLOADA(k0) do { sA_v0 = *(const bf16x8*)&Vh[(long)((k0) + sr) * LDV + sc]; sA_v1 = *(const bf16x8*)&Vh[(long)((k0) + 32 + sr) * LDV + sc]; \
    sA_k0 = *(const bf16x8*)&Kh[(long)(k0) * LDK + kg0]; sA_k1 = *(const bf16x8*)&Kh[(long)(k0) * LDK + kg1]; sA_k2 = *(const bf16x8*)&Kh[(long)(k0) * LDK + kg2]; } while (0)
#define SWRITEA(b) do { *(bf16x8*)(V_lds + (b) * SHM_V + vst0) = sA_v0; *(bf16x8*)(V_lds + (b) * SHM_V + vst1) = sA_v1; \
    *(bf16x8*)(K_lds + (b) * SHM_K + kl0) = sA_k0; *(bf16x8*)(K_lds + (b) * SHM_K + kl1) = sA_k1; *(bf16x8*)(K_lds + (b) * SHM_K + kl2) = sA_k2; } while (0)
#define SWAIT() asm volatile("s_waitcnt vmcnt(0)" ::: "memory")
#define RESC(a) do { if (__any((a) < 1.f)) { \
    _Pragma("unroll") for (int r = 0; r < 16; ++r) { const float al_ = __shfl((a), crow(r, hi)); _Pragma("unroll") for (int d = 0; d < 4; ++d) o[d][r] *= al_; } } } while (0)
  f32x16 pA0, pA1, pB0, pB1; float mnA, mnB, alA, alB; bf16x8 pa0, pa1, pa2, pa3; const int NT = seq / KVBLK;
  SLOADA(0); SWAIT(); SWRITEA(0); __syncthreads();
  qkt(pA0, pA1, K_lds, qr, Qs, r32, hi); partialSM(pA0, pA1, m_reg, mnA, alA);
  SLOADA(KVBLK);
  SWAIT(); SWRITEA(1); __syncthreads();
  for (int j = 1; j + 1 < NT; j += 2) {
    SBAR(); qkt(pB0, pB1, K_lds + SHM_K, qr, Qs, r32, hi);
    finishSM(pA0, pA1, alA, l_reg, pa0, pa1, pa2, pa3); SBAR();
    SLOADA((j + 1) * KVBLK); SBAR();
    pv_d0(o, vb0, pa0, pa1, pa2, pa3); partialSM(pB0, pB1, m_reg, mnB, alB);
    __syncthreads(); SWAIT(); SWRITEA(0);
    RESC(alB); __syncthreads();
    SBAR(); qkt(pA0, pA1, K_lds, qr, Qs, r32, hi);
    finishSM(pB0, pB1, alB, l_reg, pa0, pa1, pa2, pa3); SBAR();
    SLOADA((j + 2) * KVBLK); SBAR();
    pv_d0(o, vb0 + SHM_V, pa0, pa1, pa2, pa3); partialSM(pA0, pA1, m_reg, mnA, alA);
    __syncthreads(); SWAIT(); SWRITEA(1);
    RESC(alA); __syncthreads();
  }
  SBAR(); qkt(pB0, pB1, K_lds + SHM_K, qr, Qs, r32, hi);
  finishSM(pA0, pA1, alA, l_reg, pa0, pa1, pa2, pa3); SBAR();
  pv_d0(o, vb0, pa0, pa1, pa2, pa3); partialSM(pB0, pB1, m_reg, mnB, alB);
  __syncthreads(); RESC(alB);
  finishSM(pB0, pB1, alB, l_reg, pa0, pa1, pa2, pa3); SBAR();
  pv_d0(o, vb0 + SHM_V, pa0, pa1, pa2, pa3);
  float rli[16];
#pragma unroll
  for (int r = 0; r < 16; ++r) rli[r] = __builtin_amdgcn_rcpf(__shfl(l_reg, crow(r, hi)));
  bf16_t* Ow = Ob + (long)(wid * QBLK) * LDO;
#pragma unroll
  for (int r = 0; r < 16; ++r) { int orow = crow(r, hi);
#pragma unroll
    for (int d0 = 0; d0 < 4; ++d0) Ow[(long)orow * LDO + d0 * 32 + r32] = (bf16_t)f2bf(o[d0][r] * rli[r]); }
  asm volatile("s_waitcnt vmcnt(0)" ::: "memory");
  __syncthreads();
#undef SLOADA
#undef SWRITEA
#undef SWAIT
#undef RESC
}
}

__device__ __forceinline__ int hgrn_chunk_row0(int dir, int b, int p) {
    if (p < 4) return ML + b * CTXL + 64 * (dir ? 3 - p : p);
    return b * SEQ + 64 * (dir ? 63 - (p - 4) : p - 4);
}
__device__ __forceinline__ void hgrn_cumsum(const _Float16* G, int k, int qd, int dir, float* qt, float (&gv)[16], float (&bl)[16], float& tot, float& bref) {
#pragma unroll
    for (int i = 0; i < 16; ++i) gv[i] = (float)G[(size_t)(16 * qd + i) * 512 + k];
    float run = 0.f;
    if (dir == 0) {
#pragma unroll
        for (int i = 0; i < 16; ++i) { run += gv[i]; bl[i] = run; }
    } else {
#pragma unroll
        for (int i = 15; i >= 0; --i) { run += gv[i]; bl[i] = run; }
    }
    qt[qd * 128 + k] = run;
    __syncthreads();
    const float q0 = qt[k], q1 = qt[128 + k], q2 = qt[256 + k], q3 = qt[384 + k];
    tot = (q0 + q1) + (q2 + q3);
    float off;
    if (dir == 0) { off = (qd > 0 ? q0 : 0.f) + (qd > 1 ? q1 : 0.f) + (qd > 2 ? q2 : 0.f); bref = q0 + q1; }
    else          { off = (qd < 3 ? q3 : 0.f) + (qd < 2 ? q2 : 0.f) + (qd < 1 ? q1 : 0.f); bref = q2 + q3; }
#pragma unroll
    for (int i = 0; i < 16; ++i) bl[i] += off;
}
__device__ __forceinline__ void hgrn_passA(const Args& a, char* lds, int item) {
    const int tid = threadIdx.x, wave = tid >> 6, lane = tid & 63, r32 = lane & 31, hi = lane >> 5;
    const int dir = item / (32 * NCH), rem = item % (32 * NCH), bh = rem / NCH, p = rem % NCH, b = bh >> 2, h = bh & 3;
#ifdef EXPR_SKIPCTX
    if (p < 4) return;
#endif
#ifdef EXPR_ONLYCTX
    if (p >= 4) return;
#endif
    const int row0 = hgrn_chunk_row0(dir, b, p);
    const _Float16* G = (const _Float16*)(a.ws + (dir ? WS_GB : WS_GF)) + (size_t)row0 * 512 + h * 128;
    const bf16_t* Vp = (const bf16_t*)(a.ws + WS_HI) + (size_t)row0 * 512 + h * 128;
    char* Kt = lds; char* Vt = lds + 128 * 144; float* qt = (float*)(lds + 2 * 128 * 144);
    const int k = tid & 127, qd = tid >> 7;
    float gv[16], bl[16], tot, bref;
    hgrn_cumsum(G, k, qd, dir, qt, gv, bl, tot, bref);
    unsigned kw[8], vw[8];
#pragma unroll
    for (int i = 0; i < 8; ++i) {
        const float k0 = (1.f - __expf(gv[2 * i])) * __expf(tot - bl[2 * i]), k1 = (1.f - __expf(gv[2 * i + 1])) * __expf(tot - bl[2 * i + 1]);
        kw[i] = pk2(k0, k1);
        vw[i] = (unsigned)Vp[(size_t)(16 * qd + 2 * i) * 512 + k] | ((unsigned)Vp[(size_t)(16 * qd + 2 * i + 1) * 512 + k] << 16);
    }
    *(u32x4*)(Kt + k * 144 + qd * 32) = (u32x4){kw[0], kw[1], kw[2], kw[3]}; *(u32x4*)(Kt + k * 144 + qd * 32 + 16) = (u32x4){kw[4], kw[5], kw[6], kw[7]};
    *(u32x4*)(Vt + k * 144 + qd * 32) = (u32x4){vw[0], vw[1], vw[2], vw[3]}; *(u32x4*)(Vt + k * 144 + qd * 32 + 16) = (u32x4){vw[4], vw[5], vw[6], vw[7]};
    const size_t slot = (size_t)(dir * 32 + bh) * NCH + p;
    if (qd == 0) ((float*)(a.ws + WS_DG))[slot * 128 + k] = __expf(tot);
    __syncthreads();
    const int kb = wave >> 1, vb0 = (wave & 1) * 2;
    f32x16 acc0 = {}, acc1 = {};
#pragma unroll
    for (int ks = 0; ks < 4; ++ks) {
        const bf16x8 af = *(const bf16x8*)(Kt + (32 * kb + r32) * 144 + ks * 32 + hi * 16);
        const bf16x8 b0 = *(const bf16x8*)(Vt + (32 * vb0 + r32) * 144 + ks * 32 + hi * 16);
        const bf16x8 b1 = *(const bf16x8*)(Vt + (32 * (vb0 + 1) + r32) * 144 + ks * 32 + hi * 16);
        acc0 = __builtin_amdgcn_mfma_f32_32x32x16_bf16(af, b0, acc0, 0, 0, 0);
        acc1 = __builtin_amdgcn_mfma_f32_32x32x16_bf16(af, b1, acc1, 0, 0, 0);
    }
    bf16_t* Lt = (bf16_t*)(a.ws + WS_A) + slot * 16384;
#pragma unroll
    for (int rg = 0; rg < 4; ++rg) {
        const int k4 = 32 * kb + 8 * rg + 4 * hi;
        u32x2 w0, w1; w0.x = pk2(acc0[4 * rg], acc0[4 * rg + 1]); w0.y = pk2(acc0[4 * rg + 2], acc0[4 * rg + 3]);
        w1.x = pk2(acc1[4 * rg], acc1[4 * rg + 1]); w1.y = pk2(acc1[4 * rg + 2], acc1[4 * rg + 3]);
#ifdef EXPT1
        w0.x = 0x3f803f80u; w0.y = 0x3f803f80u; w1.x = 0x3f803f80u; w1.y = 0x3f803f80u;
#endif
        *(u32x2*)(Lt + (size_t)(32 * vb0 + r32) * 128 + k4) = w0;
        *(u32x2*)(Lt + (size_t)(32 * (vb0 + 1) + r32) * 128 + k4) = w1;
    }
    __syncthreads();
}
__device__ __forceinline__ void hgrn_passB(const Args& a, int G) {
    bf16_t* LS = (bf16_t*)(a.ws + WS_A); const float* DG = (const float*)(a.ws + WS_DG);
    for (int it = blockIdx.x * 512 + threadIdx.x; it < 64 * 2048; it += G * 512) {
        const int dbh = it >> 11, e8 = it & 2047, k0 = (e8 & 15) * 8;
        bf16_t* base = LS + (size_t)dbh * NCH * 16384 + e8 * 8; const float* dp = DG + (size_t)dbh * NCH * 128 + k0;
        float S[8];
#pragma unroll
        for (int e = 0; e < 8; ++e) S[e] = 0.f;
#pragma unroll 4
        for (int p = 0; p < NCH; ++p) {
            const u32x4 L = *(const u32x4*)(base + (size_t)p * 16384);
            const f32x4 d0 = *(const f32x4*)(dp + p * 128), d1 = *(const f32x4*)(dp + p * 128 + 4);
            if (p >= 4) { u32x4 w; w.x = pk2(S[0], S[1]); w.y = pk2(S[2], S[3]); w.z = pk2(S[4], S[5]); w.w = pk2(S[6], S[7]); *(u32x4*)(base + (size_t)p * 16384) = w; }
            S[0] = d0.x * S[0] + bf2f(L.x & 0xffffu); S[1] = d0.y * S[1] + bf2f(L.x >> 16);
            S[2] = d0.z * S[2] + bf2f(L.y & 0xffffu); S[3] = d0.w * S[3] + bf2f(L.y >> 16);
            S[4] = d1.x * S[4] + bf2f(L.z & 0xffffu); S[5] = d1.y * S[5] + bf2f(L.z >> 16);
            S[6] = d1.z * S[6] + bf2f(L.w & 0xffffu); S[7] = d1.w * S[7] + bf2f(L.w >> 16);
        }
    }
}
__device__ __forceinline__ void hgrn_passC(const Args& a, char* lds, int item) {
    const int tid = threadIdx.x, wave = tid >> 6, lane = tid & 63, r32 = lane & 31, hi = lane >> 5;
    const int bh = item >> 6, lc = item & 63, b = bh >> 2, h = bh & 3;
    const int row0 = b * SEQ + 64 * lc;
    char* St = lds; char* Qd = lds + 34816; char* Qd2 = lds + 52224; char* Kd2 = lds + 69632; char* Vt = lds + 87040; char* Bs = lds + 105472;
    float* qt = (float*)(lds + 138240); float* brefs = (float*)(lds + 140288);
    const int k = tid & 127, qd = tid >> 7;
    {
        const bf16_t* Vp = (const bf16_t*)(a.ws + WS_HI) + (size_t)row0 * 512 + h * 128;
        unsigned vw[8];
#pragma unroll
        for (int i = 0; i < 8; ++i) vw[i] = (unsigned)Vp[(size_t)(16 * qd + 2 * i) * 512 + k] | ((unsigned)Vp[(size_t)(16 * qd + 2 * i + 1) * 512 + k] << 16);
        *(u32x4*)(Vt + k * 144 + qd * 32) = (u32x4){vw[0], vw[1], vw[2], vw[3]}; *(u32x4*)(Vt + k * 144 + qd * 32 + 16) = (u32x4){vw[4], vw[5], vw[6], vw[7]};
    }
    const int rb = wave >> 2, cb = wave & 3;
    f32x16 o = {};
#pragma unroll 1
    for (int dir = 0; dir < 2; ++dir) {
        const int p = dir ? 4 + 63 - lc : 4 + lc;
        const size_t slot = (size_t)(dir * 32 + bh) * NCH + p;
        {
            const u32x4* Sg = (const u32x4*)((const bf16_t*)(a.ws + WS_A) + slot * 16384);
#pragma unroll
            for (int i = 0; i < 4; ++i) { const int id = tid + 512 * i; *(u32x4*)(St + (id >> 4) * 272 + (id & 15) * 16) = Sg[id]; }
        }
        const _Float16* G = (const _Float16*)(a.ws + (dir ? WS_GB : WS_GF)) + (size_t)row0 * 512 + h * 128;
        {
            float gv[16], bl[16], tot, bref;
            hgrn_cumsum(G, k, qd, dir, qt, gv, bl, tot, bref);
#pragma unroll
            for (int i = 0; i < 16; ++i) ((float*)Bs)[(16 * qd + i) * 128 + k] = bl[i];
            if (qd == 0) brefs[k] = bref;
        }
        __syncthreads();
        {
            const int tok = tid >> 3, ks = (tid & 7) * 16;
            typedef _Float16 h8 __attribute__((ext_vector_type(8)));
            const h8 g0 = *(const h8*)(G + (size_t)tok * 512 + ks), g1 = *(const h8*)(G + (size_t)tok * 512 + ks + 8);
            const bf16_t* Qp = (const bf16_t*)(a.ws + WS_HQ) + (size_t)(row0 + tok) * 512 + h * 128 + ks;
            const u32x4 q0 = *(const u32x4*)Qp, q1 = *(const u32x4*)(Qp + 8);
            float qd_[16], qd2_[16], kd2_[16];
#pragma unroll
            for (int e = 0; e < 16; ++e) {
                const float g = e < 8 ? (float)g0[e & 7] : (float)g1[e & 7];
                const unsigned qw = e < 8 ? q0[(e & 7) >> 1] : q1[(e & 7) >> 1];
                const float q = bf2f((e & 1) ? (qw >> 16) : (qw & 0xffffu));
                const float bb = ((const float*)Bs)[tok * 128 + ks + e], d = bb - brefs[ks + e];
                qd_[e] = q * __expf(bb); qd2_[e] = q * __expf(d); kd2_[e] = (1.f - __expf(g)) * __expf(-d);
            }
#pragma unroll
            for (int hlf = 0; hlf < 2; ++hlf) {
                u32x4 w;
                w.x = pk2(qd_[8 * hlf + 0], qd_[8 * hlf + 1]); w.y = pk2(qd_[8 * hlf + 2], qd_[8 * hlf + 3]); w.z = pk2(qd_[8 * hlf + 4], qd_[8 * hlf + 5]); w.w = pk2(qd_[8 * hlf + 6], qd_[8 * hlf + 7]);
                *(u32x4*)(Qd + tok * 272 + ks * 2 + hlf * 16) = w;
                w.x = pk2(qd2_[8 * hlf + 0], qd2_[8 * hlf + 1]); w.y = pk2(qd2_[8 * hlf + 2], qd2_[8 * hlf + 3]); w.z = pk2(qd2_[8 * hlf + 4], qd2_[8 * hlf + 5]); w.w = pk2(qd2_[8 * hlf + 6], qd2_[8 * hlf + 7]);
                *(u32x4*)(Qd2 + tok * 272 + ks * 2 + hlf * 16) = w;
                w.x = pk2(kd2_[8 * hlf + 0], kd2_[8 * hlf + 1]); w.y = pk2(kd2_[8 * hlf + 2], kd2_[8 * hlf + 3]); w.z = pk2(kd2_[8 * hlf + 4], kd2_[8 * hlf + 5]); w.w = pk2(kd2_[8 * hlf + 6], kd2_[8 * hlf + 7]);
                *(u32x4*)(Kd2 + tok * 272 + ks * 2 + hlf * 16) = w;
            }
        }
        __syncthreads();
        const int tr = (wave & 3) >> 1, tc = wave & 1;
        f32x16 pacc = {};
#pragma unroll
        for (int kk = 0; kk < 8; ++kk) {
            const bf16x8 af = *(const bf16x8*)(Qd + (32 * rb + r32) * 272 + kk * 32 + hi * 16);
            const bf16x8 bf = *(const bf16x8*)(St + (32 * cb + r32) * 272 + kk * 32 + hi * 16);
            o = __builtin_amdgcn_mfma_f32_32x32x16_bf16(af, bf, o, 0, 0, 0);
            const bf16x8 a2 = *(const bf16x8*)(Qd2 + (32 * tr + r32) * 272 + kk * 32 + hi * 16);
            const bf16x8 b2 = *(const bf16x8*)(Kd2 + (32 * tc + r32) * 272 + kk * 32 + hi * 16);
            pacc = __builtin_amdgcn_mfma_f32_32x32x16_bf16(a2, b2, pacc, 0, 0, 0);
        }
        if (wave < 4) {
#pragma unroll
            for (int r = 0; r < 16; ++r) {
                const int t = 32 * tr + att::crow(r, hi), s = 32 * tc + r32;
                const bool keep = dir ? (s >= t) : (s <= t);
                *(bf16_t*)(Bs + t * 144 + s * 2) = (bf16_t)f2bf(keep ? pacc[r] : 0.f);
            }
        }
        __syncthreads();
#pragma unroll
        for (int ks = 0; ks < 4; ++ks) {
            const bf16x8 af = *(const bf16x8*)(Bs + (32 * rb + r32) * 144 + ks * 32 + hi * 16);
            const bf16x8 bf = *(const bf16x8*)(Vt + (32 * cb + r32) * 144 + ks * 32 + hi * 16);
            o = __builtin_amdgcn_mfma_f32_32x32x16_bf16(af, bf, o, 0, 0, 0);
        }
        __syncthreads();
    }
#pragma unroll
    for (int r = 0; r < 16; ++r) ((float*)Bs)[(32 * rb + att::crow(r, hi)) * 128 + 32 * cb + r32] = o[r];
    __syncthreads();
    {
        const int tok = tid >> 3, vs = (tid & 7) * 16;
        float ov[16]; float ss = 0.f;
#pragma unroll
        for (int e = 0; e < 16; ++e) { ov[e] = ((const float*)Bs)[tok * 128 + vs + e]; ss += ov[e] * ov[e]; }
        ss += __shfl_xor(ss, 1); ss += __shfl_xor(ss, 2); ss += __shfl_xor(ss, 4);
        const float rstd = rsqrtf(ss * (1.f / 128.f) + EPS);
        const bf16_t* Hg = (const bf16_t*)(a.ws + WS_HG) + (size_t)(row0 + tok) * 512 + h * 128 + vs;
        const u32x4 h0 = *(const u32x4*)Hg, h1 = *(const u32x4*)(Hg + 8);
        float res[16];
#pragma unroll
        for (int e = 0; e < 16; ++e) {
            const unsigned hw = e < 8 ? h0[(e & 7) >> 1] : h1[(e & 7) >> 1];
            const float hg = bf2f((e & 1) ? (hw >> 16) : (hw & 0xffffu));
            res[e] = ov[e] * rstd * a.g_on[vs + e] * (hg * sigmoidf_(hg));
        }
        bf16_t* Mx = (bf16_t*)(a.ws + WS_MIX) + (size_t)(row0 + tok) * 1024 + 512 + h * 128 + vs;
        u32x4 w;
        w.x = pk2(res[0], res[1]); w.y = pk2(res[2], res[3]); w.z = pk2(res[4], res[5]); w.w = pk2(res[6], res[7]); *(u32x4*)Mx = w;
        w.x = pk2(res[8], res[9]); w.y = pk2(res[10], res[11]); w.z = pk2(res[12], res[13]); w.w = pk2(res[14], res[15]); *(u32x4*)(Mx + 8) = w;
    }
    __syncthreads();
}

__global__ void __launch_bounds__(512, 2) fwd_megakernel(Args a) {
    extern __shared__ __attribute__((aligned(16))) unsigned char lds[];
    cg::grid_group grid = cg::this_grid();
    const int tid = threadIdx.x, wave = __builtin_amdgcn_readfirstlane(tid >> 6), lane = tid & 63;
    const int G = gridDim.x;
    unsigned char* ws = a.ws;
    LAS unsigned char* ldsl = (LAS unsigned char*)lds;
    char* ldsc = (char*)lds;
    const int lo = a.ph_lo, hi = a.ph_hi;
#ifndef SKIPMASK
#define SKIPMASK 0
#endif
#define IN(k) (!((SKIPMASK >> (k)) & 1) && lo <= (k) && (k) < hi)
#define SEAM(k) do { if (lo <= (k) && (k) + 1 < hi) { __builtin_amdgcn_fence(__ATOMIC_RELEASE, ""); grid.sync(); __builtin_amdgcn_fence(__ATOMIC_ACQUIRE, ""); } } while (0)
    float* MOD = (float*)(ws + WS_MOD);
    float* RSS = (float*)(ws + WS_RSSP);
    const float* RC = (const float*)(ws + WS_RCOS); const float* RS = (const float*)(ws + WS_RSIN);
    bf16_t* Hb = (bf16_t*)(ws + WS_A);
    bf16_t* Qb = (bf16_t*)a.out;
    bf16_t* Kb = (bf16_t*)((char*)a.out + 48 * MiB);
    bf16_t* Vb = (bf16_t*)(ws + WS_V);
    bf16_t* MIX = (bf16_t*)(ws + WS_MIX);
    const int gw = blockIdx.x * 8 + wave, NGW = G * 8;

    if (IN(0)) { p0_prologue(a, ldsc, G); }
    SEAM(0);
    if (IN(1)) {
        for (int r = gw; r < MT; r += NGW) {
            const bool lat = r < ML; const float* src = lat ? a.x + (size_t)r * 1024 : a.ctx + (size_t)(r - ML) * 1024;
            const float* md = MOD + (size_t)(lat ? (r >> 12) : 8) * 6144;
            row_norm_mod_bf16(src, a.g_mix, md, md + 1024, Hb + (size_t)r * 1024, lane);
        }
    }
#ifdef ZERO_MIX
    if (IN(1)) { u32x4* mz = (u32x4*)(ws + WS_MIX); const u32x4 z = {0u, 0u, 0u, 0u}; for (size_t i = (size_t)blockIdx.x * 512 + tid; i < (size_t)ML * 1024 * 2 / 16; i += (size_t)G * 512) mz[i] = z; }
#endif
    SEAM(1);
    if (IN(2)) {
        pg8::Gemm g{Hb, (const bf16_t*)(ws + WS_WIN), MT, NINP, 1024}; pg8::StaticOrder S; S.init(MT, NINP, G, (int)blockIdx.x);
        EpiInProj E{ws, Kb};
        pg8::gemm_phase<EpiInProj, pg8::StaticOrder, true, true>(ldsl, g, S, E);
    }
    SEAM(2);
    if (IN(3)) {
#ifndef SKIP3A
        { pg8::Gemm g{(const bf16_t*)(ws + WS_CQ), (const bf16_t*)(ws + WS_WUQ), ML, 768, 256}; pg8::StaticOrder S; S.init(ML, 768, G, (int)blockIdx.x);
          EpiQ E{Qb, RSS, RC, RS};
          pg8::gemm_phase<EpiQ, pg8::StaticOrder, true, true>(ldsl, g, S, E); }
#endif
#ifndef SKIP3B
        { pg8::Gemm g{(const bf16_t*)(ws + WS_CKV), (const bf16_t*)(ws + WS_WUKV), MT, 1024, 256}; pg8::StaticOrder S; S.init(MT, 1024, G, (int)blockIdx.x);
          EpiKV E{Kb, Vb, RSS};
          pg8::gemm_phase<EpiKV, pg8::StaticOrder, true, true>(ldsl, g, S, E); }
#endif
#ifndef SKIP3C
        for (int it = blockIdx.x; it < 2 * 32 * NCH; it += G) hgrn_passA(a, ldsc, it);
#endif
    }
#ifdef EXPJ
    if (IN(3)) {
        const u32x4* srcA = (const u32x4*)(ws + EXPJ_A); const u32x4* srcB = (const u32x4*)(ws + EXPJ_B); u32x4* dst = (u32x4*)MIX;
        for (size_t i = (size_t)blockIdx.x * 512 + tid; i < (size_t)ML * 64; i += (size_t)G * 512) { const size_t r = i >> 6, c = i & 63; dst[r * 128 + c] = srcA[r * 64 + c]; dst[r * 128 + 64 + c] = srcB[r * 64 + c]; }
    }
#endif
    SEAM(3);
    if (IN(4)) { hgrn_passB(a, G); }
    SEAM(4);
    if (IN(5)) {
#ifndef SKIP5A
        for (int u = blockIdx.x; u < 512; u += G) {
            int bh, qb;
            if (G == 256) { const int xcd = blockIdx.x & 7, cu = blockIdx.x >> 3, i = u >> 8; bh = xcd * 4 + i * 2 + (cu >> 4); qb = cu & 15; }
            else { bh = u >> 4; qb = u & 15; }
            const int b = bh >> 2, h = bh & 3;
            att::attn_body(Qb + ((size_t)bh * SEQ + qb * 256) * 192, Kb + (size_t)bh * KVL * 192, Vb + (size_t)bh * KVL * 128,
                           MIX + ((size_t)b * SEQ + qb * 256) * 1024 + h * 128, KVL, ldsc);
        }
#endif
#ifndef SKIP5B
        for (int it = blockIdx.x; it < 2048; it += G) hgrn_passC(a, ldsc, it);
#endif
    }
#ifdef EXPM
    if (IN(5)) { const u32x4* src = (const u32x4*)(ws + WS_A); u32x4* dst = (u32x4*)MIX;
        for (size_t i = (size_t)blockIdx.x * 512 + tid; i < (size_t)ML * 128; i += (size_t)G * 512) dst[i] = src[i]; }
#endif
    SEAM(5);
    if (IN(6)) {
        pg8::Gemm g{MIX, (const bf16_t*)(ws + WS_WOUT), ML, 1024, 1024}; pg8::StaticOrder S; S.init(ML, 1024, G, (int)blockIdx.x);
        EpiRes E{a.x, a.out, MOD + 2048};
        pg8::gemm_phase<EpiRes, pg8::StaticOrder, true, true>(ldsl, g, S, E);
    }
    SEAM(6);
    if (IN(7)) {
        for (int r = gw; r < ML; r += NGW) {
            const float* md = MOD + (size_t)(r >> 12) * 6144;
            row_norm_mod_bf16(a.out + (size_t)r * 1024, a.g_ffn, md + 3072, md + 4096, Hb + (size_t)r * 1024, lane);
        }
    }
    SEAM(7);
    if (IN(8)) {
        pg8::Gemm g{Hb, (const bf16_t*)(ws + WS_WGU), ML, 2 * DFF, 1024}; pg8::StaticOrder S; S.init(ML, 2 * DFF, G, (int)blockIdx.x);
        EpiSwiglu E{(bf16_t*)(ws + WS_ACT)};
        pg8::gemm_phase<EpiSwiglu, pg8::StaticOrder, true, true>(ldsl, g, S, E);
    }
    SEAM(8);
    if (IN(9)) {
        pg8::Gemm g{(const bf16_t*)(ws + WS_ACT), (const bf16_t*)(ws + WS_WDN), ML, 1024, DFF}; pg8::StaticOrder S; S.init(ML, 1024, G, (int)blockIdx.x);
        EpiRes E{a.out, a.out, MOD + 5120};
        pg8::gemm_phase<EpiRes, pg8::StaticOrder, true, true>(ldsl, g, S, E);
    }
    SEAM(9);
    if (IN(10)) {
        for (int r = gw; r < ML; r += NGW) row_norm_f32(a.out + (size_t)r * 1024, a.g_final, lane);
    }
#undef IN
#undef SEAM
}

#ifndef MK_PER_PHASE
#define MK_PER_PHASE 0
#endif
extern "C" void kernel_launch(void* const* d_in, const int* in_sizes, int n_in, void* d_out, int out_size, void* d_ws, size_t ws_size, hipStream_t stream) {
    static int grid = 0;
    if (grid == 0) {
        if (n_in != 21 || out_size != ML * DM || ws_size < WS_END) { fprintf(stderr, "kernel_launch: unexpected shapes (n_in %d out %d ws %zu)\n", n_in, out_size, ws_size); grid = -1; return; }
        int dev = 0, cus = 0, per_cu = 0;
        hipGetDevice(&dev); hipDeviceGetAttribute(&cus, hipDeviceAttributeMultiprocessorCount, dev);
        if (hipFuncSetAttribute((const void*)fwd_megakernel, hipFuncAttributeMaxDynamicSharedMemorySize, LDS_BYTES) != hipSuccess) { fprintf(stderr, "kernel_launch: hipFuncSetAttribute failed\n"); grid = -1; return; }
        if (hipOccupancyMaxActiveBlocksPerMultiprocessor(&per_cu, (const void*)fwd_megakernel, 512, LDS_BYTES) != hipSuccess || per_cu < 1) { fprintf(stderr, "kernel_launch: occupancy query says %d\n", per_cu); per_cu = 1; }
        (void)hipGetLastError();
        grid = cus * 1;
        fprintf(stderr, "kernel_launch: grid %d (per_cu %d)\n", grid, per_cu);
    }
    if (grid < 0) return;
    Args a{};
    const float** ap = (const float**)&a;
    for (int i = 0; i < 21; ++i) ap[i] = (const float*)d_in[i];
    a.out = (float*)d_out; a.ws = (unsigned char*)d_ws;
#if MK_PER_PHASE
    for (int ph = 0; ph < 11; ++ph) {
        a.ph_lo = ph; a.ph_hi = ph + 1;
        hipLaunchKernelGGL(fwd_megakernel, dim3(grid), dim3(512), LDS_BYTES, stream, a);
    }
#else
    a.ph_lo = 0; a.ph_hi = 11;
    void* args[] = {&a};
    hipError_t e = hipLaunchCooperativeKernel((const void*)fwd_megakernel, dim3(grid), dim3(512), args, LDS_BYTES, stream);
    if (e != hipSuccess) fprintf(stderr, "cooperative launch failed: %s (grid %d)\n", hipGetErrorString(e), grid);
#endif
}
```

```cpp
#include <hip/hip_runtime.h>
#include <hip/hip_cooperative_groups.h>
#include <hip/hip_bf16.h>
#include <cstdio>
#include <cstdint>
namespace cg = cooperative_groups;
namespace pg8 {
#define PG8_LAS __attribute__((address_space(3)))
typedef unsigned short bf16_t;
typedef short bf16x8 __attribute__((ext_vector_type(8)));
typedef float f32x4 __attribute__((ext_vector_type(4)));
typedef unsigned u32x4 __attribute__((ext_vector_type(4)));
constexpr int BM = 256, BK = 64, HALF = 128, HTB = HALF * BK * 2  , STAGE_BYTES = 8 * HTB, NXCD = 8, WGM = 8;

__host__ __device__ __forceinline__ int lds_byte(int r, int c) { const int st = (r >> 4) * 2 + (c >> 5), rr = r & 15, cc = c & 31, ob = rr * 64 + cc * 2; return st * 1024 + (ob ^ (((ob >> 9) & 1) << 5)); }
__host__ __device__ __forceinline__ void stage_rc(int b, int& R, int& C) { const int st = b / 1024, sb = b % 1024, swz = sb ^ (((sb >> 9) & 1) << 5); R = (st >> 1) * 16 + swz / 64; C = (st & 1) * 32 + (swz % 64) / 2; }
__host__ __device__ __forceinline__ int perm32(int rho) { const int n = rho >> 4, i = rho & 15; return 8 * (i >> 2) + 4 * n + (i & 3); }

struct Unit { int pm, pn; };
struct Gemm { const bf16_t* A; const bf16_t* Bt; int M, N, K; };

struct StaticOrder {
    int nM, nN, nwg, G, c;
    __host__ __device__ void init(int M, int N, int G_, int c_) { nM = M / BM; nN = N / BM; nwg = nM * nN; G = G_; c = c_; }
    __host__ __device__ bool next(int i, Unit& u) const {
        const long L = (long)i * G + c; if (L >= nwg) return false;
        int wgid = (int)L; { const int q = nwg / NXCD, r = nwg % NXCD, xcd = wgid % NXCD, off = wgid / NXCD; wgid = (xcd < r ? xcd * (q + 1) : r * (q + 1) + (xcd - r) * q) + off; }
        const int nig = WGM * nN, gid = wgid / nig, fm = gid * WGM, gsz = (nM - fm) < WGM ? (nM - fm) : WGM;
        u.pm = fm + ((wgid % nig) % gsz); u.pn = (wgid % nig) / gsz; return true;
    }
    __device__ __forceinline__ void a_ready(const Unit&) const {}
    __device__ __forceinline__ void done(const Unit&) const {}
};

__device__ __forceinline__ unsigned cvt_pk_bf16(float lo, float hi) { unsigned r; asm volatile("v_cvt_pk_bf16_f32 %0, %1, %2" : "=v"(r) : "v"(lo), "v"(hi)); return r; }
typedef float f32x2 __attribute__((ext_vector_type(2)));
template <class Epi, class Sched, bool ALIGN_EPI = false, bool SP2 = false>
__device__ __forceinline__ void gemm_phase(PG8_LAS unsigned char* lds, const Gemm g, const Sched& S, const Epi& E) {
    const int tid = threadIdx.x, wid = __builtin_amdgcn_readfirstlane(tid >> 6), lane = tid & 63, wr = wid >> 2, wc = wid & 3, fr = lane & 15, fq = lane >> 4;
    const int K = g.K, nt = K / BK;
    unsigned voffA[2], voffB[2];
#pragma unroll
    for (int i = 0; i < 2; ++i) { int R, C; stage_rc(tid * 16 + i * 8192, R, C); const int Rb = Epi::PERM ? ((R & ~31) + perm32(R & 31)) : R;
        voffA[i] = (unsigned)(R * K + C) * 2u; voffB[i] = (unsigned)(Rb * K + C) * 2u; }
    const size_t kstep = (size_t)(BK * 2);
    const size_t hstep = (size_t)HALF * K * 2;
    const size_t tstep = 2 * hstep;
    const unsigned ldsw = (unsigned)wid * 1024u;
    const int aoff = lds_byte(wr * 64 + fr, fq * 8), boff = lds_byte(wc * 32 + fr, fq * 8);
#define PG8_SA(b, h) (((b) * 2 + (h)) * HTB)
#define PG8_SB(b, h) ((4 + (b) * 2 + (h)) * HTB)
#define PG8_STAGE(bufoff, gbase, voff) do { _Pragma("unroll") for (int _i = 0; _i < 2; ++_i) \
        __builtin_amdgcn_global_load_lds((const unsigned*)((const char*)(gbase) + (voff)[_i]), (PG8_LAS unsigned*)(lds + (bufoff) + ldsw + _i * 8192), 16, 0, 0); } while (0)
#define PG8_LDA(dst, b, h) do { _Pragma("unroll") for (int m = 0; m < 4; ++m) _Pragma("unroll") for (int k = 0; k < 2; ++k) dst[m][k] = *(const PG8_LAS bf16x8*)(lds + PG8_SA(b, h) + aoff + m * 2048 + k * 1024); } while (0)
#define PG8_LDB(dst, b, h) do { _Pragma("unroll") for (int n = 0; n < 2; ++n) _Pragma("unroll") for (int k = 0; k < 2; ++k) dst[n][k] = *(const PG8_LAS bf16x8*)(lds + PG8_SB(b, h) + boff + n * 2048 + k * 1024); } while (0)
#define PG8_MMA(ai, bj, At, Bt) do { __builtin_amdgcn_s_setprio(1); _Pragma("unroll") for (int m = 0; m < 4; ++m) _Pragma("unroll") for (int n = 0; n < 2; ++n) _Pragma("unroll") for (int k = 0; k < 2; ++k) \
        acc[ai][bj][m][n] = __builtin_amdgcn_mfma_f32_16x16x32_bf16(Bt[n][k], At[m][k], acc[ai][bj][m][n], 0, 0, 0); __builtin_amdgcn_s_setprio(0); } while (0)
#define PG8_WAIT_V(n) asm volatile("s_waitcnt vmcnt(" #n ")" ::: "memory")
#define PG8_WAIT_L(n) asm volatile("s_waitcnt lgkmcnt(" #n ")" ::: "memory")
#define PG8_BAR __builtin_amdgcn_s_barrier()
#define PG8_SCHED __builtin_amdgcn_sched_barrier(0)
    Unit cur, nxt; int ui = 0;
    if (!S.next(0, cur)) return;
    f32x4 acc[2][2][4][2];
#pragma unroll
    for (int a = 0; a < 2; ++a)
#pragma unroll
        for (int b = 0; b < 2; ++b)
#pragma unroll
            for (int m = 0; m < 4; ++m)
#pragma unroll
                for (int n = 0; n < 2; ++n) acc[a][b][m][n] = (f32x4){0.f, 0.f, 0.f, 0.f};
    bf16x8 At[4][2], B0[2][2], B1[2][2];
    const char* cA = (const char*)g.A + (size_t)cur.pm * tstep; const char* cB = (const char*)g.Bt + (size_t)cur.pn * tstep;
    S.a_ready(cur);
    if constexpr (SP2) {
        PG8_STAGE(PG8_SB(0, 0), cB, voffB); PG8_STAGE(PG8_SB(0, 1), cB + hstep, voffB); PG8_STAGE(PG8_SA(0, 0), cA, voffA); PG8_STAGE(PG8_SA(0, 1), cA + hstep, voffA);
        if (wr == 1) PG8_BAR;
        PG8_WAIT_V(2); PG8_BAR;
        PG8_STAGE(PG8_SB(1, 0), cB + kstep, voffB); PG8_STAGE(PG8_SA(1, 0), cA + kstep, voffA); PG8_STAGE(PG8_SB(1, 1), cB + hstep + kstep, voffB);
        PG8_WAIT_V(6); PG8_BAR;
    } else {
        PG8_STAGE(PG8_SB(0, 0), cB, voffB); PG8_STAGE(PG8_SA(0, 0), cA, voffA); PG8_STAGE(PG8_SB(0, 1), cB + hstep, voffB); PG8_STAGE(PG8_SA(0, 1), cA + hstep, voffA);
        if (wr == 1) PG8_BAR;
        PG8_WAIT_V(4); PG8_BAR;
        PG8_STAGE(PG8_SB(1, 0), cB + kstep, voffB); PG8_STAGE(PG8_SA(1, 0), cA + kstep, voffA); PG8_STAGE(PG8_SB(1, 1), cB + hstep + kstep, voffB);
        PG8_WAIT_V(6); PG8_BAR;
    }
    for (;;) {
        const bool has_next = S.next(ui + 1, nxt);
        const char* nA = has_next ? (const char*)g.A + (size_t)nxt.pm * tstep : cA; const char* nB = has_next ? (const char*)g.Bt + (size_t)nxt.pn * tstep : cB;
#pragma unroll 1
        for (int t = 0; t < nt; t += 2) {
            const bool last = (t == nt - 2);
            const char* a1 = cA + (size_t)(t + 1) * kstep;
            const char* a2 = last ? nA : cA + (size_t)(t + 2) * kstep; const char* b2 = last ? nB : cB + (size_t)(t + 2) * kstep;
            const char* a3 = a2 + kstep; const char* b3 = b2 + kstep;
            if (last && has_next) S.a_ready(nxt);
            if constexpr (SP2) {
            PG8_LDB(B0, 0, 0); PG8_LDB(B1, 0, 1); PG8_SCHED; PG8_LDA(At, 0, 0); PG8_STAGE(PG8_SA(1, 1), a1 + hstep, voffA);
            PG8_WAIT_V(8); PG8_WAIT_L(0); PG8_BAR; PG8_MMA(0, 0, At, B0); PG8_MMA(0, 1, At, B1); PG8_BAR; PG8_SCHED;
            PG8_LDA(At, 0, 1); PG8_STAGE(PG8_SB(0, 0), b2, voffB); PG8_STAGE(PG8_SB(0, 1), b2 + hstep, voffB); PG8_STAGE(PG8_SA(0, 0), a2, voffA);
            PG8_WAIT_V(8); PG8_WAIT_L(0); PG8_BAR; PG8_MMA(1, 0, At, B0); PG8_MMA(1, 1, At, B1); PG8_BAR; PG8_SCHED;
            PG8_LDB(B0, 1, 0); PG8_LDB(B1, 1, 1); PG8_SCHED; PG8_LDA(At, 1, 0); PG8_STAGE(PG8_SA(0, 1), a2 + hstep, voffA);
            PG8_WAIT_V(8); PG8_WAIT_L(0); PG8_BAR; PG8_MMA(0, 0, At, B0); PG8_MMA(0, 1, At, B1); PG8_BAR; PG8_SCHED;
            PG8_LDA(At, 1, 1); PG8_STAGE(PG8_SB(1, 0), b3, voffB); PG8_STAGE(PG8_SB(1, 1), b3 + hstep, voffB); PG8_STAGE(PG8_SA(1, 0), a3, voffA);
            PG8_WAIT_V(8); PG8_WAIT_L(0); PG8_BAR; PG8_MMA(1, 0, At, B0); PG8_MMA(1, 1, At, B1); PG8_BAR; PG8_SCHED;
            } else {
            PG8_LDB(B0, 0, 0); PG8_SCHED; PG8_LDA(At, 0, 0); PG8_STAGE(PG8_SA(1, 1), a1 + hstep, voffA);
            PG8_WAIT_L(8); PG8_BAR; PG8_WAIT_L(0); PG8_MMA(0, 0, At, B0); PG8_BAR; PG8_SCHED;
            PG8_LDB(B1, 0, 1); PG8_STAGE(PG8_SB(0, 0), b2, voffB);
            PG8_BAR; PG8_WAIT_L(0); PG8_MMA(0, 1, At, B1); PG8_BAR;
            PG8_LDA(At, 0, 1); PG8_STAGE(PG8_SA(0, 0), a2, voffA);
            PG8_BAR; PG8_WAIT_L(0); PG8_MMA(1, 0, At, B0); PG8_BAR; PG8_SCHED;
            PG8_STAGE(PG8_SB(0, 1), b2 + hstep, voffB);
            PG8_WAIT_V(6); PG8_BAR; PG8_MMA(1, 1, At, B1); PG8_BAR;
            PG8_LDB(B0, 1, 0); PG8_SCHED; PG8_LDA(At, 1, 0); PG8_STAGE(PG8_SA(0, 1), a2 + hstep, voffA);
            PG8_WAIT_L(8); PG8_BAR; PG8_WAIT_L(0); PG8_MMA(0, 0, At, B0); PG8_BAR; PG8_SCHED;
            PG8_LDB(B1, 1, 1); PG8_STAGE(PG8_SB(1, 0), b3, voffB);
            PG8_BAR; PG8_WAIT_L(0); PG8_MMA(0, 1, At, B1); PG8_BAR;
            PG8_LDA(At, 1, 1); PG8_STAGE(PG8_SA(1, 0), a3, voffA);
            PG8_BAR; PG8_WAIT_L(0); PG8_MMA(1, 0, At, B0); PG8_BAR; PG8_SCHED;
            PG8_STAGE(PG8_SB(1, 1), b3 + hstep, voffB);
            PG8_WAIT_V(6); PG8_BAR; PG8_MMA(1, 1, At, B1); PG8_BAR;
            }
        }
        if constexpr (ALIGN_EPI) { if (wr == 0) PG8_BAR; }
        if constexpr (!Epi::AFTER_DRAIN) { E(acc, cur, wr, wc, fr, fq); S.done(cur); }
        if (!has_next) break;
#pragma unroll
        for (int a = 0; a < 2; ++a)
#pragma unroll
            for (int b = 0; b < 2; ++b)
#pragma unroll
                for (int m = 0; m < 4; ++m)
#pragma unroll
                    for (int n = 0; n < 2; ++n) acc[a][b][m][n] = (f32x4){0.f, 0.f, 0.f, 0.f};
        cur = nxt; cA = nA; cB = nB; ++ui;
        if constexpr (ALIGN_EPI) { if (wr == 1) PG8_BAR; }
    }
    PG8_WAIT_V(0);
    if constexpr (!ALIGN_EPI) { if (wr == 0) PG8_BAR; }
    PG8_BAR;
    if constexpr (Epi::AFTER_DRAIN) { E.fused(acc, cur, wr, wc, fr, fq, lds, wid, lane); S.done(cur); }
#undef PG8_SA
#undef PG8_SB
#undef PG8_STAGE
#undef PG8_LDA
#undef PG8_LDB
#undef PG8_MMA
#undef PG8_WAIT_V
#undef PG8_WAIT_L
#undef PG8_BAR
#undef PG8_SCHED
}
}

#define LAS __attribute__((address_space(3)))
typedef unsigned short bf16_t;
typedef short bf16x8 __attribute__((ext_vector_type(8)));
typedef short s16x4 __attribute__((ext_vector_type(4)));
typedef float f32x4 __attribute__((ext_vector_type(4)));
typedef float f32x16 __attribute__((ext_vector_type(16)));
typedef unsigned u32x4 __attribute__((ext_vector_type(4)));
typedef unsigned u32x2 __attribute__((ext_vector_type(2)));

constexpr int NB = 8, SEQ = 4096, DM = 1024, CTXL = 256;
constexpr int ML = NB * SEQ, MC = NB * CTXL, MT = ML + MC;
constexpr int NIN = 3136, NINP = 3328, DFF = 2816, KVL = CTXL + SEQ;
constexpr int NCH = 68;
constexpr float EPS = 1e-6f;
constexpr size_t MiB = 1u << 20;
constexpr size_t WS_MOD = 0, WS_LBF = 256 * 1024, WS_LBB = 258 * 1024, WS_RCOS = 260 * 1024, WS_RSIN = 264 * 1024, WS_ROWSS = 512 * 1024;
constexpr size_t WS_WIN = 1 * MiB, WS_WUQ = 8 * MiB, WS_WUKV = 8 * MiB + 512 * 1024, WS_WOUT = 9 * MiB, WS_WGU = 11 * MiB, WS_WDN = 22 * MiB, WS_DG = 28 * MiB;
constexpr size_t WS_A = 32 * MiB;
constexpr size_t WS_CQ = 169 * MiB, WS_CKV = 186 * MiB, WS_HQ = 203 * MiB, WS_HI = 237 * MiB, WS_HG = 271 * MiB, WS_GF = 305 * MiB, WS_GB = 339 * MiB;
constexpr size_t WS_V = 373 * MiB, WS_MIX = 407 * MiB, WS_ACT = 169 * MiB, WS_RSSP = 471 * MiB, WS_END = 476 * MiB;
constexpr int LDS_BYTES = 147456;

__device__ __forceinline__ unsigned f2bf(float f) { unsigned u = __builtin_bit_cast(unsigned, f); return (u + 0x7fffu + ((u >> 16) & 1u)) >> 16; }
__device__ __forceinline__ float bf2f(unsigned h) { return __builtin_bit_cast(float, h << 16); }
typedef __bf16 bf16v2_t __attribute__((ext_vector_type(2)));
__device__ __forceinline__ unsigned pk2(float lo, float hi) { bf16v2_t v; v.x = (__bf16)lo; v.y = (__bf16)hi; return __builtin_bit_cast(unsigned, v); }
__device__ __forceinline__ float wave_sum(float v) {
#pragma unroll
    for (int o = 1; o < 64; o <<= 1) v += __shfl_xor(v, o);
    return v;
}
__device__ __forceinline__ float sigmoidf_(float x) { return 1.f / (1.f + __expf(-x)); }
#define LDS_WAIT() asm volatile("s_waitcnt lgkmcnt(0)" ::: "memory")

struct Args {
    const float *x, *c, *ctx, *c_ctx, *w_mod, *b_mod, *g_mix, *g_ffn, *w_in, *g_qn, *w_uq, *g_kvn, *w_ukv, *lb_fwd, *lb_bwd, *g_on, *w_out, *w_gate, *w_up, *w_down, *g_final;
    float* out; unsigned char* ws; int ph_lo, ph_hi;
};

__device__ __forceinline__ void p0_mod_item(const Args& a, char* ldsc, int item) {
    float* sl = (float*)ldsc;
    float* red = sl + 9216;
    const int tid = threadIdx.x, wave = tid >> 6, lane = tid & 63;
    for (int i = tid; i < 9216; i += 512) { const float v = (i < 8192) ? a.c[i] : a.c_ctx[i - 8192]; sl[i] = v * sigmoidf_(v); }
    __syncthreads();
    float acc[9];
#pragma unroll
    for (int r = 0; r < 9; ++r) acc[r] = 0.f;
    const float* wp = a.w_mod + (size_t)(wave * 128) * 6144 + item * 64 + lane;
#pragma unroll 4
    for (int k = 0; k < 128; ++k) {
        const float w = wp[(size_t)k * 6144];
#pragma unroll
        for (int r = 0; r < 9; ++r) acc[r] += sl[r * 1024 + wave * 128 + k] * w;
    }
#pragma unroll
    for (int r = 0; r < 9; ++r) red[(wave * 9 + r) * 64 + lane] = acc[r];
    __syncthreads();
    float* MOD = (float*)(a.ws + WS_MOD);
    for (int i = tid; i < 576; i += 512) {
        const int r = i >> 6, l = i & 63; float s = 0.f;
#pragma unroll
        for (int w = 0; w < 8; ++w) s += red[(w * 9 + r) * 64 + l];
        MOD[r * 6144 + item * 64 + l] = s + a.b_mod[item * 64 + l];
    }
    __syncthreads();
}
__device__ __forceinline__ void p0_transpose_item(const float* W, int N, bf16_t* WT, int Kd, int drow0, const float* kscale, float* scr, int k0, int n0, int lane) {
#pragma unroll 8
    for (int i = 0; i < 32; ++i) { const int kk = 2 * i + (lane >> 5); float v = W[(size_t)(k0 + kk) * N + n0 + (lane & 31)]; if (kscale) v *= kscale[k0 + kk]; scr[kk * 33 + (lane & 31)] = v; }
    LDS_WAIT(); asm volatile("" ::: "memory");
    const int c = lane & 7;
#pragma unroll
    for (int j = 0; j < 4; ++j) { const int n = (lane >> 3) + 8 * j; const float* s = scr + (8 * c) * 33 + n;
        u32x4 o; o.x = pk2(s[0 * 33], s[1 * 33]); o.y = pk2(s[2 * 33], s[3 * 33]); o.z = pk2(s[4 * 33], s[5 * 33]); o.w = pk2(s[6 * 33], s[7 * 33]);
        *(u32x4*)(WT + (size_t)(drow0 + n) * Kd + k0 + 8 * c) = o; }
    LDS_WAIT(); asm volatile("" ::: "memory");
}
__device__ __forceinline__ void p0_prologue(const Args& a, char* ldsc, int G) {
    const int tid = threadIdx.x, wave = tid >> 6, lane = tid & 63;
    unsigned char* ws = a.ws;
    if (blockIdx.x < 96) p0_mod_item(a, ldsc, blockIdx.x);
    if ((int)blockIdx.x == G - 1) {
        float* LBF = (float*)(ws + WS_LBF); float* LBB = (float*)(ws + WS_LBB);
        LBF[tid] = 1.f / (1.f + __expf(a.lb_fwd[512 + tid] - a.lb_fwd[tid]));
        LBB[tid] = 1.f / (1.f + __expf(a.lb_bwd[512 + tid] - a.lb_bwd[tid]));
        float* RC = (float*)(ws + WS_RCOS); float* RS = (float*)(ws + WS_RSIN);
        for (int i = tid; i < 1024; i += 512) {
            const int pos = i >> 4, fi = i & 15;
            const float inv = exp2f(-(float)fi * (13.287712379549449f / 16.f));
            const float ang = (float)pos * inv;
            const float kq = rintf(ang * 0.15915494309189535f);
            float r = fmaf(-kq, 6.28125f, ang); r = fmaf(-kq, 0.0019353071795864769f, r);
            RC[i] = __cosf(r); RS[i] = __sinf(r);
        }
    }
    { u32x4* pz = (u32x4*)(ws + WS_WIN + (size_t)NIN * 1024 * 2); const u32x4 z = {0u, 0u, 0u, 0u};
      for (int i = blockIdx.x * 512 + tid; i < (NINP - NIN) * 1024 * 2 / 16; i += G * 512) pz[i] = z; }
    float* scr = (float*)(ldsc + wave * 16384);
    const int gw = blockIdx.x * 8 + wave, NGW = G * 8;
    constexpr int I_IN = 16 * 98, I_UQ = 4 * 24, I_UKV = 4 * 32, I_OUT = 16 * 32, I_G = 16 * 88, I_DN = 44 * 32;
    constexpr int NITEMS = I_IN + I_UQ + I_UKV + I_OUT + 2 * I_G + I_DN;
    for (int it = gw; it < NITEMS; it += NGW) {
        int r = it;
        if (r < I_IN) { const int kb = r / 98, nb = r % 98; p0_transpose_item(a.w_in, NIN, (bf16_t*)(ws + WS_WIN), 1024, 32 * nb, nullptr, scr, 64 * kb, 32 * nb, lane); continue; } r -= I_IN;
        if (r < I_UQ) { const int kb = r / 24, nb = r % 24; p0_transpose_item(a.w_uq, 768, (bf16_t*)(ws + WS_WUQ), 256, 32 * nb, a.g_qn, scr, 64 * kb, 32 * nb, lane); continue; } r -= I_UQ;
        if (r < I_UKV) { const int kb = r / 32, nb = r % 32; p0_transpose_item(a.w_ukv, 1024, (bf16_t*)(ws + WS_WUKV), 256, 32 * nb, a.g_kvn, scr, 64 * kb, 32 * nb, lane); continue; } r -= I_UKV;
        if (r < I_OUT) { const int kb = r / 32, nb = r % 32; p0_transpose_item(a.w_out, 1024, (bf16_t*)(ws + WS_WOUT), 1024, 32 * nb, nullptr, scr, 64 * kb, 32 * nb, lane); continue; } r -= I_OUT;
        if (r < 2 * I_G) { const int up = r >= I_G; if (up) r -= I_G; const int kb = r / 88, nb = r % 88, n0 = 32 * nb;
            const int drow = (n0 >> 7) * 256 + (n0 & 127) + (up ? 128 : 0);
            p0_transpose_item(up ? a.w_up : a.w_gate, DFF, (bf16_t*)(ws + WS_WGU), 1024, drow, nullptr, scr, 64 * kb, n0, lane); continue; } r -= 2 * I_G;
        { const int kb = r / 32, nb = r % 32; p0_transpose_item(a.w_down, 1024, (bf16_t*)(ws + WS_WDN), DFF, 32 * nb, nullptr, scr, 64 * kb, 32 * nb, lane); }
    }
}

__device__ __forceinline__ void row_norm_mod_bf16(const float* src, const float* g, const float* sh, const float* sc, bf16_t* dst, int lane) {
    const f32x4* xr = (const f32x4*)src + lane;
    f32x4 v[4]; float s = 0.f;
#pragma unroll
    for (int j = 0; j < 4; ++j) { v[j] = xr[64 * j]; s += (v[j].x * v[j].x + v[j].y * v[j].y) + (v[j].z * v[j].z + v[j].w * v[j].w); }
    const float rstd = rsqrtf(wave_sum(s) * (1.f / 1024.f) + EPS);
    u32x2* o8 = (u32x2*)dst + lane;
#pragma unroll
    for (int j = 0; j < 4; ++j) {
        const f32x4 gg = ((const f32x4*)g)[lane + 64 * j], s1 = ((const f32x4*)sc)[lane + 64 * j], s0 = ((const f32x4*)sh)[lane + 64 * j];
        const f32x4 y = v[j] * rstd * gg * (s1 + 1.f) + s0;
        u32x2 w; w.x = pk2(y.x, y.y); w.y = pk2(y.z, y.w); o8[64 * j] = w;
    }
}
__device__ __forceinline__ void row_norm_f32(float* row, const float* g, int lane) {
    f32x4* xr = (f32x4*)row + lane;
    f32x4 v[4]; float s = 0.f;
#pragma unroll
    for (int j = 0; j < 4; ++j) { v[j] = xr[64 * j]; s += (v[j].x * v[j].x + v[j].y * v[j].y) + (v[j].z * v[j].z + v[j].w * v[j].w); }
    const float rstd = rsqrtf(wave_sum(s) * (1.f / 1024.f) + EPS);
#pragma unroll
    for (int j = 0; j < 4; ++j) { f32x4 o = v[j] * rstd * ((const f32x4*)g)[lane + 64 * j];
#ifdef SANITIZE
        o.x = __builtin_isfinite(o.x) ? o.x : 1000.f; o.y = __builtin_isfinite(o.y) ? o.y : 1000.f; o.z = __builtin_isfinite(o.z) ? o.z : 1000.f; o.w = __builtin_isfinite(o.w) ? o.w : 1000.f;
#endif
        xr[64 * j] = o; }
}

__device__ __forceinline__ void rope8(float (&v)[8], int fq, const float* rc, const float* rs, int pos, bool apply) {
    const int ib = pos * 16 + 8 * (fq & 1);
#pragma unroll
    for (int e = 0; e < 8; ++e) {
        const float partner = __shfl_xor(v[e], 32);
        const float cs = rc[ib + e], sn = rs[ib + e];
        const float r = (fq < 2) ? (v[e] * cs - partner * sn) : (v[e] * cs + partner * sn);
        v[e] = apply ? r : v[e];
    }
}
__device__ __forceinline__ u32x4 pack8(const float (&v)[8]) { u32x4 w; w.x = pk2(v[0], v[1]); w.y = pk2(v[2], v[3]); w.z = pk2(v[4], v[5]); w.w = pk2(v[6], v[7]); return w; }

struct EpiInProj {
    static constexpr bool PERM = true, AFTER_DRAIN = false;
    unsigned char* ws; bf16_t* Kb;
    __device__ __forceinline__ void operator()(const pg8::f32x4 (&acc)[2][2][4][2], const pg8::Unit& u, int wr, int wc, int fr, int fq) const {
        float* RSS = (float*)(ws + WS_RSSP); const float* RC = (const float*)(ws + WS_RCOS); const float* RS = (const float*)(ws + WS_RSIN);
#pragma unroll
        for (int bj = 0; bj < 2; ++bj) {
            const int cbase = u.pn * 256 + bj * 128 + wc * 32;
            if (cbase >= NIN) continue;
            const int c0 = cbase + 8 * fq;
#pragma unroll
            for (int ai = 0; ai < 2; ++ai)
#pragma unroll
                for (int m = 0; m < 4; ++m) {
                    const int row = u.pm * 256 + ai * 128 + wr * 64 + m * 16 + fr;
                    float v[8];
#pragma unroll
                    for (int e = 0; e < 4; ++e) { v[e] = acc[ai][bj][m][0][e]; v[4 + e] = acc[ai][bj][m][1][e]; }
                    if (cbase < 512) {
                        bf16_t* dst = (bf16_t*)(ws + WS_CQ + (cbase < 256 ? (size_t)0 : (WS_CKV - WS_CQ))) + (size_t)row * 256 + (c0 & 255);
                        *(u32x4*)dst = pack8(v);
                        float ss = 0.f;
#pragma unroll
                        for (int e = 0; e < 8; ++e) ss += v[e] * v[e];
                        ss += __shfl_xor(ss, 16); ss += __shfl_xor(ss, 32);
                        if (fq == 0) RSS[((size_t)row * 2 + (cbase < 256 ? 0 : 1)) * 8 + bj * 4 + wc] = ss;
                    } else if (cbase < 576) {
                        const int axis = (cbase - 512) >> 5;
                        const bool lat = row < ML;
                        const int n = row & 4095;
                        const int pos = axis ? (n & 63) : (n >> 6);
                        rope8(v, fq, RC, RS, lat ? pos : 0, lat);
                        const int b = lat ? (row >> 12) : ((row - ML) >> 8);
                        const int kvpos = lat ? (CTXL + n) : ((row - ML) & 255);
                        const u32x4 w = pack8(v);
#pragma unroll
                        for (int h = 0; h < 4; ++h) *(u32x4*)(Kb + ((size_t)(b * 4 + h) * KVL + kvpos) * 192 + 128 + axis * 32 + 8 * fq) = w;
                    } else if (cbase < 2112) {
                        const int seg = (cbase - 576) >> 9;
                        bf16_t* base = (bf16_t*)(ws + WS_HQ + (size_t)seg * (WS_HI - WS_HQ));
                        *(u32x4*)(base + (size_t)row * 512 + (c0 - 576 - seg * 512)) = pack8(v);
                    } else {
                        const int dirn = (cbase - 2112) >> 9, j = c0 - 2112 - dirn * 512;
                        const float* lbp = (const float*)(ws + WS_LBF + (size_t)dirn * (WS_LBB - WS_LBF)) + j;
                        typedef _Float16 h8 __attribute__((ext_vector_type(8)));
                        h8 o;
#pragma unroll
                        for (int e = 0; e < 8; ++e) { const float lb = lbp[e]; const float f = lb + (1.f - lb) * sigmoidf_(v[e]); o[e] = (_Float16)__logf(f); }
                        *(h8*)((_Float16*)(ws + WS_GF + (size_t)dirn * (WS_GB - WS_GF)) + (size_t)row * 512 + j) = o;
                    }
                }
        }
    }
};
struct EpiQ {
    static constexpr bool PERM = true, AFTER_DRAIN = false;
    bf16_t* Q; const float* RSS; const float *RC, *RS;
    __device__ __forceinline__ void operator()(const pg8::f32x4 (&acc)[2][2][4][2], const pg8::Unit& u, int wr, int wc, int fr, int fq) const {
#pragma unroll
        for (int bj = 0; bj < 2; ++bj) {
            const int cbase = u.pn * 256 + bj * 128 + wc * 32;
            const int h = cbase / 192, d0 = cbase - h * 192;
            const bool rope = d0 >= 128; const int axis = (d0 - 128) >> 5;
#pragma unroll
            for (int ai = 0; ai < 2; ++ai)
#pragma unroll
                for (int m = 0; m < 4; ++m) {
                    const int row = u.pm * 256 + ai * 128 + wr * 64 + m * 16 + fr;
                    const f32x4 s0 = *(const f32x4*)(RSS + (size_t)row * 16), s1 = *(const f32x4*)(RSS + (size_t)row * 16 + 4);
                    const float rstd = rsqrtf((((s0.x + s0.y) + (s0.z + s0.w)) + ((s1.x + s1.y) + (s1.z + s1.w))) * (1.f / 256.f) + EPS);
                    float v[8];
#pragma unroll
                    for (int e = 0; e < 4; ++e) { v[e] = acc[ai][bj][m][0][e] * rstd; v[4 + e] = acc[ai][bj][m][1][e] * rstd; }
                    const int b = row >> 12, n = row & 4095;
                    if (rope) { const int pos = axis ? (n & 63) : (n >> 6); rope8(v, fq, RC, RS, pos, true); }
                    *(u32x4*)(Q + ((size_t)(b * 4 + h) * SEQ + n) * 192 + d0 + 8 * fq) = pack8(v);
                    asm volatile("" ::: "memory");
                }
        }
    }
};
struct EpiKV {
    static constexpr bool PERM = true, AFTER_DRAIN = false;
    bf16_t *Kb, *Vb; const float* RSS;
    __device__ __forceinline__ void operator()(const pg8::f32x4 (&acc)[2][2][4][2], const pg8::Unit& u, int wr, int wc, int fr, int fq) const {
#pragma unroll
        for (int bj = 0; bj < 2; ++bj) {
            const int cbase = u.pn * 256 + bj * 128 + wc * 32;
            const int h = cbase >> 8, j0 = cbase & 255;
#pragma unroll
            for (int ai = 0; ai < 2; ++ai)
#pragma unroll
                for (int m = 0; m < 4; ++m) {
                    const int row = u.pm * 256 + ai * 128 + wr * 64 + m * 16 + fr;
                    const f32x4 s0 = *(const f32x4*)(RSS + (size_t)row * 16 + 8), s1 = *(const f32x4*)(RSS + (size_t)row * 16 + 12);
                    const float rstd = rsqrtf((((s0.x + s0.y) + (s0.z + s0.w)) + ((s1.x + s1.y) + (s1.z + s1.w))) * (1.f / 256.f) + EPS);
                    float v[8];
#pragma unroll
                    for (int e = 0; e < 4; ++e) { v[e] = acc[ai][bj][m][0][e] * rstd; v[4 + e] = acc[ai][bj][m][1][e] * rstd; }
                    const bool lat = row < ML;
                    const int b = lat ? (row >> 12) : ((row - ML) >> 8);
                    const int kvpos = lat ? (CTXL + (row & 4095)) : ((row - ML) & 255);
                    const size_t r = (size_t)(b * 4 + h) * KVL + kvpos;
                    if (j0 < 128) *(u32x4*)(Kb + r * 192 + j0 + 8 * fq) = pack8(v);
                    else          *(u32x4*)(Vb + r * 128 + (j0 - 128) + 8 * fq) = pack8(v);
                    asm volatile("" ::: "memory");
                }
        }
    }
};
struct EpiRes {
    static constexpr bool PERM = false, AFTER_DRAIN = false;
    const float* base; float* out; const float* gate;
    __device__ __forceinline__ void operator()(const pg8::f32x4 (&acc)[2][2][4][2], const pg8::Unit& u, int wr, int wc, int fr, int fq) const {
#pragma unroll
        for (int ai = 0; ai < 2; ++ai)
#pragma unroll
            for (int m = 0; m < 4; ++m) {
                const int row = u.pm * 256 + ai * 128 + wr * 64 + m * 16 + fr;
                const float* gp = gate + (size_t)(row >> 12) * 6144;
#pragma unroll
                for (int bj = 0; bj < 2; ++bj)
#pragma unroll
                    for (int n = 0; n < 2; ++n) {
                        const int c = u.pn * 256 + bj * 128 + wc * 32 + 16 * n + 4 * fq;
                        const f32x4 g = *(const f32x4*)(gp + c), bs = *(const f32x4*)(base + (size_t)row * 1024 + c);
                        const pg8::f32x4 a4 = acc[ai][bj][m][n];
                        f32x4 o; o.x = bs.x + g.x * a4[0]; o.y = bs.y + g.y * a4[1]; o.z = bs.z + g.z * a4[2]; o.w = bs.w + g.w * a4[3];
                        *(f32x4*)(out + (size_t)row * 1024 + c) = o;
                    }
            }
    }
};
struct EpiSwiglu {
    static constexpr bool PERM = true, AFTER_DRAIN = false;
    bf16_t* ACT;
    __device__ __forceinline__ void operator()(const pg8::f32x4 (&acc)[2][2][4][2], const pg8::Unit& u, int wr, int wc, int fr, int fq) const {
#pragma unroll
        for (int ai = 0; ai < 2; ++ai)
#pragma unroll
            for (int m = 0; m < 4; ++m) {
                const int row = u.pm * 256 + ai * 128 + wr * 64 + m * 16 + fr;
                float v[8];
#pragma unroll
                for (int n = 0; n < 2; ++n)
#pragma unroll
                    for (int e = 0; e < 4; ++e) { const float g = acc[ai][0][m][n][e], uu = acc[ai][1][m][n][e]; v[4 * n + e] = g * sigmoidf_(g) * uu; }
                *(u32x4*)(ACT + (size_t)row * DFF + u.pn * 128 + wc * 32 + 8 * fq) = pack8(v);
            }
    }
};

#ifndef ATT_QREG
#define ATT_QREG 2
#endif
namespace att {
constexpr int NW = 8, QBLK = 32, KVBLK = 64;
constexpr float SCALE = 0.07216878364870322f;
constexpr float THR = 8.f;
constexpr int LDQ = 192, LDK = 192, LDV = 128, LDO = 1024;
constexpr int SHM_V = KVBLK * 128 * 2, SHM_K = KVBLK * 192 * 2, SHM_ATTN = 2 * SHM_V + 2 * SHM_K;
static_assert(SHM_ATTN <= 163840, "attention LDS");
#define KSWZ(row, colB) ((row) * 384 + ((colB) ^ (((row) & 7) << 4)))
#define SBAR() __builtin_amdgcn_sched_barrier(0)
__device__ __forceinline__ int crow(int r, int hi) { return (r & 3) + 8 * (r >> 2) + 4 * hi; }
__device__ __forceinline__ unsigned cvtpk(float lo, float hi) { return pk2(lo, hi); }
__device__ __forceinline__ void partialSM(f32x16& p0, f32x16& p1, float& m_reg, float& mn, float& alpha) {
  constexpr float C = SCALE * 1.4426950408889634f;
  float pmax = p0[0];
#pragma unroll
  for (int r = 1; r < 16; ++r) pmax = fmaxf(pmax, p0[r]);
#pragma unroll
  for (int r = 0; r < 16; ++r) pmax = fmaxf(pmax, p1[r]);
  { auto rr = __builtin_amdgcn_permlane32_swap(__float_as_uint(pmax), __float_as_uint(pmax), false, false);
    pmax = fmaxf(__uint_as_float(rr[0]), __uint_as_float(rr[1])); }
  if (__builtin_expect(__all(pmax - m_reg <= THR / SCALE), 1)) { mn = m_reg; alpha = 1.f; }
  else { mn = fmaxf(m_reg, pmax); alpha = __builtin_amdgcn_exp2f((m_reg - mn) * C); m_reg = mn; }
  float mnC = -mn * C;
#pragma unroll
  for (int r = 0; r < 16; ++r) p0[r] = fmaf(p0[r], C, mnC);
#pragma unroll
  for (int r = 0; r < 16; ++r) p1[r] = fmaf(p1[r], C, mnC);
#pragma unroll
  for (int r = 0; r < 16; ++r) p0[r] = __builtin_amdgcn_exp2f(p0[r]);
}
__device__ __forceinline__ void finishSM(f32x16& p0, f32x16& p1, float alpha, float& l_reg, bf16x8& pa0, bf16x8& pa1, bf16x8& pa2, bf16x8& pa3) {
#pragma unroll
  for (int r = 0; r < 16; ++r) p1[r] = __builtin_amdgcn_exp2f(p1[r]);
  float ps = 0;
#pragma unroll
  for (int r = 0; r < 16; ++r) ps += p0[r];
#pragma unroll
  for (int r = 0; r < 16; ++r) ps += p1[r];
  { auto rr = __builtin_amdgcn_permlane32_swap(__float_as_uint(ps), __float_as_uint(ps), false, false);
    ps = __uint_as_float(rr[0]) + __uint_as_float(rr[1]); }
  l_reg = l_reg * alpha + ps;
#define PK4(P, BASE, OUT) do { unsigned a0 = cvtpk(P[BASE + 0], P[BASE + 1]), a1 = cvtpk(P[BASE + 2], P[BASE + 3]);   \
    unsigned b0 = cvtpk(P[BASE + 4], P[BASE + 5]), b1 = cvtpk(P[BASE + 6], P[BASE + 7]);                              \
    auto r0 = __builtin_amdgcn_permlane32_swap(a0, b0, false, false); auto r1 = __builtin_amdgcn_permlane32_swap(a1, b1, false, false); \
    u32x4 w = {r0[0], r1[0], r0[1], r1[1]}; OUT = *reinterpret_cast<bf16x8*>(&w); } while (0)
  PK4(p0, 0, pa0); PK4(p0, 8, pa1); PK4(p1, 0, pa2); PK4(p1, 8, pa3);
#undef PK4
}
__device__ __forceinline__ void qkt(f32x16& p0, f32x16& p1, const char* Ks, const bf16x8* qr, int r32, int hi) {
  p0 = f32x16{}; p1 = f32x16{};
#pragma unroll
  for (int d0 = 0; d0 < 12; ++d0) { int cb = (d0 * 16 + hi * 8) * 2;
    bf16x8 b0 = *reinterpret_cast<const bf16x8*>(Ks + KSWZ(r32, cb));
    bf16x8 b1 = *reinterpret_cast<const bf16x8*>(Ks + KSWZ(32 + r32, cb));
    p0 = __builtin_amdgcn_mfma_f32_32x32x16_bf16(b0, qr[d0], p0, 0, 0, 0);
    p1 = __builtin_amdgcn_mfma_f32_32x32x16_bf16(b1, qr[d0], p1, 0, 0, 0); }
}
__device__ __forceinline__ int v_st(int k, int c) { const int kk = (k & ~0xC) | ((k & 4) << 1) | ((k & 8) >> 1); return ((kk >> 3) * 4 + (c >> 5)) * 512 + ((kk & 7) * 32 + (c & 31)) * 2; }
__device__ __forceinline__ int v_rd_base(int lane) { return ((lane & 3) << 3) | (((lane >> 2) & 3) << 6) | (((lane >> 4) & 1) << 5) | (((lane >> 5) & 1) << 8); }
constexpr int v_rd_off(int d0, int ks, int half) { return d0 * 512 + ks * 4096 + half * 2048; }
template <int OFF> __device__ __forceinline__ s16x4 tr_read(int vb) {
  s16x4 r; asm volatile("ds_read_b64_tr_b16 %0, %1 offset:%2" : "=&v"(r) : "v"(vb), "i"(OFF) : "memory"); return r;
}
template <int D0> __device__ __forceinline__ void pv_one(f32x16& od, int vb, bf16x8 pa0, bf16x8 pa1, bf16x8 pa2, bf16x8 pa3) {
  const s16x4 l0 = tr_read<v_rd_off(D0, 0, 0)>(vb), h0 = tr_read<v_rd_off(D0, 0, 1)>(vb), l1 = tr_read<v_rd_off(D0, 1, 0)>(vb), h1 = tr_read<v_rd_off(D0, 1, 1)>(vb);
  const s16x4 l2 = tr_read<v_rd_off(D0, 2, 0)>(vb), h2 = tr_read<v_rd_off(D0, 2, 1)>(vb), l3 = tr_read<v_rd_off(D0, 3, 0)>(vb), h3 = tr_read<v_rd_off(D0, 3, 1)>(vb);
  asm volatile("s_waitcnt lgkmcnt(0)" ::: "memory"); SBAR();
#define PK(L, H) (bf16x8){L[0], L[1], L[2], L[3], H[0], H[1], H[2], H[3]}
  od = __builtin_amdgcn_mfma_f32_32x32x16_bf16(pa0, PK(l0, h0), od, 0, 0, 0);
  od = __builtin_amdgcn_mfma_f32_32x32x16_bf16(pa1, PK(l1, h1), od, 0, 0, 0);
  od = __builtin_amdgcn_mfma_f32_32x32x16_bf16(pa2, PK(l2, h2), od, 0, 0, 0);
  od = __builtin_amdgcn_mfma_f32_32x32x16_bf16(pa3, PK(l3, h3), od, 0, 0, 0);
#undef PK
}
__device__ __forceinline__ void pv_d0(f32x16* o, int vb, bf16x8 pa0, bf16x8 pa1, bf16x8 pa2, bf16x8 pa3) {
  pv_one<0>(o[0], vb, pa0, pa1, pa2, pa3); pv_one<1>(o[1], vb, pa0, pa1, pa2, pa3); pv_one<2>(o[2], vb, pa0, pa1, pa2, pa3); pv_one<3>(o[3], vb, pa0, pa1, pa2, pa3);
}
__device__ __forceinline__ void attn_body(const bf16_t* __restrict__ Qb, const bf16_t* __restrict__ Kh, const bf16_t* __restrict__ Vh, bf16_t* __restrict__ Ob, int seq, char* lds) {
  const int tid = threadIdx.x, wid = tid >> 6, lane = tid & 63, r32 = lane & 31, hi = lane >> 5;
  char* V_lds = lds; char* K_lds = lds + 2 * SHM_V;
  float m_reg = -1e30f, l_reg = 0; f32x16 o[4] = {}; bf16x8 qr[12];
  const bf16_t* Qw = Qb + (long)(wid * QBLK + r32) * LDQ + hi * 8;
#pragma unroll
  for (int d0 = 0; d0 < 12; ++d0) qr[d0] = *reinterpret_cast<const bf16x8*>(Qw + d0 * 16);
  const int sr = tid >> 4, sc = (tid & 15) * 8, vst0 = v_st(sr, sc), vst1 = v_st(32 + sr, sc);
  const int kid0 = tid, kid1 = tid + 512, kid2 = tid + 1024;
  const int kr0 = kid0 / 24, kc0 = kid0 % 24, kr1 = kid1 / 24, kc1 = kid1 % 24, kr2 = kid2 / 24, kc2 = kid2 % 24;
  const int kg0 = kr0 * LDK + kc0 * 8, kg1 = kr1 * LDK + kc1 * 8, kg2 = kr2 * LDK + kc2 * 8;
  const int kl0 = KSWZ(kr0, kc0 * 16), kl1 = KSWZ(kr1, kc1 * 16), kl2 = KSWZ(kr2, kc2 * 16);
  const int vb0 = (int)(uintptr_t)V_lds + v_rd_base(lane);
  bf16x8 sA_v0, sA_v1, sA_k0, sA_k1, sA_k2;
#define SLOADA(k0) do { sA_v0 = *(const bf16x8*)&Vh[(long)((k0) + sr) * LDV + sc]; sA_v1 = *(const bf16x8*)&Vh[(long)((k0) + 32 + sr) * LDV + sc]; \
    sA_k0 = *(const bf16x8*)&Kh[(long)(k0) * LDK + kg0]; sA_k1 = *(const bf16x8*)&Kh[(long)(k0) * LDK + kg1]; sA_k2 = *(const bf16x8*)&Kh[(long)(k0) * LDK + kg2]; } while (0)
#define SWRITEA(b) do { *(bf16x8*)(V_lds + (b) * SHM_V + vst0) = sA_v0; *(bf16x8*)(V_lds + (b) * SHM_V + vst1) = sA_v1; \
    *(bf16x8*)(K_lds + (b) * SHM_K + kl0) = sA_k0; *(bf16x8*)(K_lds + (b) * SHM_K + kl1) = sA_k1; *(bf16x8*)(K_lds + (b) * SHM_K + kl2) = sA_k2; } while (0)
#define SWAIT() asm volatile("s_waitcnt vmcnt(0)" ::: "memory")
#define RESC(a) do { if (__any((a) < 1.f)) { \
    _Pragma("unroll") for (int r = 0; r < 16; ++r) { const float al_ = __shfl((a), crow(r, hi)); _Pragma("unroll") for (int d = 0; d < 4; ++d) o[d][r] *= al_; } } } while (0)
  const int NT = seq / KVBLK;
  SLOADA(0); SWAIT(); SWRITEA(0); __syncthreads();
#pragma unroll 1
  for (int j = 0; j < NT; ++j) {
    const int b = j & 1;
    if (j + 1 < NT) SLOADA((j + 1) * KVBLK);
    f32x16 p0, p1; float mn, al; bf16x8 pa0, pa1, pa2, pa3;
    SBAR(); qkt(p0, p1, K_lds + b * SHM_K, qr, r32, hi);
    partialSM(p0, p1, m_reg, mn, al);
    RESC(al);
    finishSM(p0, p1, al, l_reg, pa0, pa1, pa2, pa3); SBAR();
    pv_d0(o, vb0 + b * SHM_V, pa0, pa1, pa2, pa3);
    if (j + 1 < NT) { SWAIT(); SWRITEA(b ^ 1); }
    __syncthreads();
  }
  float rli[16];
#pragma unroll
  for (int r = 0; r < 16; ++r) rli[r] = __builtin_amdgcn_rcpf(__shfl(l_reg, crow(r, hi)));
  bf16_t* Ow = Ob + (long)(wid * QBLK) * LDO;
#pragma unroll
  for (int r = 0; r < 16; ++r) { int orow = crow(r, hi);
#pragma unroll
    for (int d0 = 0; d0 < 4; ++d0) Ow[(long)orow * LDO + d0 * 32 + r32] = (bf16_t)f2bf(o[d0][r] * rli[r]); }
  asm volatile("s_waitcnt vmcnt(0)" ::: "memory");
  __syncthreads();
#undef SLOADA
#undef SWRITEA
#undef SWAIT
#undef RESC
}
}

__device__ __forceinline__ int hgrn_chunk_row0(int dir, int b, int p) {
    if (p < 4) return ML + b * CTXL + 64 * (dir ? 3 - p : p);
    return b * SEQ + 64 * (dir ? 63 - (p - 4) : p - 4);
}
__device__ __forceinline__ void hgrn_cumsum(const _Float16* G, int k, int qd, int dir, float* qt, float (&gv)[16], float (&bl)[16], float& tot, float& bref) {
#pragma unroll
    for (int i = 0; i < 16; ++i) gv[i] = (float)G[(size_t)(16 * qd + i) * 512 + k];
    float run = 0.f;
    if (dir == 0) {
#pragma unroll
        for (int i = 0; i < 16; ++i) { run += gv[i]; bl[i] = run; }
    } else {
#pragma unroll
        for (int i = 15; i >= 0; --i) { run += gv[i]; bl[i] = run; }
    }
    qt[qd * 128 + k] = run;
    __syncthreads();
    const float q0 = qt[k], q1 = qt[128 + k], q2 = qt[256 + k], q3 = qt[384 + k];
    tot = (q0 + q1) + (q2 + q3);
    float off;
    if (dir == 0) { off = (qd > 0 ? q0 : 0.f) + (qd > 1 ? q1 : 0.f) + (qd > 2 ? q2 : 0.f); bref = q0 + q1; }
    else          { off = (qd < 3 ? q3 : 0.f) + (qd < 2 ? q2 : 0.f) + (qd < 1 ? q1 : 0.f); bref = q2 + q3; }
#pragma unroll
    for (int i = 0; i < 16; ++i) bl[i] += off;
}
__device__ __forceinline__ void hgrn_passA(const Args& a, char* lds, int item) {
    const int tid = threadIdx.x, wave = tid >> 6, lane = tid & 63, r32 = lane & 31, hi = lane >> 5;
    const int dir = item / (32 * NCH), rem = item % (32 * NCH), bh = rem / NCH, p = rem % NCH, b = bh >> 2, h = bh & 3;
#ifdef EXPR_SKIPCTX
    if (p < 4) return;
#endif
#ifdef EXPR_ONLYCTX
    if (p >= 4) return;
#endif
    const int row0 = hgrn_chunk_row0(dir, b, p);
    const _Float16* G = (const _Float16*)(a.ws + (dir ? WS_GB : WS_GF)) + (size_t)row0 * 512 + h * 128;
    const bf16_t* Vp = (const bf16_t*)(a.ws + WS_HI) + (size_t)row0 * 512 + h * 128;
    char* Kt = lds; char* Vt = lds + 128 * 144; float* qt = (float*)(lds + 2 * 128 * 144);
    const int k = tid & 127, qd = tid >> 7;
    float gv[16], bl[16], tot, bref;
    hgrn_cumsum(G, k, qd, dir, qt, gv, bl, tot, bref);
    unsigned kw[8], vw[8];
#pragma unroll
    for (int i = 0; i < 8; ++i) {
        const float k0 = (1.f - __expf(gv[2 * i])) * __expf(tot - bl[2 * i]), k1 = (1.f - __expf(gv[2 * i + 1])) * __expf(tot - bl[2 * i + 1]);
        kw[i] = pk2(k0, k1);
        vw[i] = (unsigned)Vp[(size_t)(16 * qd + 2 * i) * 512 + k] | ((unsigned)Vp[(size_t)(16 * qd + 2 * i + 1) * 512 + k] << 16);
    }
    *(u32x4*)(Kt + k * 144 + qd * 32) = (u32x4){kw[0], kw[1], kw[2], kw[3]}; *(u32x4*)(Kt + k * 144 + qd * 32 + 16) = (u32x4){kw[4], kw[5], kw[6], kw[7]};
    *(u32x4*)(Vt + k * 144 + qd * 32) = (u32x4){vw[0], vw[1], vw[2], vw[3]}; *(u32x4*)(Vt + k * 144 + qd * 32 + 16) = (u32x4){vw[4], vw[5], vw[6], vw[7]};
    const size_t slot = (size_t)(dir * 32 + bh) * NCH + p;
    if (qd == 0) ((float*)(a.ws + WS_DG))[slot * 128 + k] = __expf(tot);
    __syncthreads();
    const int kb = wave >> 1, vb0 = (wave & 1) * 2;
    f32x16 acc0 = {}, acc1 = {};
#pragma unroll
    for (int ks = 0; ks < 4; ++ks) {
        const bf16x8 af = *(const bf16x8*)(Kt + (32 * kb + r32) * 144 + ks * 32 + hi * 16);
        const bf16x8 b0 = *(const bf16x8*)(Vt + (32 * vb0 + r32) * 144 + ks * 32 + hi * 16);
        const bf16x8 b1 = *(const bf16x8*)(Vt + (32 * (vb0 + 1) + r32) * 144 + ks * 32 + hi * 16);
        acc0 = __builtin_amdgcn_mfma_f32_32x32x16_bf16(af, b0, acc0, 0, 0, 0);
        acc1 = __builtin_amdgcn_mfma_f32_32x32x16_bf16(af, b1, acc1, 0, 0, 0);
    }
    bf16_t* Lt = (bf16_t*)(a.ws + WS_A) + slot * 16384;
#pragma unroll
    for (int rg = 0; rg < 4; ++rg) {
        const int k4 = 32 * kb + 8 * rg + 4 * hi;
        u32x2 w0, w1; w0.x = pk2(acc0[4 * rg], acc0[4 * rg + 1]); w0.y = pk2(acc0[4 * rg + 2], acc0[4 * rg + 3]);
        w1.x = pk2(acc1[4 * rg], acc1[4 * rg + 1]); w1.y = pk2(acc1[4 * rg + 2], acc1[4 * rg + 3]);
#ifdef EXPT1
        w0.x = 0x3f803f80u; w0.y = 0x3f803f80u; w1.x = 0x3f803f80u; w1.y = 0x3f803f80u;
#endif
        *(u32x2*)(Lt + (size_t)(32 * vb0 + r32) * 128 + k4) = w0;
        *(u32x2*)(Lt + (size_t)(32 * (vb0 + 1) + r32) * 128 + k4) = w1;
    }
    __syncthreads();
}
__device__ __forceinline__ void hgrn_passB(const Args& a, int G) {
    bf16_t* LS = (bf16_t*)(a.ws + WS_A); const float* DG = (const float*)(a.ws + WS_DG);
    for (int it = blockIdx.x * 512 + threadIdx.x; it < 64 * 2048; it += G * 512) {
        const int dbh = it >> 11, e8 = it & 2047, k0 = (e8 & 15) * 8;
        bf16_t* base = LS + (size_t)dbh * NCH * 16384 + e8 * 8; const float* dp = DG + (size_t)dbh * NCH * 128 + k0;
        float S[8];
#pragma unroll
        for (int e = 0; e < 8; ++e) S[e] = 0.f;
#pragma unroll 4
        for (int p = 0; p < NCH; ++p) {
            const u32x4 L = *(const u32x4*)(base + (size_t)p * 16384);
            const f32x4 d0 = *(const f32x4*)(dp + p * 128), d1 = *(const f32x4*)(dp + p * 128 + 4);
            if (p >= 4) { u32x4 w; w.x = pk2(S[0], S[1]); w.y = pk2(S[2], S[3]); w.z = pk2(S[4], S[5]); w.w = pk2(S[6], S[7]); *(u32x4*)(base + (size_t)p * 16384) = w; }
            S[0] = d0.x * S[0] + bf2f(L.x & 0xffffu); S[1] = d0.y * S[1] + bf2f(L.x >> 16);
            S[2] = d0.z * S[2] + bf2f(L.y & 0xffffu); S[3] = d0.w * S[3] + bf2f(L.y >> 16);
            S[4] = d1.x * S[4] + bf2f(L.z & 0xffffu); S[5] = d1.y * S[5] + bf2f(L.z >> 16);
            S[6] = d1.z * S[6] + bf2f(L.w & 0xffffu); S[7] = d1.w * S[7] + bf2f(L.w >> 16);
        }
    }
}
__device__ __forceinline__ void hgrn_passC(const Args& a, char* lds, int item) {
    const int tid = threadIdx.x, wave = tid >> 6, lane = tid & 63, r32 = lane & 31, hi = lane >> 5;
    const int bh = item >> 6, lc = item & 63, b = bh >> 2, h = bh & 3;
    const int row0 = b * SEQ + 64 * lc;
    char* St = lds; char* Qd = lds + 34816; char* Qd2 = lds + 52224; char* Kd2 = lds + 69632; char* Vt = lds + 87040; char* Bs = lds + 105472;
    float* qt = (float*)(lds + 138240); float* brefs = (float*)(lds + 140288);
    const int k = tid & 127, qd = tid >> 7;
    {
        const bf16_t* Vp = (const bf16_t*)(a.ws + WS_HI) + (size_t)row0 * 512 + h * 128;
        unsigned vw[8];
#pragma unroll
        for (int i = 0; i < 8; ++i) vw[i] = (unsigned)Vp[(size_t)(16 * qd + 2 * i) * 512 + k] | ((unsigned)Vp[(size_t)(16 * qd + 2 * i + 1) * 512 + k] << 16);
        *(u32x4*)(Vt + k * 144 + qd * 32) = (u32x4){vw[0], vw[1], vw[2], vw[3]}; *(u32x4*)(Vt + k * 144 + qd * 32 + 16) = (u32x4){vw[4], vw[5], vw[6], vw[7]};
    }
    const int rb = wave >> 2, cb = wave & 3;
    f32x16 o = {};
#pragma unroll 1
    for (int dir = 0; dir < 2; ++dir) {
        const int p = dir ? 4 + 63 - lc : 4 + lc;
        const size_t slot = (size_t)(dir * 32 + bh) * NCH + p;
        {
            const u32x4* Sg = (const u32x4*)((const bf16_t*)(a.ws + WS_A) + slot * 16384);
#pragma unroll
            for (int i = 0; i < 4; ++i) { const int id = tid + 512 * i; *(u32x4*)(St + (id >> 4) * 272 + (id & 15) * 16) = Sg[id]; }
        }
        const _Float16* G = (const _Float16*)(a.ws + (dir ? WS_GB : WS_GF)) + (size_t)row0 * 512 + h * 128;
        {
            float gv[16], bl[16], tot, bref;
            hgrn_cumsum(G, k, qd, dir, qt, gv, bl, tot, bref);
#pragma unroll
            for (int i = 0; i < 16; ++i) ((float*)Bs)[(16 * qd + i) * 128 + k] = bl[i];
            if (qd == 0) brefs[k] = bref;
        }
        __syncthreads();
        {
            const int tok = tid >> 3, ks = (tid & 7) * 16;
            typedef _Float16 h8 __attribute__((ext_vector_type(8)));
            const h8 g0 = *(const h8*)(G + (size_t)tok * 512 + ks), g1 = *(const h8*)(G + (size_t)tok * 512 + ks + 8);
            const bf16_t* Qp = (const bf16_t*)(a.ws + WS_HQ) + (size_t)(row0 + tok) * 512 + h * 128 + ks;
            const u32x4 q0 = *(const u32x4*)Qp, q1 = *(const u32x4*)(Qp + 8);
            float qd_[16], qd2_[16], kd2_[16];
#pragma unroll
            for (int e = 0; e < 16; ++e) {
                const float g = e < 8 ? (float)g0[e & 7] : (float)g1[e & 7];
                const unsigned qw = e < 8 ? q0[(e & 7) >> 1] : q1[(e & 7) >> 1];
                const float q = bf2f((e & 1) ? (qw >> 16) : (qw & 0xffffu));
                const float bb = ((const float*)Bs)[tok * 128 + ks + e], d = bb - brefs[ks + e];
                qd_[e] = q * __expf(bb); qd2_[e] = q * __expf(d); kd2_[e] = (1.f - __expf(g)) * __expf(-d);
            }
#pragma unroll
            for (int hlf = 0; hlf < 2; ++hlf) {
                u32x4 w;
                w.x = pk2(qd_[8 * hlf + 0], qd_[8 * hlf + 1]); w.y = pk2(qd_[8 * hlf + 2], qd_[8 * hlf + 3]); w.z = pk2(qd_[8 * hlf + 4], qd_[8 * hlf + 5]); w.w = pk2(qd_[8 * hlf + 6], qd_[8 * hlf + 7]);
                *(u32x4*)(Qd + tok * 272 + ks * 2 + hlf * 16) = w;
                w.x = pk2(qd2_[8 * hlf + 0], qd2_[8 * hlf + 1]); w.y = pk2(qd2_[8 * hlf + 2], qd2_[8 * hlf + 3]); w.z = pk2(qd2_[8 * hlf + 4], qd2_[8 * hlf + 5]); w.w = pk2(qd2_[8 * hlf + 6], qd2_[8 * hlf + 7]);
                *(u32x4*)(Qd2 + tok * 272 + ks * 2 + hlf * 16) = w;
                w.x = pk2(kd2_[8 * hlf + 0], kd2_[8 * hlf + 1]); w.y = pk2(kd2_[8 * hlf + 2], kd2_[8 * hlf + 3]); w.z = pk2(kd2_[8 * hlf + 4], kd2_[8 * hlf + 5]); w.w = pk2(kd2_[8 * hlf + 6], kd2_[8 * hlf + 7]);
                *(u32x4*)(Kd2 + tok * 272 + ks * 2 + hlf * 16) = w;
            }
        }
        __syncthreads();
        const int tr = (wave & 3) >> 1, tc = wave & 1;
        f32x16 pacc = {};
#pragma unroll
        for (int kk = 0; kk < 8; ++kk) {
            const bf16x8 af = *(const bf16x8*)(Qd + (32 * rb + r32) * 272 + kk * 32 + hi * 16);
            const bf16x8 bf = *(const bf16x8*)(St + (32 * cb + r32) * 272 + kk * 32 + hi * 16);
            o = __builtin_amdgcn_mfma_f32_32x32x16_bf16(af, bf, o, 0, 0, 0);
            const bf16x8 a2 = *(const bf16x8*)(Qd2 + (32 * tr + r32) * 272 + kk * 32 + hi * 16);
            const bf16x8 b2 = *(const bf16x8*)(Kd2 + (32 * tc + r32) * 272 + kk * 32 + hi * 16);
            pacc = __builtin_amdgcn_mfma_f32_32x32x16_bf16(a2, b2, pacc, 0, 0, 0);
        }
        if (wave < 4) {
#pragma unroll
            for (int r = 0; r < 16; ++r) {
                const int t = 32 * tr + att::crow(r, hi), s = 32 * tc + r32;
                const bool keep = dir ? (s >= t) : (s <= t);
                *(bf16_t*)(Bs + t * 144 + s * 2) = (bf16_t)f2bf(keep ? pacc[r] : 0.f);
            }
        }
        __syncthreads();
#pragma unroll
        for (int ks = 0; ks < 4; ++ks) {
            const bf16x8 af = *(const bf16x8*)(Bs + (32 * rb + r32) * 144 + ks * 32 + hi * 16);
            const bf16x8 bf = *(const bf16x8*)(Vt + (32 * cb + r32) * 144 + ks * 32 + hi * 16);
            o = __builtin_amdgcn_mfma_f32_32x32x16_bf16(af, bf, o, 0, 0, 0);
        }
        __syncthreads();
    }
#pragma unroll
    for (int r = 0; r < 16; ++r) ((float*)Bs)[(32 * rb + att::crow(r, hi)) * 128 + 32 * cb + r32] = o[r];
    __syncthreads();
    {
        const int tok = tid >> 3, vs = (tid & 7) * 16;
        float ov[16]; float ss = 0.f;
#pragma unroll
        for (int e = 0; e < 16; ++e) { ov[e] = ((const float*)Bs)[tok * 128 + vs + e]; ss += ov[e] * ov[e]; }
        ss += __shfl_xor(ss, 1); ss += __shfl_xor(ss, 2); ss += __shfl_xor(ss, 4);
        const float rstd = rsqrtf(ss * (1.f / 128.f) + EPS);
        const bf16_t* Hg = (const bf16_t*)(a.ws + WS_HG) + (size_t)(row0 + tok) * 512 + h * 128 + vs;
        const u32x4 h0 = *(const u32x4*)Hg, h1 = *(const u32x4*)(Hg + 8);
        float res[16];
#pragma unroll
        for (int e = 0; e < 16; ++e) {
            const unsigned hw = e < 8 ? h0[(e & 7) >> 1] : h1[(e & 7) >> 1];
            const float hg = bf2f((e & 1) ? (hw >> 16) : (hw & 0xffffu));
            res[e] = ov[e] * rstd * a.g_on[vs + e] * (hg * sigmoidf_(hg));
        }
        bf16_t* Mx = (bf16_t*)(a.ws + WS_MIX) + (size_t)(row0 + tok) * 1024 + 512 + h * 128 + vs;
        u32x4 w;
        w.x = pk2(res[0], res[1]); w.y = pk2(res[2], res[3]); w.z = pk2(res[4], res[5]); w.w = pk2(res[6], res[7]); *(u32x4*)Mx = w;
        w.x = pk2(res[8], res[9]); w.y = pk2(res[10], res[11]); w.z = pk2(res[12], res[13]); w.w = pk2(res[14], res[15]); *(u32x4*)(Mx + 8) = w;
    }
    __syncthreads();
}

__global__ void __launch_bounds__(512, 2) fwd_megakernel(Args a) {
    extern __shared__ __attribute__((aligned(16))) unsigned char lds[];
    cg::grid_group grid = cg::this_grid();
    const int tid = threadIdx.x, wave = __builtin_amdgcn_readfirstlane(tid >> 6), lane = tid & 63;
    const int G = gridDim.x;
    unsigned char* ws = a.ws;
    LAS unsigned char* ldsl = (LAS unsigned char*)lds;
    char* ldsc = (char*)lds;
    const int lo = a.ph_lo, hi = a.ph_hi;
#ifndef SKIPMASK
#define SKIPMASK 0
#endif
#ifndef REPMASK
#define REPMASK 0
#endif
#define REPN(k) (((REPMASK >> (k)) & 1) ? 2 : 1)
#define IN(k) (!((SKIPMASK >> (k)) & 1) && lo <= (k) && (k) < hi)
#define SEAM(k) do { if (lo <= (k) && (k) + 1 < hi) { grid.sync(); } } while (0)
    float* MOD = (float*)(ws + WS_MOD);
    float* RSS = (float*)(ws + WS_RSSP);
    const float* RC = (const float*)(ws + WS_RCOS); const float* RS = (const float*)(ws + WS_RSIN);
    bf16_t* Hb = (bf16_t*)(ws + WS_A);
    bf16_t* Qb = (bf16_t*)a.out;
    bf16_t* Kb = (bf16_t*)((char*)a.out + 48 * MiB);
    bf16_t* Vb = (bf16_t*)(ws + WS_V);
    bf16_t* MIX = (bf16_t*)(ws + WS_MIX);
    const int gw = blockIdx.x * 8 + wave, NGW = G * 8;

    if (IN(0)) { p0_prologue(a, ldsc, G); }
    SEAM(0);
    if (IN(1)) {
        for (int r = gw; r < MT; r += NGW) {
            const bool lat = r < ML; const float* src = lat ? a.x + (size_t)r * 1024 : a.ctx + (size_t)(r - ML) * 1024;
            const float* md = MOD + (size_t)(lat ? (r >> 12) : 8) * 6144;
            row_norm_mod_bf16(src, a.g_mix, md, md + 1024, Hb + (size_t)r * 1024, lane);
        }
    }
#ifdef ZERO_MIX
    if (IN(1)) { u32x4* mz = (u32x4*)(ws + WS_MIX); const u32x4 z = {0u, 0u, 0u, 0u}; for (size_t i = (size_t)blockIdx.x * 512 + tid; i < (size_t)ML * 1024 * 2 / 16; i += (size_t)G * 512) mz[i] = z; }
#endif
    SEAM(1);
    if (IN(2)) {
        pg8::Gemm g{Hb, (const bf16_t*)(ws + WS_WIN), MT, NINP, 1024}; pg8::StaticOrder S; S.init(MT, NINP, G, (int)blockIdx.x);
        EpiInProj E{ws, Kb};
        pg8::gemm_phase<EpiInProj, pg8::StaticOrder, true, true>(ldsl, g, S, E);
    }
    SEAM(2);
    if (IN(3)) {
#ifndef SKIP3A
        { pg8::Gemm g{(const bf16_t*)(ws + WS_CQ), (const bf16_t*)(ws + WS_WUQ), ML, 768, 256}; pg8::StaticOrder S; S.init(ML, 768, G, (int)blockIdx.x);
          EpiQ E{Qb, RSS, RC, RS};
          pg8::gemm_phase<EpiQ, pg8::StaticOrder, true, true>(ldsl, g, S, E); }
#endif
#ifndef SKIP3B
        { pg8::Gemm g{(const bf16_t*)(ws + WS_CKV), (const bf16_t*)(ws + WS_WUKV), MT, 1024, 256}; pg8::StaticOrder S; S.init(MT, 1024, G, (int)blockIdx.x);
          EpiKV E{Kb, Vb, RSS};
          pg8::gemm_phase<EpiKV, pg8::StaticOrder, true, true>(ldsl, g, S, E); }
#endif
#ifndef SKIP3C
        for (int it = blockIdx.x; it < 2 * 32 * NCH; it += G) hgrn_passA(a, ldsc, it);
#endif
    }
#ifdef EXPJ
    if (IN(3)) {
        const u32x4* srcA = (const u32x4*)(ws + EXPJ_A); const u32x4* srcB = (const u32x4*)(ws + EXPJ_B); u32x4* dst = (u32x4*)MIX;
        for (size_t i = (size_t)blockIdx.x * 512 + tid; i < (size_t)ML * 64; i += (size_t)G * 512) { const size_t r = i >> 6, c = i & 63; dst[r * 128 + c] = srcA[r * 64 + c]; dst[r * 128 + 64 + c] = srcB[r * 64 + c]; }
    }
#endif
    SEAM(3);
    if (IN(4)) { hgrn_passB(a, G); }
    SEAM(4);
    if (IN(5)) {
#ifndef SKIP5A
        for (int u = blockIdx.x; u < 512; u += G) {
            int bh, qb;
            if (G == 256) { const int xcd = blockIdx.x & 7, cu = blockIdx.x >> 3, i = u >> 8; bh = xcd * 4 + i * 2 + (cu >> 4); qb = cu & 15; }
            else { bh = u >> 4; qb = u & 15; }
            const int b = bh >> 2, h = bh & 3;
            att::attn_body(Qb + ((size_t)bh * SEQ + qb * 256) * 192, Kb + (size_t)bh * KVL * 192, Vb + (size_t)bh * KVL * 128,
                           MIX + ((size_t)b * SEQ + qb * 256) * 1024 + h * 128, KVL, ldsc);
        }
#endif
#ifndef SKIP5B
        for (int it = blockIdx.x; it < 2048; it += G) hgrn_passC(a, ldsc, it);
#endif
    }
#ifdef EXPM
    if (IN(5)) { const u32x4* src = (const u32x4*)(ws + WS_A); u32x4* dst = (u32x4*)MIX;
        for (size_t i = (size_t)blockIdx.x * 512 + tid; i < (size_t)ML * 128; i += (size_t)G * 512) dst[i] = src[i]; }
#endif
    SEAM(5);
    if (IN(6)) {
        pg8::Gemm g{MIX, (const bf16_t*)(ws + WS_WOUT), ML, 1024, 1024}; pg8::StaticOrder S; S.init(ML, 1024, G, (int)blockIdx.x);
        EpiRes E{a.x, a.out, MOD + 2048};
        pg8::gemm_phase<EpiRes, pg8::StaticOrder, true, true>(ldsl, g, S, E);
    }
    SEAM(6);
    if (IN(7)) {
        for (int r = gw; r < ML; r += NGW) {
            const float* md = MOD + (size_t)(r >> 12) * 6144;
            row_norm_mod_bf16(a.out + (size_t)r * 1024, a.g_ffn, md + 3072, md + 4096, Hb + (size_t)r * 1024, lane);
        }
    }
    SEAM(7);
    if (IN(8)) {
        pg8::Gemm g{Hb, (const bf16_t*)(ws + WS_WGU), ML, 2 * DFF, 1024}; pg8::StaticOrder S; S.init(ML, 2 * DFF, G, (int)blockIdx.x);
        EpiSwiglu E{(bf16_t*)(ws + WS_ACT)};
        pg8::gemm_phase<EpiSwiglu, pg8::StaticOrder, true, true>(ldsl, g, S, E);
    }
    SEAM(8);
    if (IN(9)) {
        pg8::Gemm g{(const bf16_t*)(ws + WS_ACT), (const bf16_t*)(ws + WS_WDN), ML, 1024, DFF}; pg8::StaticOrder S; S.init(ML, 1024, G, (int)blockIdx.x);
        EpiRes E{a.out, a.out, MOD + 5120};
        pg8::gemm_phase<EpiRes, pg8::StaticOrder, true, true>(ldsl, g, S, E);
    }
    SEAM(9);
    if (IN(10)) {
        for (int r = gw; r < ML; r += NGW) row_norm_f32(a.out + (size_t)r * 1024, a.g_final, lane);
    }
#undef IN
#undef SEAM
}

#ifndef PROBE_REPS
#define PROBE_REPS 1
#endif
#ifndef MK_PER_PHASE
#define MK_PER_PHASE 0
#endif
extern "C" void kernel_launch(void* const* d_in, const int* in_sizes, int n_in, void* d_out, int out_size, void* d_ws, size_t ws_size, hipStream_t stream) {
    static int grid = 0;
    if (grid == 0) {
        if (n_in != 21 || out_size != ML * DM || ws_size < WS_END) { fprintf(stderr, "kernel_launch: unexpected shapes (n_in %d out %d ws %zu)\n", n_in, out_size, ws_size); grid = -1; return; }
        int dev = 0, cus = 0, per_cu = 0;
        hipGetDevice(&dev); hipDeviceGetAttribute(&cus, hipDeviceAttributeMultiprocessorCount, dev);
        if (hipFuncSetAttribute((const void*)fwd_megakernel, hipFuncAttributeMaxDynamicSharedMemorySize, LDS_BYTES) != hipSuccess) { fprintf(stderr, "kernel_launch: hipFuncSetAttribute failed\n"); grid = -1; return; }
        if (hipOccupancyMaxActiveBlocksPerMultiprocessor(&per_cu, (const void*)fwd_megakernel, 512, LDS_BYTES) != hipSuccess || per_cu < 1) { fprintf(stderr, "kernel_launch: occupancy query says %d\n", per_cu); per_cu = 1; }
        (void)hipGetLastError();
        grid = cus * 1;
        fprintf(stderr, "kernel_launch: grid %d (per_cu %d)\n", grid, per_cu);
    }
    if (grid < 0) return;
    Args a{};
    const float** ap = (const float**)&a;
    for (int i = 0; i < 21; ++i) ap[i] = (const float*)d_in[i];
    a.out = (float*)d_out; a.ws = (unsigned char*)d_ws;
#if MK_PER_PHASE
    for (int ph = 0; ph < 11; ++ph) {
        a.ph_lo = ph; a.ph_hi = ph + 1;
        hipLaunchKernelGGL(fwd_megakernel, dim3(grid), dim3(512), LDS_BYTES, stream, a);
    }
#else
#ifdef PROBE_PHASE
    for (int pr_ = 0; pr_ < PROBE_REPS; ++pr_) { a.ph_lo = PROBE_PHASE; a.ph_hi = PROBE_PHASE + 1; hipLaunchKernelGGL(fwd_megakernel, dim3(grid), dim3(512), LDS_BYTES, stream, a); }
#endif
    a.ph_lo = 0; a.ph_hi = 11;
    void* args[] = {&a};
    hipError_t e = hipLaunchCooperativeKernel((const void*)fwd_megakernel, dim3(grid), dim3(512), args, LDS_BYTES, stream);
    if (e != hipSuccess) fprintf(stderr, "cooperative launch failed: %s (grid %d)\n", hipGetErrorString(e), grid);
#endif
}
```

```cpp
#include <hip/hip_runtime.h>
#include <hip/hip_cooperative_groups.h>
#include <hip/hip_bf16.h>
#include <cstdio>
#include <cstdint>
namespace cg = cooperative_groups;
namespace pg8 {
#define PG8_LAS __attribute__((address_space(3)))
typedef unsigned short bf16_t;
typedef short bf16x8 __attribute__((ext_vector_type(8)));
typedef float f32x4 __attribute__((ext_vector_type(4)));
typedef unsigned u32x4 __attribute__((ext_vector_type(4)));
constexpr int BM = 256, BK = 64, HALF = 128, HTB = HALF * BK * 2  , STAGE_BYTES = 8 * HTB, NXCD = 8, WGM = 8;

__host__ __device__ __forceinline__ int lds_byte(int r, int c) { const int st = (r >> 4) * 2 + (c >> 5), rr = r & 15, cc = c & 31, ob = rr * 64 + cc * 2; return st * 1024 + (ob ^ (((ob >> 9) & 1) << 5)); }
__host__ __device__ __forceinline__ void stage_rc(int b, int& R, int& C) { const int st = b / 1024, sb = b % 1024, swz = sb ^ (((sb >> 9) & 1) << 5); R = (st >> 1) * 16 + swz / 64; C = (st & 1) * 32 + (swz % 64) / 2; }
__host__ __device__ __forceinline__ int perm32(int rho) { const int n = rho >> 4, i = rho & 15; return 8 * (i >> 2) + 4 * n + (i & 3); }

struct Unit { int pm, pn; };
struct Gemm { const bf16_t* A; const bf16_t* Bt; int M, N, K; };

struct StaticOrder {
    int nM, nN, nwg, G, c;
    __host__ __device__ void init(int M, int N, int G_, int c_) { nM = M / BM; nN = N / BM; nwg = nM * nN; G = G_; c = c_; }
    __host__ __device__ bool next(int i, Unit& u) const {
        const long L = (long)i * G + c; if (L >= nwg) return false;
        int wgid = (int)L; { const int q = nwg / NXCD, r = nwg % NXCD, xcd = wgid % NXCD, off = wgid / NXCD; wgid = (xcd < r ? xcd * (q + 1) : r * (q + 1) + (xcd - r) * q) + off; }
        const int nig = WGM * nN, gid = wgid / nig, fm = gid * WGM, gsz = (nM - fm) < WGM ? (nM - fm) : WGM;
        u.pm = fm + ((wgid % nig) % gsz); u.pn = (wgid % nig) / gsz; return true;
    }
    __device__ __forceinline__ void a_ready(const Unit&) const {}
    __device__ __forceinline__ void done(const Unit&) const {}
};

__device__ __forceinline__ unsigned cvt_pk_bf16(float lo, float hi) { unsigned r; asm volatile("v_cvt_pk_bf16_f32 %0, %1, %2" : "=v"(r) : "v"(lo), "v"(hi)); return r; }
typedef float f32x2 __attribute__((ext_vector_type(2)));
template <class Epi, class Sched, bool ALIGN_EPI = false, bool SP2 = false>
__device__ __forceinline__ void gemm_phase(PG8_LAS unsigned char* lds, const Gemm g, const Sched& S, const Epi& E) {
    const int tid = threadIdx.x, wid = __builtin_amdgcn_readfirstlane(tid >> 6), lane = tid & 63, wr = wid >> 2, wc = wid & 3, fr = lane & 15, fq = lane >> 4;
    const int K = g.K, nt = K / BK;
    unsigned voffA[2], voffB[2];
#pragma unroll
    for (int i = 0; i < 2; ++i) { int R, C; stage_rc(tid * 16 + i * 8192, R, C); const int Rb = Epi::PERM ? ((R & ~31) + perm32(R & 31)) : R;
        voffA[i] = (unsigned)(R * K + C) * 2u; voffB[i] = (unsigned)(Rb * K + C) * 2u; }
    const size_t kstep = (size_t)(BK * 2);
    const size_t hstep = (size_t)HALF * K * 2;
    const size_t tstep = 2 * hstep;
    const unsigned ldsw = (unsigned)wid * 1024u;
    const int aoff = lds_byte(wr * 64 + fr, fq * 8), boff = lds_byte(wc * 32 + fr, fq * 8);
#define PG8_SA(b, h) (((b) * 2 + (h)) * HTB)
#define PG8_SB(b, h) ((4 + (b) * 2 + (h)) * HTB)
#define PG8_STAGE(bufoff, gbase, voff) do { _Pragma("unroll") for (int _i = 0; _i < 2; ++_i) \
        __builtin_amdgcn_global_load_lds((const unsigned*)((const char*)(gbase) + (voff)[_i]), (PG8_LAS unsigned*)(lds + (bufoff) + ldsw + _i * 8192), 16, 0, 0); } while (0)
#define PG8_LDA(dst, b, h) do { _Pragma("unroll") for (int m = 0; m < 4; ++m) _Pragma("unroll") for (int k = 0; k < 2; ++k) dst[m][k] = *(const PG8_LAS bf16x8*)(lds + PG8_SA(b, h) + aoff + m * 2048 + k * 1024); } while (0)
#define PG8_LDB(dst, b, h) do { _Pragma("unroll") for (int n = 0; n < 2; ++n) _Pragma("unroll") for (int k = 0; k < 2; ++k) dst[n][k] = *(const PG8_LAS bf16x8*)(lds + PG8_SB(b, h) + boff + n * 2048 + k * 1024); } while (0)
#define PG8_MMA(ai, bj, At, Bt) do { __builtin_amdgcn_s_setprio(1); _Pragma("unroll") for (int m = 0; m < 4; ++m) _Pragma("unroll") for (int n = 0; n < 2; ++n) _Pragma("unroll") for (int k = 0; k < 2; ++k) \
        acc[ai][bj][m][n] = __builtin_amdgcn_mfma_f32_16x16x32_bf16(Bt[n][k], At[m][k], acc[ai][bj][m][n], 0, 0, 0); __builtin_amdgcn_s_setprio(0); } while (0)
#define PG8_WAIT_V(n) asm volatile("s_waitcnt vmcnt(" #n ")" ::: "memory")
#define PG8_WAIT_L(n) asm volatile("s_waitcnt lgkmcnt(" #n ")" ::: "memory")
#define PG8_BAR __builtin_amdgcn_s_barrier()
#define PG8_SCHED __builtin_amdgcn_sched_barrier(0)
    Unit cur, nxt; int ui = 0;
    if (!S.next(0, cur)) return;
    f32x4 acc[2][2][4][2];
#pragma unroll
    for (int a = 0; a < 2; ++a)
#pragma unroll
        for (int b = 0; b < 2; ++b)
#pragma unroll
            for (int m = 0; m < 4; ++m)
#pragma unroll
                for (int n = 0; n < 2; ++n) acc[a][b][m][n] = (f32x4){0.f, 0.f, 0.f, 0.f};
    bf16x8 At[4][2], B0[2][2], B1[2][2];
    const char* cA = (const char*)g.A + (size_t)cur.pm * tstep; const char* cB = (const char*)g.Bt + (size_t)cur.pn * tstep;
    S.a_ready(cur);
    if constexpr (SP2) {
        PG8_STAGE(PG8_SB(0, 0), cB, voffB); PG8_STAGE(PG8_SB(0, 1), cB + hstep, voffB); PG8_STAGE(PG8_SA(0, 0), cA, voffA); PG8_STAGE(PG8_SA(0, 1), cA + hstep, voffA);
        if (wr == 1) PG8_BAR;
        PG8_WAIT_V(2); PG8_BAR;
        PG8_STAGE(PG8_SB(1, 0), cB + kstep, voffB); PG8_STAGE(PG8_SA(1, 0), cA + kstep, voffA); PG8_STAGE(PG8_SB(1, 1), cB + hstep + kstep, voffB);
        PG8_WAIT_V(6); PG8_BAR;
    } else {
        PG8_STAGE(PG8_SB(0, 0), cB, voffB); PG8_STAGE(PG8_SA(0, 0), cA, voffA); PG8_STAGE(PG8_SB(0, 1), cB + hstep, voffB); PG8_STAGE(PG8_SA(0, 1), cA + hstep, voffA);
        if (wr == 1) PG8_BAR;
        PG8_WAIT_V(4); PG8_BAR;
        PG8_STAGE(PG8_SB(1, 0), cB + kstep, voffB); PG8_STAGE(PG8_SA(1, 0), cA + kstep, voffA); PG8_STAGE(PG8_SB(1, 1), cB + hstep + kstep, voffB);
        PG8_WAIT_V(6); PG8_BAR;
    }
    for (;;) {
        const bool has_next = S.next(ui + 1, nxt);
        const char* nA = has_next ? (const char*)g.A + (size_t)nxt.pm * tstep : cA; const char* nB = has_next ? (const char*)g.Bt + (size_t)nxt.pn * tstep : cB;
#pragma unroll 1
        for (int t = 0; t < nt; t += 2) {
            const bool last = (t == nt - 2);
            const char* a1 = cA + (size_t)(t + 1) * kstep;
            const char* a2 = last ? nA : cA + (size_t)(t + 2) * kstep; const char* b2 = last ? nB : cB + (size_t)(t + 2) * kstep;
            const char* a3 = a2 + kstep; const char* b3 = b2 + kstep;
            if (last && has_next) S.a_ready(nxt);
            if constexpr (SP2) {
            PG8_LDB(B0, 0, 0); PG8_LDB(B1, 0, 1); PG8_SCHED; PG8_LDA(At, 0, 0); PG8_STAGE(PG8_SA(1, 1), a1 + hstep, voffA);
            PG8_WAIT_V(8); PG8_WAIT_L(0); PG8_BAR; PG8_MMA(0, 0, At, B0); PG8_MMA(0, 1, At, B1); PG8_BAR; PG8_SCHED;
            PG8_LDA(At, 0, 1); PG8_STAGE(PG8_SB(0, 0), b2, voffB); PG8_STAGE(PG8_SB(0, 1), b2 + hstep, voffB); PG8_STAGE(PG8_SA(0, 0), a2, voffA);
            PG8_WAIT_V(8); PG8_WAIT_L(0); PG8_BAR; PG8_MMA(1, 0, At, B0); PG8_MMA(1, 1, At, B1); PG8_BAR; PG8_SCHED;
            PG8_LDB(B0, 1, 0); PG8_LDB(B1, 1, 1); PG8_SCHED; PG8_LDA(At, 1, 0); PG8_STAGE(PG8_SA(0, 1), a2 + hstep, voffA);
            PG8_WAIT_V(8); PG8_WAIT_L(0); PG8_BAR; PG8_MMA(0, 0, At, B0); PG8_MMA(0, 1, At, B1); PG8_BAR; PG8_SCHED;
            PG8_LDA(At, 1, 1); PG8_STAGE(PG8_SB(1, 0), b3, voffB); PG8_STAGE(PG8_SB(1, 1), b3 + hstep, voffB); PG8_STAGE(PG8_SA(1, 0), a3, voffA);
            PG8_WAIT_V(8); PG8_WAIT_L(0); PG8_BAR; PG8_MMA(1, 0, At, B0); PG8_MMA(1, 1, At, B1); PG8_BAR; PG8_SCHED;
            } else {
            PG8_LDB(B0, 0, 0); PG8_SCHED; PG8_LDA(At, 0, 0); PG8_STAGE(PG8_SA(1, 1), a1 + hstep, voffA);
            PG8_WAIT_L(8); PG8_BAR; PG8_WAIT_L(0); PG8_MMA(0, 0, At, B0); PG8_BAR; PG8_SCHED;
            PG8_LDB(B1, 0, 1); PG8_STAGE(PG8_SB(0, 0), b2, voffB);
            PG8_BAR; PG8_WAIT_L(0); PG8_MMA(0, 1, At, B1); PG8_BAR;
            PG8_LDA(At, 0, 1); PG8_STAGE(PG8_SA(0, 0), a2, voffA);
            PG8_BAR; PG8_WAIT_L(0); PG8_MMA(1, 0, At, B0); PG8_BAR; PG8_SCHED;
            PG8_STAGE(PG8_SB(0, 1), b2 + hstep, voffB);
            PG8_WAIT_V(6); PG8_BAR; PG8_MMA(1, 1, At, B1); PG8_BAR;
            PG8_LDB(B0, 1, 0); PG8_SCHED; PG8_LDA(At, 1, 0); PG8_STAGE(PG8_SA(0, 1), a2 + hstep, voffA);
            PG8_WAIT_L(8); PG8_BAR; PG8_WAIT_L(0); PG8_MMA(0, 0, At, B0); PG8_BAR; PG8_SCHED;
            PG8_LDB(B1, 1, 1); PG8_STAGE(PG8_SB(1, 0), b3, voffB);
            PG8_BAR; PG8_WAIT_L(0); PG8_MMA(0, 1, At, B1); PG8_BAR;
            PG8_LDA(At, 1, 1); PG8_STAGE(PG8_SA(1, 0), a3, voffA);
            PG8_BAR; PG8_WAIT_L(0); PG8_MMA(1, 0, At, B0); PG8_BAR; PG8_SCHED;
            PG8_STAGE(PG8_SB(1, 1), b3 + hstep, voffB);
            PG8_WAIT_V(6); PG8_BAR; PG8_MMA(1, 1, At, B1); PG8_BAR;
            }
        }
        if constexpr (ALIGN_EPI) { if (wr == 0) PG8_BAR; }
        if constexpr (!Epi::AFTER_DRAIN) { E(acc, cur, wr, wc, fr, fq); S.done(cur); }
        if (!has_next) break;
#pragma unroll
        for (int a = 0; a < 2; ++a)
#pragma unroll
            for (int b = 0; b < 2; ++b)
#pragma unroll
                for (int m = 0; m < 4; ++m)
#pragma unroll
                    for (int n = 0; n < 2; ++n) acc[a][b][m][n] = (f32x4){0.f, 0.f, 0.f, 0.f};
        cur = nxt; cA = nA; cB = nB; ++ui;
        if constexpr (ALIGN_EPI) { if (wr == 1) PG8_BAR; }
    }
    PG8_WAIT_V(0);
    if constexpr (!ALIGN_EPI) { if (wr == 0) PG8_BAR; }
    PG8_BAR;
    if constexpr (Epi::AFTER_DRAIN) { E.fused(acc, cur, wr, wc, fr, fq, lds, wid, lane); S.done(cur); }
#undef PG8_SA
#undef PG8_SB
#undef PG8_STAGE
#undef PG8_LDA
#undef PG8_LDB
#undef PG8_MMA
#undef PG8_WAIT_V
#undef PG8_WAIT_L
#undef PG8_BAR
#undef PG8_SCHED
}
}

#define LAS __attribute__((address_space(3)))
typedef unsigned short bf16_t;
typedef short bf16x8 __attribute__((ext_vector_type(8)));
typedef short s16x4 __attribute__((ext_vector_type(4)));
typedef float f32x4 __attribute__((ext_vector_type(4)));
typedef float f32x16 __attribute__((ext_vector_type(16)));
typedef unsigned u32x4 __attribute__((ext_vector_type(4)));
typedef unsigned u32x2 __attribute__((ext_vector_type(2)));

constexpr int NB = 8, SEQ = 4096, DM = 1024, CTXL = 256;
constexpr int ML = NB * SEQ, MC = NB * CTXL, MT = ML + MC;
constexpr int NIN = 3136, NINP = 3328, DFF = 2816, KVL = CTXL + SEQ;
constexpr int NCH = 68;
constexpr float EPS = 1e-6f;
constexpr size_t MiB = 1u << 20;
constexpr size_t WS_MOD = 0, WS_LBF = 256 * 1024, WS_LBB = 258 * 1024, WS_RCOS = 260 * 1024, WS_RSIN = 264 * 1024, WS_ROWSS = 512 * 1024;
constexpr size_t WS_WIN = 1 * MiB, WS_WUQ = 8 * MiB, WS_WUKV = 8 * MiB + 512 * 1024, WS_WOUT = 9 * MiB, WS_WGU = 11 * MiB, WS_WDN = 22 * MiB, WS_DG = 28 * MiB;
constexpr size_t WS_A = 32 * MiB;
constexpr size_t WS_CQ = 169 * MiB, WS_CKV = 186 * MiB, WS_HQ = 203 * MiB, WS_HI = 237 * MiB, WS_HG = 271 * MiB, WS_GF = 305 * MiB, WS_GB = 339 * MiB;
constexpr size_t WS_V = 373 * MiB, WS_MIX = 407 * MiB, WS_ACT = 169 * MiB, WS_RSSP = 471 * MiB, WS_BAR = 480 * MiB, WS_END = 481 * MiB;
constexpr int LDS_BYTES = 147456;

__device__ __forceinline__ unsigned f2bf(float f) { unsigned u = __builtin_bit_cast(unsigned, f); return (u + 0x7fffu + ((u >> 16) & 1u)) >> 16; }
__device__ __forceinline__ float bf2f(unsigned h) { return __builtin_bit_cast(float, h << 16); }
typedef __bf16 bf16v2_t __attribute__((ext_vector_type(2)));
__device__ __forceinline__ unsigned pk2(float lo, float hi) { bf16v2_t v; v.x = (__bf16)lo; v.y = (__bf16)hi; return __builtin_bit_cast(unsigned, v); }
__device__ __forceinline__ float wave_sum(float v) {
#pragma unroll
    for (int o = 1; o < 64; o <<= 1) v += __shfl_xor(v, o);
    return v;
}
__device__ __forceinline__ float sigmoidf_(float x) { return 1.f / (1.f + __expf(-x)); }
#define LDS_WAIT() asm volatile("s_waitcnt lgkmcnt(0)" ::: "memory")

struct Args {
    const float *x, *c, *ctx, *c_ctx, *w_mod, *b_mod, *g_mix, *g_ffn, *w_in, *g_qn, *w_uq, *g_kvn, *w_ukv, *lb_fwd, *lb_bwd, *g_on, *w_out, *w_gate, *w_up, *w_down, *g_final;
    float* out; unsigned char* ws; int ph_lo, ph_hi;
};

__device__ __forceinline__ void p0_mod_item(const Args& a, char* ldsc, int item) {
    float* sl = (float*)ldsc;
    float* red = sl + 9216;
    const int tid = threadIdx.x, wave = tid >> 6, lane = tid & 63;
    for (int i = tid; i < 9216; i += 512) { const float v = (i < 8192) ? a.c[i] : a.c_ctx[i - 8192]; sl[i] = v * sigmoidf_(v); }
    __syncthreads();
    float acc[9];
#pragma unroll
    for (int r = 0; r < 9; ++r) acc[r] = 0.f;
    const float* wp = a.w_mod + (size_t)(wave * 128) * 6144 + item * 64 + lane;
#pragma unroll 4
    for (int k = 0; k < 128; ++k) {
        const float w = wp[(size_t)k * 6144];
#pragma unroll
        for (int r = 0; r < 9; ++r) acc[r] += sl[r * 1024 + wave * 128 + k] * w;
    }
#pragma unroll
    for (int r = 0; r < 9; ++r) red[(wave * 9 + r) * 64 + lane] = acc[r];
    __syncthreads();
    float* MOD = (float*)(a.ws + WS_MOD);
    for (int i = tid; i < 576; i += 512) {
        const int r = i >> 6, l = i & 63; float s = 0.f;
#pragma unroll
        for (int w = 0; w < 8; ++w) s += red[(w * 9 + r) * 64 + l];
        MOD[r * 6144 + item * 64 + l] = s + a.b_mod[item * 64 + l];
    }
    __syncthreads();
}
__device__ __forceinline__ void p0_transpose_item(const float* W, int N, bf16_t* WT, int Kd, int drow0, const float* kscale, float* scr, int k0, int n0, int lane) {
#pragma unroll 8
    for (int i = 0; i < 32; ++i) { const int kk = 2 * i + (lane >> 5); float v = W[(size_t)(k0 + kk) * N + n0 + (lane & 31)]; if (kscale) v *= kscale[k0 + kk]; scr[kk * 33 + (lane & 31)] = v; }
    LDS_WAIT(); asm volatile("" ::: "memory");
    const int c = lane & 7;
#pragma unroll
    for (int j = 0; j < 4; ++j) { const int n = (lane >> 3) + 8 * j; const float* s = scr + (8 * c) * 33 + n;
        u32x4 o; o.x = pk2(s[0 * 33], s[1 * 33]); o.y = pk2(s[2 * 33], s[3 * 33]); o.z = pk2(s[4 * 33], s[5 * 33]); o.w = pk2(s[6 * 33], s[7 * 33]);
        *(u32x4*)(WT + (size_t)(drow0 + n) * Kd + k0 + 8 * c) = o; }
    LDS_WAIT(); asm volatile("" ::: "memory");
}
__device__ __forceinline__ void p0_prologue(const Args& a, char* ldsc, int G) {
    const int tid = threadIdx.x, wave = tid >> 6, lane = tid & 63;
    unsigned char* ws = a.ws;
    if (blockIdx.x < 96) p0_mod_item(a, ldsc, blockIdx.x);
    if ((int)blockIdx.x == G - 1) {
        float* LBF = (float*)(ws + WS_LBF); float* LBB = (float*)(ws + WS_LBB);
        LBF[tid] = 1.f / (1.f + __expf(a.lb_fwd[512 + tid] - a.lb_fwd[tid]));
        LBB[tid] = 1.f / (1.f + __expf(a.lb_bwd[512 + tid] - a.lb_bwd[tid]));
        float* RC = (float*)(ws + WS_RCOS); float* RS = (float*)(ws + WS_RSIN);
        for (int i = tid; i < 1024; i += 512) {
            const int pos = i >> 4, fi = i & 15;
            const float inv = exp2f(-(float)fi * (13.287712379549449f / 16.f));
            const float ang = (float)pos * inv;
            const float kq = rintf(ang * 0.15915494309189535f);
            float r = fmaf(-kq, 6.28125f, ang); r = fmaf(-kq, 0.0019353071795864769f, r);
            RC[i] = __cosf(r); RS[i] = __sinf(r);
        }
    }
    { u32x4* pz = (u32x4*)(ws + WS_WIN + (size_t)NIN * 1024 * 2); const u32x4 z = {0u, 0u, 0u, 0u};
      for (int i = blockIdx.x * 512 + tid; i < (NINP - NIN) * 1024 * 2 / 16; i += G * 512) pz[i] = z; }
    float* scr = (float*)(ldsc + wave * 16384);
    const int gw = blockIdx.x * 8 + wave, NGW = G * 8;
    constexpr int I_IN = 16 * 98, I_UQ = 4 * 24, I_UKV = 4 * 32, I_OUT = 16 * 32, I_G = 16 * 88, I_DN = 44 * 32;
    constexpr int NITEMS = I_IN + I_UQ + I_UKV + I_OUT + 2 * I_G + I_DN;
    for (int it = gw; it < NITEMS; it += NGW) {
        int r = it;
        if (r < I_IN) { const int kb = r / 98, nb = r % 98; p0_transpose_item(a.w_in, NIN, (bf16_t*)(ws + WS_WIN), 1024, 32 * nb, nullptr, scr, 64 * kb, 32 * nb, lane); continue; } r -= I_IN;
        if (r < I_UQ) { const int kb = r / 24, nb = r % 24; p0_transpose_item(a.w_uq, 768, (bf16_t*)(ws + WS_WUQ), 256, 32 * nb, a.g_qn, scr, 64 * kb, 32 * nb, lane); continue; } r -= I_UQ;
        if (r < I_UKV) { const int kb = r / 32, nb = r % 32; p0_transpose_item(a.w_ukv, 1024, (bf16_t*)(ws + WS_WUKV), 256, 32 * nb, a.g_kvn, scr, 64 * kb, 32 * nb, lane); continue; } r -= I_UKV;
        if (r < I_OUT) { const int kb = r / 32, nb = r % 32; p0_transpose_item(a.w_out, 1024, (bf16_t*)(ws + WS_WOUT), 1024, 32 * nb, nullptr, scr, 64 * kb, 32 * nb, lane); continue; } r -= I_OUT;
        if (r < 2 * I_G) { const int up = r >= I_G; if (up) r -= I_G; const int kb = r / 88, nb = r % 88, n0 = 32 * nb;
            const int drow = (n0 >> 7) * 256 + (n0 & 127) + (up ? 128 : 0);
            p0_transpose_item(up ? a.w_up : a.w_gate, DFF, (bf16_t*)(ws + WS_WGU), 1024, drow, nullptr, scr, 64 * kb, n0, lane); continue; } r -= 2 * I_G;
        { const int kb = r / 32, nb = r % 32; p0_transpose_item(a.w_down, 1024, (bf16_t*)(ws + WS_WDN), DFF, 32 * nb, nullptr, scr, 64 * kb, 32 * nb, lane); }
    }
}

__device__ __forceinline__ void row_norm_mod_bf16(const float* src, const float* g, const float* sh, const float* sc, bf16_t* dst, int lane) {
    const f32x4* xr = (const f32x4*)src + lane;
    f32x4 v[4]; float s = 0.f;
#pragma unroll
    for (int j = 0; j < 4; ++j) { v[j] = xr[64 * j]; s += (v[j].x * v[j].x + v[j].y * v[j].y) + (v[j].z * v[j].z + v[j].w * v[j].w); }
    const float rstd = rsqrtf(wave_sum(s) * (1.f / 1024.f) + EPS);
    u32x2* o8 = (u32x2*)dst + lane;
#pragma unroll
    for (int j = 0; j < 4; ++j) {
        const f32x4 gg = ((const f32x4*)g)[lane + 64 * j], s1 = ((const f32x4*)sc)[lane + 64 * j], s0 = ((const f32x4*)sh)[lane + 64 * j];
        const f32x4 y = v[j] * rstd * gg * (s1 + 1.f) + s0;
        u32x2 w; w.x = pk2(y.x, y.y); w.y = pk2(y.z, y.w); o8[64 * j] = w;
    }
}
__device__ __forceinline__ void row_norm_f32(float* row, const float* g, int lane) {
    f32x4* xr = (f32x4*)row + lane;
    f32x4 v[4]; float s = 0.f;
#pragma unroll
    for (int j = 0; j < 4; ++j) { v[j] = xr[64 * j]; s += (v[j].x * v[j].x + v[j].y * v[j].y) + (v[j].z * v[j].z + v[j].w * v[j].w); }
    const float rstd = rsqrtf(wave_sum(s) * (1.f / 1024.f) + EPS);
#pragma unroll
    for (int j = 0; j < 4; ++j) { f32x4 o = v[j] * rstd * ((const f32x4*)g)[lane + 64 * j];
#ifdef SANITIZE
        o.x = __builtin_isfinite(o.x) ? o.x : 1000.f; o.y = __builtin_isfinite(o.y) ? o.y : 1000.f; o.z = __builtin_isfinite(o.z) ? o.z : 1000.f; o.w = __builtin_isfinite(o.w) ? o.w : 1000.f;
#endif
        xr[64 * j] = o; }
}

__device__ __forceinline__ void rope8(float (&v)[8], int fq, const float* rc, const float* rs, int pos, bool apply) {
    const int ib = pos * 16 + 8 * (fq & 1);
#pragma unroll
    for (int e = 0; e < 8; ++e) {
        const float partner = __shfl_xor(v[e], 32);
        const float cs = rc[ib + e], sn = rs[ib + e];
        const float r = (fq < 2) ? (v[e] * cs - partner * sn) : (v[e] * cs + partner * sn);
        v[e] = apply ? r : v[e];
    }
}
__device__ __forceinline__ u32x4 pack8(const float (&v)[8]) { u32x4 w; w.x = pk2(v[0], v[1]); w.y = pk2(v[2], v[3]); w.z = pk2(v[4], v[5]); w.w = pk2(v[6], v[7]); return w; }

struct EpiInProj {
    static constexpr bool PERM = true, AFTER_DRAIN = false;
    unsigned char* ws; bf16_t* Kb;
    __device__ __forceinline__ void operator()(const pg8::f32x4 (&acc)[2][2][4][2], const pg8::Unit& u, int wr, int wc, int fr, int fq) const {
        float* RSS = (float*)(ws + WS_RSSP); const float* RC = (const float*)(ws + WS_RCOS); const float* RS = (const float*)(ws + WS_RSIN);
#pragma unroll
        for (int bj = 0; bj < 2; ++bj) {
            const int cbase = u.pn * 256 + bj * 128 + wc * 32;
            if (cbase >= NIN) continue;
            const int c0 = cbase + 8 * fq;
#pragma unroll
            for (int ai = 0; ai < 2; ++ai)
#pragma unroll
                for (int m = 0; m < 4; ++m) {
                    const int row = u.pm * 256 + ai * 128 + wr * 64 + m * 16 + fr;
                    float v[8];
#pragma unroll
                    for (int e = 0; e < 4; ++e) { v[e] = acc[ai][bj][m][0][e]; v[4 + e] = acc[ai][bj][m][1][e]; }
                    if (cbase < 512) {
                        bf16_t* dst = (bf16_t*)(ws + WS_CQ + (cbase < 256 ? (size_t)0 : (WS_CKV - WS_CQ))) + (size_t)row * 256 + (c0 & 255);
                        *(u32x4*)dst = pack8(v);
                        float ss = 0.f;
#pragma unroll
                        for (int e = 0; e < 8; ++e) ss += v[e] * v[e];
                        ss += __shfl_xor(ss, 16); ss += __shfl_xor(ss, 32);
                        if (fq == 0) RSS[((size_t)row * 2 + (cbase < 256 ? 0 : 1)) * 8 + bj * 4 + wc] = ss;
                    } else if (cbase < 576) {
                        const int axis = (cbase - 512) >> 5;
                        const bool lat = row < ML;
                        const int n = row & 4095;
                        const int pos = axis ? (n & 63) : (n >> 6);
                        rope8(v, fq, RC, RS, lat ? pos : 0, lat);
                        const int b = lat ? (row >> 12) : ((row - ML) >> 8);
                        const int kvpos = lat ? (CTXL + n) : ((row - ML) & 255);
                        const u32x4 w = pack8(v);
#pragma unroll
                        for (int h = 0; h < 4; ++h) *(u32x4*)(Kb + ((size_t)(b * 4 + h) * KVL + kvpos) * 192 + 128 + axis * 32 + 8 * fq) = w;
                    } else if (cbase < 2112) {
                        const int seg = (cbase - 576) >> 9;
                        bf16_t* base = (bf16_t*)(ws + WS_HQ + (size_t)seg * (WS_HI - WS_HQ));
                        *(u32x4*)(base + (size_t)row * 512 + (c0 - 576 - seg * 512)) = pack8(v);
                    } else {
                        const int dirn = (cbase - 2112) >> 9, j = c0 - 2112 - dirn * 512;
                        const float* lbp = (const float*)(ws + WS_LBF + (size_t)dirn * (WS_LBB - WS_LBF)) + j;
                        typedef _Float16 h8 __attribute__((ext_vector_type(8)));
                        h8 o;
#pragma unroll
                        for (int e = 0; e < 8; ++e) { const float lb = lbp[e]; const float f = lb + (1.f - lb) * sigmoidf_(v[e]); o[e] = (_Float16)__logf(f); }
                        *(h8*)((_Float16*)(ws + WS_GF + (size_t)dirn * (WS_GB - WS_GF)) + (size_t)row * 512 + j) = o;
                    }
                }
        }
    }
};
struct EpiQ {
    static constexpr bool PERM = true, AFTER_DRAIN = false;
    bf16_t* Q; const float* RSS; const float *RC, *RS;
    __device__ __forceinline__ void operator()(const pg8::f32x4 (&acc)[2][2][4][2], const pg8::Unit& u, int wr, int wc, int fr, int fq) const {
#pragma unroll
        for (int bj = 0; bj < 2; ++bj) {
            const int cbase = u.pn * 256 + bj * 128 + wc * 32;
            const int h = cbase / 192, d0 = cbase - h * 192;
            const bool rope = d0 >= 128; const int axis = (d0 - 128) >> 5;
#pragma unroll
            for (int ai = 0; ai < 2; ++ai)
#pragma unroll
                for (int m = 0; m < 4; ++m) {
                    const int row = u.pm * 256 + ai * 128 + wr * 64 + m * 16 + fr;
                    const f32x4 s0 = *(const f32x4*)(RSS + (size_t)row * 16), s1 = *(const f32x4*)(RSS + (size_t)row * 16 + 4);
                    const float rstd = rsqrtf((((s0.x + s0.y) + (s0.z + s0.w)) + ((s1.x + s1.y) + (s1.z + s1.w))) * (1.f / 256.f) + EPS);
                    float v[8];
#pragma unroll
                    for (int e = 0; e < 4; ++e) { v[e] = acc[ai][bj][m][0][e] * rstd; v[4 + e] = acc[ai][bj][m][1][e] * rstd; }
                    const int b = row >> 12, n = row & 4095;
                    if (rope) { const int pos = axis ? (n & 63) : (n >> 6); rope8(v, fq, RC, RS, pos, true); }
                    *(u32x4*)(Q + ((size_t)(b * 4 + h) * SEQ + n) * 192 + d0 + 8 * fq) = pack8(v);
                    asm volatile("" ::: "memory");
                }
        }
    }
};
struct EpiKV {
    static constexpr bool PERM = true, AFTER_DRAIN = false;
    bf16_t *Kb, *Vb; const float* RSS;
    __device__ __forceinline__ void operator()(const pg8::f32x4 (&acc)[2][2][4][2], const pg8::Unit& u, int wr, int wc, int fr, int fq) const {
#pragma unroll
        for (int bj = 0; bj < 2; ++bj) {
            const int cbase = u.pn * 256 + bj * 128 + wc * 32;
            const int h = cbase >> 8, j0 = cbase & 255;
#pragma unroll
            for (int ai = 0; ai < 2; ++ai)
#pragma unroll
                for (int m = 0; m < 4; ++m) {
                    const int row = u.pm * 256 + ai * 128 + wr * 64 + m * 16 + fr;
                    const f32x4 s0 = *(const f32x4*)(RSS + (size_t)row * 16 + 8), s1 = *(const f32x4*)(RSS + (size_t)row * 16 + 12);
                    const float rstd = rsqrtf((((s0.x + s0.y) + (s0.z + s0.w)) + ((s1.x + s1.y) + (s1.z + s1.w))) * (1.f / 256.f) + EPS);
                    float v[8];
#pragma unroll
                    for (int e = 0; e < 4; ++e) { v[e] = acc[ai][bj][m][0][e] * rstd; v[4 + e] = acc[ai][bj][m][1][e] * rstd; }
                    const bool lat = row < ML;
                    const int b = lat ? (row >> 12) : ((row - ML) >> 8);
                    const int kvpos = lat ? (CTXL + (row & 4095)) : ((row - ML) & 255);
                    const size_t r = (size_t)(b * 4 + h) * KVL + kvpos;
                    if (j0 < 128) *(u32x4*)(Kb + r * 192 + j0 + 8 * fq) = pack8(v);
                    else          *(u32x4*)(Vb + r * 128 + (j0 - 128) + 8 * fq) = pack8(v);
                    asm volatile("" ::: "memory");
                }
        }
    }
};
struct EpiRes {
    static constexpr bool PERM = false, AFTER_DRAIN = false;
    const float* base; float* out; const float* gate;
    __device__ __forceinline__ void operator()(const pg8::f32x4 (&acc)[2][2][4][2], const pg8::Unit& u, int wr, int wc, int fr, int fq) const {
#pragma unroll
        for (int ai = 0; ai < 2; ++ai)
#pragma unroll
            for (int m = 0; m < 4; ++m) {
                const int row = u.pm * 256 + ai * 128 + wr * 64 + m * 16 + fr;
                const float* gp = gate + (size_t)(row >> 12) * 6144;
#pragma unroll
                for (int bj = 0; bj < 2; ++bj)
#pragma unroll
                    for (int n = 0; n < 2; ++n) {
                        const int c = u.pn * 256 + bj * 128 + wc * 32 + 16 * n + 4 * fq;
                        const f32x4 g = *(const f32x4*)(gp + c), bs = *(const f32x4*)(base + (size_t)row * 1024 + c);
                        const pg8::f32x4 a4 = acc[ai][bj][m][n];
                        f32x4 o; o.x = bs.x + g.x * a4[0]; o.y = bs.y + g.y * a4[1]; o.z = bs.z + g.z * a4[2]; o.w = bs.w + g.w * a4[3];
                        *(f32x4*)(out + (size_t)row * 1024 + c) = o;
                    }
            }
    }
};
struct EpiSwiglu {
    static constexpr bool PERM = true, AFTER_DRAIN = false;
    bf16_t* ACT;
    __device__ __forceinline__ void operator()(const pg8::f32x4 (&acc)[2][2][4][2], const pg8::Unit& u, int wr, int wc, int fr, int fq) const {
#pragma unroll
        for (int ai = 0; ai < 2; ++ai)
#pragma unroll
            for (int m = 0; m < 4; ++m) {
                const int row = u.pm * 256 + ai * 128 + wr * 64 + m * 16 + fr;
                float v[8];
#pragma unroll
                for (int n = 0; n < 2; ++n)
#pragma unroll
                    for (int e = 0; e < 4; ++e) { const float g = acc[ai][0][m][n][e], uu = acc[ai][1][m][n][e]; v[4 * n + e] = g * sigmoidf_(g) * uu; }
                *(u32x4*)(ACT + (size_t)row * DFF + u.pn * 128 + wc * 32 + 8 * fq) = pack8(v);
            }
    }
};

#ifndef ATT_QREG
#define ATT_QREG 2
#endif
namespace att {
constexpr int NW = 8, QBLK = 32, KVBLK = 64;
constexpr float SCALE = 0.07216878364870322f;
constexpr float THR = 8.f;
constexpr int LDQ = 192, LDK = 192, LDV = 128, LDO = 1024;
constexpr int SHM_V = KVBLK * 128 * 2, SHM_K = KVBLK * 192 * 2, SHM_ATTN = 2 * SHM_V + 2 * SHM_K;
static_assert(SHM_ATTN <= 163840, "attention LDS");
#define KSWZ(row, colB) ((row) * 384 + ((colB) ^ (((row) & 7) << 4)))
#define SBAR() __builtin_amdgcn_sched_barrier(0)
__device__ __forceinline__ int crow(int r, int hi) { return (r & 3) + 8 * (r >> 2) + 4 * hi; }
__device__ __forceinline__ unsigned cvtpk(float lo, float hi) { return pk2(lo, hi); }
__device__ __forceinline__ void partialSM(f32x16& p0, f32x16& p1, float& m_reg, float& mn, float& alpha) {
  constexpr float C = SCALE * 1.4426950408889634f;
  float pmax = p0[0];
#pragma unroll
  for (int r = 1; r < 16; ++r) pmax = fmaxf(pmax, p0[r]);
#pragma unroll
  for (int r = 0; r < 16; ++r) pmax = fmaxf(pmax, p1[r]);
  { auto rr = __builtin_amdgcn_permlane32_swap(__float_as_uint(pmax), __float_as_uint(pmax), false, false);
    pmax = fmaxf(__uint_as_float(rr[0]), __uint_as_float(rr[1])); }
  if (__builtin_expect(__all(pmax - m_reg <= THR / SCALE), 1)) { mn = m_reg; alpha = 1.f; }
  else { mn = fmaxf(m_reg, pmax); alpha = __builtin_amdgcn_exp2f((m_reg - mn) * C); m_reg = mn; }
  float mnC = -mn * C;
#pragma unroll
  for (int r = 0; r < 16; ++r) p0[r] = fmaf(p0[r], C, mnC);
#pragma unroll
  for (int r = 0; r < 16; ++r) p1[r] = fmaf(p1[r], C, mnC);
#pragma unroll
  for (int r = 0; r < 16; ++r) p0[r] = __builtin_amdgcn_exp2f(p0[r]);
}
__device__ __forceinline__ void finishSM(f32x16& p0, f32x16& p1, float alpha, float& l_reg, bf16x8& pa0, bf16x8& pa1, bf16x8& pa2, bf16x8& pa3) {
#pragma unroll
  for (int r = 0; r < 16; ++r) p1[r] = __builtin_amdgcn_exp2f(p1[r]);
  float ps = 0;
#pragma unroll
  for (int r = 0; r < 16; ++r) ps += p0[r];
#pragma unroll
  for (int r = 0; r < 16; ++r) ps += p1[r];
  { auto rr = __builtin_amdgcn_permlane32_swap(__float_as_uint(ps), __float_as_uint(ps), false, false);
    ps = __uint_as_float(rr[0]) + __uint_as_float(rr[1]); }
  l_reg = l_reg * alpha + ps;
#define PK4(P, BASE, OUT) do { unsigned a0 = cvtpk(P[BASE + 0], P[BASE + 1]), a1 = cvtpk(P[BASE + 2], P[BASE + 3]);   \
    unsigned b0 = cvtpk(P[BASE + 4], P[BASE + 5]), b1 = cvtpk(P[BASE + 6], P[BASE + 7]);                              \
    auto r0 = __builtin_amdgcn_permlane32_swap(a0, b0, false, false); auto r1 = __builtin_amdgcn_permlane32_swap(a1, b1, false, false); \
    u32x4 w = {r0[0], r1[0], r0[1], r1[1]}; OUT = *reinterpret_cast<bf16x8*>(&w); } while (0)
  PK4(p0, 0, pa0); PK4(p0, 8, pa1); PK4(p1, 0, pa2); PK4(p1, 8, pa3);
#undef PK4
}
__device__ __forceinline__ void qkt(f32x16& p0, f32x16& p1, const char* Ks, const bf16x8* qr, int r32, int hi) {
  p0 = f32x16{}; p1 = f32x16{};
#pragma unroll
  for (int d0 = 0; d0 < 12; ++d0) { int cb = (d0 * 16 + hi * 8) * 2;
    bf16x8 b0 = *reinterpret_cast<const bf16x8*>(Ks + KSWZ(r32, cb));
    bf16x8 b1 = *reinterpret_cast<const bf16x8*>(Ks + KSWZ(32 + r32, cb));
    p0 = __builtin_amdgcn_mfma_f32_32x32x16_bf16(b0, qr[d0], p0, 0, 0, 0);
    p1 = __builtin_amdgcn_mfma_f32_32x32x16_bf16(b1, qr[d0], p1, 0, 0, 0); }
}
__device__ __forceinline__ int v_st(int k, int c) { const int kk = (k & ~0xC) | ((k & 4) << 1) | ((k & 8) >> 1); return ((kk >> 3) * 4 + (c >> 5)) * 512 + ((kk & 7) * 32 + (c & 31)) * 2; }
__device__ __forceinline__ int v_rd_base(int lane) { return ((lane & 3) << 3) | (((lane >> 2) & 3) << 6) | (((lane >> 4) & 1) << 5) | (((lane >> 5) & 1) << 8); }
constexpr int v_rd_off(int d0, int ks, int half) { return d0 * 512 + ks * 4096 + half * 2048; }
template <int OFF> __device__ __forceinline__ s16x4 tr_read(int vb) {
  s16x4 r; asm volatile("ds_read_b64_tr_b16 %0, %1 offset:%2" : "=&v"(r) : "v"(vb), "i"(OFF) : "memory"); return r;
}
template <int D0> __device__ __forceinline__ void pv_one(f32x16& od, int vb, bf16x8 pa0, bf16x8 pa1, bf16x8 pa2, bf16x8 pa3) {
  const s16x4 l0 = tr_read<v_rd_off(D0, 0, 0)>(vb), h0 = tr_read<v_rd_off(D0, 0, 1)>(vb), l1 = tr_read<v_rd_off(D0, 1, 0)>(vb), h1 = tr_read<v_rd_off(D0, 1, 1)>(vb);
  const s16x4 l2 = tr_read<v_rd_off(D0, 2, 0)>(vb), h2 = tr_read<v_rd_off(D0, 2, 1)>(vb), l3 = tr_read<v_rd_off(D0, 3, 0)>(vb), h3 = tr_read<v_rd_off(D0, 3, 1)>(vb);
  asm volatile("s_waitcnt lgkmcnt(0)" ::: "memory"); SBAR();
#define PK(L, H) (bf16x8){L[0], L[1], L[2], L[3], H[0], H[1], H[2], H[3]}
  od = __builtin_amdgcn_mfma_f32_32x32x16_bf16(pa0, PK(l0, h0), od, 0, 0, 0);
  od = __builtin_amdgcn_mfma_f32_32x32x16_bf16(pa1, PK(l1, h1), od, 0, 0, 0);
  od = __builtin_amdgcn_mfma_f32_32x32x16_bf16(pa2, PK(l2, h2), od, 0, 0, 0);
  od = __builtin_amdgcn_mfma_f32_32x32x16_bf16(pa3, PK(l3, h3), od, 0, 0, 0);
#undef PK
}
__device__ __forceinline__ void pv_d0(f32x16* o, int vb, bf16x8 pa0, bf16x8 pa1, bf16x8 pa2, bf16x8 pa3) {
  pv_one<0>(o[0], vb, pa0, pa1, pa2, pa3); pv_one<1>(o[1], vb, pa0, pa1, pa2, pa3); pv_one<2>(o[2], vb, pa0, pa1, pa2, pa3); pv_one<3>(o[3], vb, pa0, pa1, pa2, pa3);
}
__device__ __forceinline__ void attn_body(const bf16_t* __restrict__ Qb, const bf16_t* __restrict__ Kh, const bf16_t* __restrict__ Vh, bf16_t* __restrict__ Ob, int seq, char* lds) {
  const int tid = threadIdx.x, wid = tid >> 6, lane = tid & 63, r32 = lane & 31, hi = lane >> 5;
  char* V_lds = lds; char* K_lds = lds + 2 * SHM_V;
  float m_reg = -1e30f, l_reg = 0; f32x16 o[4] = {}; bf16x8 qr[12];
  const bf16_t* Qw = Qb + (long)(wid * QBLK + r32) * LDQ + hi * 8;
#pragma unroll
  for (int d0 = 0; d0 < 12; ++d0) qr[d0] = *reinterpret_cast<const bf16x8*>(Qw + d0 * 16);
  const int sr = tid >> 4, sc = (tid & 15) * 8, vst0 = v_st(sr, sc), vst1 = v_st(32 + sr, sc);
  const int kid0 = tid, kid1 = tid + 512, kid2 = tid + 1024;
  const int kr0 = kid0 / 24, kc0 = kid0 % 24, kr1 = kid1 / 24, kc1 = kid1 % 24, kr2 = kid2 / 24, kc2 = kid2 % 24;
  const int kg0 = kr0 * LDK + kc0 * 8, kg1 = kr1 * LDK + kc1 * 8, kg2 = kr2 * LDK + kc2 * 8;
  const int kl0 = KSWZ(kr0, kc0 * 16), kl1 = KSWZ(kr1, kc1 * 16), kl2 = KSWZ(kr2, kc2 * 16);
  const int vb0 = (int)(uintptr_t)V_lds + v_rd_base(lane);
  bf16x8 sA_v0, sA_v1, sA_k0, sA_k1, sA_k2;
#define SLOADA(k0) do { sA_v0 = *(const bf16x8*)&Vh[(long)((k0) + sr) * LDV + sc]; sA_v1 = *(const bf16x8*)&Vh[(long)((k0) + 32 + sr) * LDV + sc]; \
    sA_k0 = *(const bf16x8*)&Kh[(long)(k0) * LDK + kg0]; sA_k1 = *(const bf16x8*)&Kh[(long)(k0) * LDK + kg1]; sA_k2 = *(const bf16x8*)&Kh[(long)(k0) * LDK + kg2]; } while (0)
#define SWRITEA(b) do { *(bf16x8*)(V_lds + (b) * SHM_V + vst0) = sA_v0; *(bf16x8*)(V_lds + (b) * SHM_V + vst1) = sA_v1; \
    *(bf16x8*)(K_lds + (b) * SHM_K + kl0) = sA_k0; *(bf16x8*)(K_lds + (b) * SHM_K + kl1) = sA_k1; *(bf16x8*)(K_lds + (b) * SHM_K + kl2) = sA_k2; } while (0)
#define SWAIT() asm volatile("s_waitcnt vmcnt(0)" ::: "memory")
#define RESC(a) do { if (__any((a) < 1.f)) { \
    _Pragma("unroll") for (int r = 0; r < 16; ++r) { const float al_ = __shfl((a), crow(r, hi)); _Pragma("unroll") for (int d = 0; d < 4; ++d) o[d][r] *= al_; } } } while (0)
  const int NT = seq / KVBLK;
  SLOADA(0); SWAIT(); SWRITEA(0); __syncthreads();
#pragma unroll 1
  for (int j = 0; j < NT; ++j) {
    const int b = j & 1;
    if (j + 1 < NT) SLOADA((j + 1) * KVBLK);
    f32x16 p0, p1; float mn, al; bf16x8 pa0, pa1, pa2, pa3;
    SBAR(); qkt(p0, p1, K_lds + b * SHM_K, qr, r32, hi);
    partialSM(p0, p1, m_reg, mn, al);
    RESC(al);
    finishSM(p0, p1, al, l_reg, pa0, pa1, pa2, pa3); SBAR();
    pv_d0(o, vb0 + b * SHM_V, pa0, pa1, pa2, pa3);
    if (j + 1 < NT) { SWAIT(); SWRITEA(b ^ 1); }
    __syncthreads();
  }
  float rli[16];
#pragma unroll
  for (int r = 0; r < 16; ++r) rli[r] = __builtin_amdgcn_rcpf(__shfl(l_reg, crow(r, hi)));
  bf16_t* Ow = Ob + (long)(wid * QBLK) * LDO;
#pragma unroll
  for (int r = 0; r < 16; ++r) { int orow = crow(r, hi);
#pragma unroll
    for (int d0 = 0; d0 < 4; ++d0) Ow[(long)orow * LDO + d0 * 32 + r32] = (bf16_t)f2bf(o[d0][r] * rli[r]); }
  asm volatile("s_waitcnt vmcnt(0)" ::: "memory");
  __syncthreads();
#undef SLOADA
#undef SWRITEA
#undef SWAIT
#undef RESC
}
}

__device__ __forceinline__ int hgrn_chunk_row0(int dir, int b, int p) {
    if (p < 4) return ML + b * CTXL + 64 * (dir ? 3 - p : p);
    return b * SEQ + 64 * (dir ? 63 - (p - 4) : p - 4);
}
__device__ __forceinline__ void hgrn_cumsum(const _Float16* G, int k, int qd, int dir, float* qt, float (&gv)[16], float (&bl)[16], float& tot, float& bref) {
#pragma unroll
    for (int i = 0; i < 16; ++i) gv[i] = (float)G[(size_t)(16 * qd + i) * 512 + k];
    float run = 0.f;
    if (dir == 0) {
#pragma unroll
        for (int i = 0; i < 16; ++i) { run += gv[i]; bl[i] = run; }
    } else {
#pragma unroll
        for (int i = 15; i >= 0; --i) { run += gv[i]; bl[i] = run; }
    }
    qt[qd * 128 + k] = run;
    __syncthreads();
    const float q0 = qt[k], q1 = qt[128 + k], q2 = qt[256 + k], q3 = qt[384 + k];
    tot = (q0 + q1) + (q2 + q3);
    float off;
    if (dir == 0) { off = (qd > 0 ? q0 : 0.f) + (qd > 1 ? q1 : 0.f) + (qd > 2 ? q2 : 0.f); bref = q0 + q1; }
    else          { off = (qd < 3 ? q3 : 0.f) + (qd < 2 ? q2 : 0.f) + (qd < 1 ? q1 : 0.f); bref = q2 + q3; }
#pragma unroll
    for (int i = 0; i < 16; ++i) bl[i] += off;
}
__device__ __forceinline__ void hgrn_passA(const Args& a, char* lds, int item) {
    const int tid = threadIdx.x, wave = tid >> 6, lane = tid & 63, r32 = lane & 31, hi = lane >> 5;
    const int dir = item / (32 * NCH), rem = item % (32 * NCH), bh = rem / NCH, p = rem % NCH, b = bh >> 2, h = bh & 3;
#ifdef EXPR_SKIPCTX
    if (p < 4) return;
#endif
#ifdef EXPR_ONLYCTX
    if (p >= 4) return;
#endif
    const int row0 = hgrn_chunk_row0(dir, b, p);
    const _Float16* G = (const _Float16*)(a.ws + (dir ? WS_GB : WS_GF)) + (size_t)row0 * 512 + h * 128;
    const bf16_t* Vp = (const bf16_t*)(a.ws + WS_HI) + (size_t)row0 * 512 + h * 128;
    char* Kt = lds; char* Vt = lds + 128 * 144; float* qt = (float*)(lds + 2 * 128 * 144);
    const int k = tid & 127, qd = tid >> 7;
    float gv[16], bl[16], tot, bref;
    hgrn_cumsum(G, k, qd, dir, qt, gv, bl, tot, bref);
    unsigned kw[8], vw[8];
#pragma unroll
    for (int i = 0; i < 8; ++i) {
        const float k0 = (1.f - __expf(gv[2 * i])) * __expf(tot - bl[2 * i]), k1 = (1.f - __expf(gv[2 * i + 1])) * __expf(tot - bl[2 * i + 1]);
        kw[i] = pk2(k0, k1);
        vw[i] = (unsigned)Vp[(size_t)(16 * qd + 2 * i) * 512 + k] | ((unsigned)Vp[(size_t)(16 * qd + 2 * i + 1) * 512 + k] << 16);
    }
    *(u32x4*)(Kt + k * 144 + qd * 32) = (u32x4){kw[0], kw[1], kw[2], kw[3]}; *(u32x4*)(Kt + k * 144 + qd * 32 + 16) = (u32x4){kw[4], kw[5], kw[6], kw[7]};
    *(u32x4*)(Vt + k * 144 + qd * 32) = (u32x4){vw[0], vw[1], vw[2], vw[3]}; *(u32x4*)(Vt + k * 144 + qd * 32 + 16) = (u32x4){vw[4], vw[5], vw[6], vw[7]};
    const size_t slot = (size_t)(dir * 32 + bh) * NCH + p;
    if (qd == 0) ((float*)(a.ws + WS_DG))[slot * 128 + k] = __expf(tot);
    __syncthreads();
    const int kb = wave >> 1, vb0 = (wave & 1) * 2;
    f32x16 acc0 = {}, acc1 = {};
#pragma unroll
    for (int ks = 0; ks < 4; ++ks) {
        const bf16x8 af = *(const bf16x8*)(Kt + (32 * kb + r32) * 144 + ks * 32 + hi * 16);
        const bf16x8 b0 = *(const bf16x8*)(Vt + (32 * vb0 + r32) * 144 + ks * 32 + hi * 16);
        const bf16x8 b1 = *(const bf16x8*)(Vt + (32 * (vb0 + 1) + r32) * 144 + ks * 32 + hi * 16);
        acc0 = __builtin_amdgcn_mfma_f32_32x32x16_bf16(af, b0, acc0, 0, 0, 0);
        acc1 = __builtin_amdgcn_mfma_f32_32x32x16_bf16(af, b1, acc1, 0, 0, 0);
    }
    bf16_t* Lt = (bf16_t*)(a.ws + WS_A) + slot * 16384;
#pragma unroll
    for (int rg = 0; rg < 4; ++rg) {
        const int k4 = 32 * kb + 8 * rg + 4 * hi;
        u32x2 w0, w1; w0.x = pk2(acc0[4 * rg], acc0[4 * rg + 1]); w0.y = pk2(acc0[4 * rg + 2], acc0[4 * rg + 3]);
        w1.x = pk2(acc1[4 * rg], acc1[4 * rg + 1]); w1.y = pk2(acc1[4 * rg + 2], acc1[4 * rg + 3]);
#ifdef EXPT1
        w0.x = 0x3f803f80u; w0.y = 0x3f803f80u; w1.x = 0x3f803f80u; w1.y = 0x3f803f80u;
#endif
        *(u32x2*)(Lt + (size_t)(32 * vb0 + r32) * 128 + k4) = w0;
        *(u32x2*)(Lt + (size_t)(32 * (vb0 + 1) + r32) * 128 + k4) = w1;
    }
    __syncthreads();
}
__device__ __forceinline__ void hgrn_passB(const Args& a, int G) {
    bf16_t* LS = (bf16_t*)(a.ws + WS_A); const float* DG = (const float*)(a.ws + WS_DG);
    for (int it = blockIdx.x * 512 + threadIdx.x; it < 64 * 2048; it += G * 512) {
        const int dbh = it >> 11, e8 = it & 2047, k0 = (e8 & 15) * 8;
        bf16_t* base = LS + (size_t)dbh * NCH * 16384 + e8 * 8; const float* dp = DG + (size_t)dbh * NCH * 128 + k0;
        float S[8];
#pragma unroll
        for (int e = 0; e < 8; ++e) S[e] = 0.f;
#pragma unroll 4
        for (int p = 0; p < NCH; ++p) {
            const u32x4 L = *(const u32x4*)(base + (size_t)p * 16384);
            const f32x4 d0 = *(const f32x4*)(dp + p * 128), d1 = *(const f32x4*)(dp + p * 128 + 4);
            if (p >= 4) { u32x4 w; w.x = pk2(S[0], S[1]); w.y = pk2(S[2], S[3]); w.z = pk2(S[4], S[5]); w.w = pk2(S[6], S[7]); *(u32x4*)(base + (size_t)p * 16384) = w; }
            S[0] = d0.x * S[0] + bf2f(L.x & 0xffffu); S[1] = d0.y * S[1] + bf2f(L.x >> 16);
            S[2] = d0.z * S[2] + bf2f(L.y & 0xffffu); S[3] = d0.w * S[3] + bf2f(L.y >> 16);
            S[4] = d1.x * S[4] + bf2f(L.z & 0xffffu); S[5] = d1.y * S[5] + bf2f(L.z >> 16);
            S[6] = d1.z * S[6] + bf2f(L.w & 0xffffu); S[7] = d1.w * S[7] + bf2f(L.w >> 16);
        }
    }
}
__device__ __forceinline__ void hgrn_passC(const Args& a, char* lds, int item) {
    const int tid = threadIdx.x, wave = tid >> 6, lane = tid & 63, r32 = lane & 31, hi = lane >> 5;
    const int bh = item >> 6, lc = item & 63, b = bh >> 2, h = bh & 3;
    const int row0 = b * SEQ + 64 * lc;
    char* St = lds; char* Qd = lds + 34816; char* Qd2 = lds + 52224; char* Kd2 = lds + 69632; char* Vt = lds + 87040; char* Bs = lds + 105472;
    float* qt = (float*)(lds + 138240); float* brefs = (float*)(lds + 140288);
    const int k = tid & 127, qd = tid >> 7;
    {
        const bf16_t* Vp = (const bf16_t*)(a.ws + WS_HI) + (size_t)row0 * 512 + h * 128;
        unsigned vw[8];
#pragma unroll
        for (int i = 0; i < 8; ++i) vw[i] = (unsigned)Vp[(size_t)(16 * qd + 2 * i) * 512 + k] | ((unsigned)Vp[(size_t)(16 * qd + 2 * i + 1) * 512 + k] << 16);
        *(u32x4*)(Vt + k * 144 + qd * 32) = (u32x4){vw[0], vw[1], vw[2], vw[3]}; *(u32x4*)(Vt + k * 144 + qd * 32 + 16) = (u32x4){vw[4], vw[5], vw[6], vw[7]};
    }
    const int rb = wave >> 2, cb = wave & 3;
    f32x16 o = {};
#pragma unroll 1
    for (int dir = 0; dir < 2; ++dir) {
        const int p = dir ? 4 + 63 - lc : 4 + lc;
        const size_t slot = (size_t)(dir * 32 + bh) * NCH + p;
        {
            const u32x4* Sg = (const u32x4*)((const bf16_t*)(a.ws + WS_A) + slot * 16384);
#pragma unroll
            for (int i = 0; i < 4; ++i) { const int id = tid + 512 * i; *(u32x4*)(St + (id >> 4) * 272 + (id & 15) * 16) = Sg[id]; }
        }
        const _Float16* G = (const _Float16*)(a.ws + (dir ? WS_GB : WS_GF)) + (size_t)row0 * 512 + h * 128;
        {
            float gv[16], bl[16], tot, bref;
            hgrn_cumsum(G, k, qd, dir, qt, gv, bl, tot, bref);
#pragma unroll
            for (int i = 0; i < 16; ++i) ((float*)Bs)[(16 * qd + i) * 128 + k] = bl[i];
            if (qd == 0) brefs[k] = bref;
        }
        __syncthreads();
        {
            const int tok = tid >> 3, ks = (tid & 7) * 16;
            typedef _Float16 h8 __attribute__((ext_vector_type(8)));
            const h8 g0 = *(const h8*)(G + (size_t)tok * 512 + ks), g1 = *(const h8*)(G + (size_t)tok * 512 + ks + 8);
            const bf16_t* Qp = (const bf16_t*)(a.ws + WS_HQ) + (size_t)(row0 + tok) * 512 + h * 128 + ks;
            const u32x4 q0 = *(const u32x4*)Qp, q1 = *(const u32x4*)(Qp + 8);
            float qd_[16], qd2_[16], kd2_[16];
#pragma unroll
            for (int e = 0; e < 16; ++e) {
                const float g = e < 8 ? (float)g0[e & 7] : (float)g1[e & 7];
                const unsigned qw = e < 8 ? q0[(e & 7) >> 1] : q1[(e & 7) >> 1];
                const float q = bf2f((e & 1) ? (qw >> 16) : (qw & 0xffffu));
                const float bb = ((const float*)Bs)[tok * 128 + ks + e], d = bb - brefs[ks + e];
                qd_[e] = q * __expf(bb); qd2_[e] = q * __expf(d); kd2_[e] = (1.f - __expf(g)) * __expf(-d);
            }
#pragma unroll
            for (int hlf = 0; hlf < 2; ++hlf) {
                u32x4 w;
                w.x = pk2(qd_[8 * hlf + 0], qd_[8 * hlf + 1]); w.y = pk2(qd_[8 * hlf + 2], qd_[8 * hlf + 3]); w.z = pk2(qd_[8 * hlf + 4], qd_[8 * hlf + 5]); w.w = pk2(qd_[8 * hlf + 6], qd_[8 * hlf + 7]);
                *(u32x4*)(Qd + tok * 272 + ks * 2 + hlf * 16) = w;
                w.x = pk2(qd2_[8 * hlf + 0], qd2_[8 * hlf + 1]); w.y = pk2(qd2_[8 * hlf + 2], qd2_[8 * hlf + 3]); w.z = pk2(qd2_[8 * hlf + 4], qd2_[8 * hlf + 5]); w.w = pk2(qd2_[8 * hlf + 6], qd2_[8 * hlf + 7]);
                *(u32x4*)(Qd2 + tok * 272 + ks * 2 + hlf * 16) = w;
                w.x = pk2(kd2_[8 * hlf + 0], kd2_[8 * hlf + 1]); w.y = pk2(kd2_[8 * hlf + 2], kd2_[8 * hlf + 3]); w.z = pk2(kd2_[8 * hlf + 4], kd2_[8 * hlf + 5]); w.w = pk2(kd2_[8 * hlf + 6], kd2_[8 * hlf + 7]);
                *(u32x4*)(Kd2 + tok * 272 + ks * 2 + hlf * 16) = w;
            }
        }
        __syncthreads();
        const int tr = (wave & 3) >> 1, tc = wave & 1;
        f32x16 pacc = {};
#pragma unroll
        for (int kk = 0; kk < 8; ++kk) {
            const bf16x8 af = *(const bf16x8*)(Qd + (32 * rb + r32) * 272 + kk * 32 + hi * 16);
            const bf16x8 bf = *(const bf16x8*)(St + (32 * cb + r32) * 272 + kk * 32 + hi * 16);
            o = __builtin_amdgcn_mfma_f32_32x32x16_bf16(af, bf, o, 0, 0, 0);
            const bf16x8 a2 = *(const bf16x8*)(Qd2 + (32 * tr + r32) * 272 + kk * 32 + hi * 16);
            const bf16x8 b2 = *(const bf16x8*)(Kd2 + (32 * tc + r32) * 272 + kk * 32 + hi * 16);
            pacc = __builtin_amdgcn_mfma_f32_32x32x16_bf16(a2, b2, pacc, 0, 0, 0);
        }
        if (wave < 4) {
#pragma unroll
            for (int r = 0; r < 16; ++r) {
                const int t = 32 * tr + att::crow(r, hi), s = 32 * tc + r32;
                const bool keep = dir ? (s >= t) : (s <= t);
                *(bf16_t*)(Bs + t * 144 + s * 2) = (bf16_t)f2bf(keep ? pacc[r] : 0.f);
            }
        }
        __syncthreads();
#pragma unroll
        for (int ks = 0; ks < 4; ++ks) {
            const bf16x8 af = *(const bf16x8*)(Bs + (32 * rb + r32) * 144 + ks * 32 + hi * 16);
            const bf16x8 bf = *(const bf16x8*)(Vt + (32 * cb + r32) * 144 + ks * 32 + hi * 16);
            o = __builtin_amdgcn_mfma_f32_32x32x16_bf16(af, bf, o, 0, 0, 0);
        }
        __syncthreads();
    }
#pragma unroll
    for (int r = 0; r < 16; ++r) ((float*)Bs)[(32 * rb + att::crow(r, hi)) * 128 + 32 * cb + r32] = o[r];
    __syncthreads();
    {
        const int tok = tid >> 3, vs = (tid & 7) * 16;
        float ov[16]; float ss = 0.f;
#pragma unroll
        for (int e = 0; e < 16; ++e) { ov[e] = ((const float*)Bs)[tok * 128 + vs + e]; ss += ov[e] * ov[e]; }
        ss += __shfl_xor(ss, 1); ss += __shfl_xor(ss, 2); ss += __shfl_xor(ss, 4);
        const float rstd = rsqrtf(ss * (1.f / 128.f) + EPS);
        const bf16_t* Hg = (const bf16_t*)(a.ws + WS_HG) + (size_t)(row0 + tok) * 512 + h * 128 + vs;
        const u32x4 h0 = *(const u32x4*)Hg, h1 = *(const u32x4*)(Hg + 8);
        float res[16];
#pragma unroll
        for (int e = 0; e < 16; ++e) {
            const unsigned hw = e < 8 ? h0[(e & 7) >> 1] : h1[(e & 7) >> 1];
            const float hg = bf2f((e & 1) ? (hw >> 16) : (hw & 0xffffu));
            res[e] = ov[e] * rstd * a.g_on[vs + e] * (hg * sigmoidf_(hg));
        }
        bf16_t* Mx = (bf16_t*)(a.ws + WS_MIX) + (size_t)(row0 + tok) * 1024 + 512 + h * 128 + vs;
        u32x4 w;
        w.x = pk2(res[0], res[1]); w.y = pk2(res[2], res[3]); w.z = pk2(res[4], res[5]); w.w = pk2(res[6], res[7]); *(u32x4*)Mx = w;
        w.x = pk2(res[8], res[9]); w.y = pk2(res[10], res[11]); w.z = pk2(res[12], res[13]); w.w = pk2(res[14], res[15]); *(u32x4*)(Mx + 8) = w;
    }
    __syncthreads();
}

#define XB_TMO      128
#define XB_XCNT(j)  (256  + 64 * (j))
#define XB_XSUB(j)  (1280 + 64 * (j))
#define XB_XGEN(j)  (2304 + 64 * (j))
#define XB_TOP      3328
#define XB_TOPGEN   3392
#define XCD_BAR_WORDS 3456
#define XB_SPIN_CAP (1u << 18)

__device__ __forceinline__ unsigned xb_ld(unsigned* p)              { return __hip_atomic_load(p, __ATOMIC_RELAXED, __HIP_MEMORY_SCOPE_AGENT); }
__device__ __forceinline__ unsigned xb_add(unsigned* p, unsigned v) { return __hip_atomic_fetch_add(p, v, __ATOMIC_RELAXED, __HIP_MEMORY_SCOPE_AGENT); }
__device__ __forceinline__ unsigned xb_xcc_id() { return (unsigned)__builtin_amdgcn_s_getreg((3 << 11) | 20) & 0xFu; }
#define XB_SPIN(cond, bar) do { unsigned _sp = 0; while (cond) { __builtin_amdgcn_s_sleep(1); \
    if ((++_sp & 255u) == 0u) { if (xb_ld(&(bar)[XB_TMO])) break; if (_sp > XB_SPIN_CAP) { atomicAdd(&(bar)[XB_TMO], 1u); break; } } } } while (0)

struct XcdBarrier {
    unsigned* bar; unsigned x;
    volatile LAS unsigned* st;
};

__device__ __forceinline__ XcdBarrier xcd_barrier_post(unsigned* bar, volatile LAS unsigned* st) {
    XcdBarrier b; b.bar = bar; b.x = xb_xcc_id(); b.st = st;
    if (threadIdx.x == 0) (void)xb_add(&bar[XB_XCNT(b.x)], 1u);
    return b;
}
__device__ __forceinline__ void xcd_barrier_complete(unsigned* bar, unsigned x, unsigned& nloc, unsigned& nx) {
    const unsigned G = gridDim.x * gridDim.y * gridDim.z;
    unsigned sum, cnt, mine, sp = 0u;
    for (;;) {
        sum = 0u; cnt = 0u; mine = 0u;
#pragma unroll
        for (unsigned j = 0; j < 16; ++j) { const unsigned c = xb_ld(&bar[XB_XCNT(j)]); sum += c; cnt += (c > 0u) ? 1u : 0u; mine = (j == x) ? c : mine; }
        if (sum == G) break;
        __builtin_amdgcn_s_sleep(1);
        if ((++sp & 255u) == 0u) { if (xb_ld(&bar[XB_TMO])) break; if (sp > XB_SPIN_CAP) { atomicAdd(&bar[XB_TMO], 1u); break; } }
    }
    nloc = mine > 0u ? mine : 1u; nx = cnt > 0u ? cnt : 1u;
}

__device__ __forceinline__ void xcd_barrier(const XcdBarrier& b) {
    asm volatile("s_waitcnt vmcnt(0)" ::: "memory");
    __syncthreads();
    if (threadIdx.x == 0) {
        unsigned* bar = b.bar;
        __builtin_amdgcn_s_waitcnt(0);
        unsigned nloc = b.st[0], nx = b.st[1];
        if (nloc == 0u) { xcd_barrier_complete(bar, b.x, nloc, nx); b.st[0] = nloc; b.st[1] = nx; }
        const unsigned old = xb_add(&bar[XB_XSUB(b.x)], 1u);
        const unsigned gen = old / nloc;
        if (old + 1u == (gen + 1u) * nloc) {
            __builtin_amdgcn_fence(__ATOMIC_RELEASE, "agent");
            asm volatile("s_waitcnt vmcnt(0)" ::: "memory");
            const unsigned og = xb_add(&bar[XB_TOP], 1u);
            const unsigned tg = og / nx;
            if (og + 1u == (tg + 1u) * nx) xb_add(&bar[XB_TOPGEN], 1u);
            else XB_SPIN(xb_ld(&bar[XB_TOPGEN]) == tg, bar);
            __builtin_amdgcn_fence(__ATOMIC_ACQUIRE, "agent");
            xb_add(&bar[XB_XGEN(b.x)], 1u);
            asm volatile("s_waitcnt vmcnt(0)" ::: "memory");
        } else {
            XB_SPIN(xb_ld(&bar[XB_XGEN(b.x)]) == gen, bar);
            __builtin_amdgcn_fence(__ATOMIC_ACQUIRE, "agent");
            asm volatile("s_waitcnt vmcnt(0)" ::: "memory");
        }
    }
    __syncthreads();
}

__global__ void __launch_bounds__(512, 2) fwd_megakernel(Args a) {
    extern __shared__ __attribute__((aligned(16))) unsigned char lds[];
    cg::grid_group grid = cg::this_grid();
    const int tid = threadIdx.x, wave = __builtin_amdgcn_readfirstlane(tid >> 6), lane = tid & 63;
    const int G = gridDim.x;
    unsigned char* ws = a.ws;
    LAS unsigned char* ldsl = (LAS unsigned char*)lds;
    char* ldsc = (char*)lds;
    const int lo = a.ph_lo, hi = a.ph_hi;
#ifndef SKIPMASK
#define SKIPMASK 0
#endif
#ifndef REPMASK
#define REPMASK 0
#endif
#define REPN(k) (((REPMASK >> (k)) & 1) ? 2 : 1)
#define IN(k) (!((SKIPMASK >> (k)) & 1) && lo <= (k) && (k) < hi)
#define SEAM(k) do { if (lo <= (k) && (k) + 1 < hi) { if ((k) == 0) grid.sync(); else xcd_barrier(xbar); } } while (0)
    volatile LAS unsigned* xst = (volatile LAS unsigned*)(ldsl + LDS_BYTES - 16);
    if (tid < 4) xst[tid] = 0u;
    __syncthreads();
    XcdBarrier xbar; xbar.bar = (unsigned*)(ws + WS_BAR); xbar.x = 0; xbar.st = xst;
    if (hi - lo > 1) xbar = xcd_barrier_post((unsigned*)(ws + WS_BAR), xst);
    float* MOD = (float*)(ws + WS_MOD);
    float* RSS = (float*)(ws + WS_RSSP);
    const float* RC = (const float*)(ws + WS_RCOS); const float* RS = (const float*)(ws + WS_RSIN);
    bf16_t* Hb = (bf16_t*)(ws + WS_A);
    bf16_t* Qb = (bf16_t*)a.out;
    bf16_t* Kb = (bf16_t*)((char*)a.out + 48 * MiB);
    bf16_t* Vb = (bf16_t*)(ws + WS_V);
    bf16_t* MIX = (bf16_t*)(ws + WS_MIX);
    const int gw = blockIdx.x * 8 + wave, NGW = G * 8;

    if (IN(0)) { p0_prologue(a, ldsc, G); }
    SEAM(0);
    if (IN(1)) {
        for (int r = gw; r < MT; r += NGW) {
            const bool lat = r < ML; const float* src = lat ? a.x + (size_t)r * 1024 : a.ctx + (size_t)(r - ML) * 1024;
            const float* md = MOD + (size_t)(lat ? (r >> 12) : 8) * 6144;
            row_norm_mod_bf16(src, a.g_mix, md, md + 1024, Hb + (size_t)r * 1024, lane);
        }
    }
#ifdef ZERO_MIX
    if (IN(1)) { u32x4* mz = (u32x4*)(ws + WS_MIX); const u32x4 z = {0u, 0u, 0u, 0u}; for (size_t i = (size_t)blockIdx.x * 512 + tid; i < (size_t)ML * 1024 * 2 / 16; i += (size_t)G * 512) mz[i] = z; }
#endif
    SEAM(1);
    if (IN(2)) {
        pg8::Gemm g{Hb, (const bf16_t*)(ws + WS_WIN), MT, NINP, 1024}; pg8::StaticOrder S; S.init(MT, NINP, G, (int)blockIdx.x);
        EpiInProj E{ws, Kb};
        pg8::gemm_phase<EpiInProj, pg8::StaticOrder, true, true>(ldsl, g, S, E);
    }
    SEAM(2);
    if (IN(3)) {
#ifndef SKIP3A
        { pg8::Gemm g{(const bf16_t*)(ws + WS_CQ), (const bf16_t*)(ws + WS_WUQ), ML, 768, 256}; pg8::StaticOrder S; S.init(ML, 768, G, (int)blockIdx.x);
          EpiQ E{Qb, RSS, RC, RS};
          pg8::gemm_phase<EpiQ, pg8::StaticOrder, true, true>(ldsl, g, S, E); }
#endif
#ifndef SKIP3B
        { pg8::Gemm g{(const bf16_t*)(ws + WS_CKV), (const bf16_t*)(ws + WS_WUKV), MT, 1024, 256}; pg8::StaticOrder S; S.init(MT, 1024, G, (int)blockIdx.x);
          EpiKV E{Kb, Vb, RSS};
          pg8::gemm_phase<EpiKV, pg8::StaticOrder, true, true>(ldsl, g, S, E); }
#endif
#ifndef SKIP3C
        for (int it = blockIdx.x; it < 2 * 32 * NCH; it += G) hgrn_passA(a, ldsc, it);
#endif
    }
#ifdef EXPJ
    if (IN(3)) {
        const u32x4* srcA = (const u32x4*)(ws + EXPJ_A); const u32x4* srcB = (const u32x4*)(ws + EXPJ_B); u32x4* dst = (u32x4*)MIX;
        for (size_t i = (size_t)blockIdx.x * 512 + tid; i < (size_t)ML * 64; i += (size_t)G * 512) { const size_t r = i >> 6, c = i & 63; dst[r * 128 + c] = srcA[r * 64 + c]; dst[r * 128 + 64 + c] = srcB[r * 64 + c]; }
    }
#endif
    SEAM(3);
    if (IN(4)) { hgrn_passB(a, G); }
    SEAM(4);
    if (IN(5)) {
#ifndef SKIP5A
        for (int u = blockIdx.x; u < 512; u += G) {
            int bh, qb;
            if (G == 256) { const int xcd = blockIdx.x & 7, cu = blockIdx.x >> 3, i = u >> 8; bh = xcd * 4 + i * 2 + (cu >> 4); qb = cu & 15; }
            else { bh = u >> 4; qb = u & 15; }
            const int b = bh >> 2, h = bh & 3;
            att::attn_body(Qb + ((size_t)bh * SEQ + qb * 256) * 192, Kb + (size_t)bh * KVL * 192, Vb + (size_t)bh * KVL * 128,
                           MIX + ((size_t)b * SEQ + qb * 256) * 1024 + h * 128, KVL, ldsc);
        }
#endif
#ifndef SKIP5B
        for (int it = blockIdx.x; it < 2048; it += G) hgrn_passC(a, ldsc, it);
#endif
    }
#ifdef EXPM
    if (IN(5)) { const u32x4* src = (const u32x4*)(ws + WS_A); u32x4* dst = (u32x4*)MIX;
        for (size_t i = (size_t)blockIdx.x * 512 + tid; i < (size_t)ML * 128; i += (size_t)G * 512) dst[i] = src[i]; }
#endif
    SEAM(5);
    if (IN(6)) {
        pg8::Gemm g{MIX, (const bf16_t*)(ws + WS_WOUT), ML, 1024, 1024}; pg8::StaticOrder S; S.init(ML, 1024, G, (int)blockIdx.x);
        EpiRes E{a.x, a.out, MOD + 2048};
        pg8::gemm_phase<EpiRes, pg8::StaticOrder, true, true>(ldsl, g, S, E);
    }
    SEAM(6);
    if (IN(7)) {
        for (int r = gw; r < ML; r += NGW) {
            const float* md = MOD + (size_t)(r >> 12) * 6144;
            row_norm_mod_bf16(a.out + (size_t)r * 1024, a.g_ffn, md + 3072, md + 4096, Hb + (size_t)r * 1024, lane);
        }
    }
    SEAM(7);
    if (IN(8)) {
        pg8::Gemm g{Hb, (const bf16_t*)(ws + WS_WGU), ML, 2 * DFF, 1024}; pg8::StaticOrder S; S.init(ML, 2 * DFF, G, (int)blockIdx.x);
        EpiSwiglu E{(bf16_t*)(ws + WS_ACT)};
        pg8::gemm_phase<EpiSwiglu, pg8::StaticOrder, true, true>(ldsl, g, S, E);
    }
    SEAM(8);
    if (IN(9)) {
        pg8::Gemm g{(const bf16_t*)(ws + WS_ACT), (const bf16_t*)(ws + WS_WDN), ML, 1024, DFF}; pg8::StaticOrder S; S.init(ML, 1024, G, (int)blockIdx.x);
        EpiRes E{a.out, a.out, MOD + 5120};
        pg8::gemm_phase<EpiRes, pg8::StaticOrder, true, true>(ldsl, g, S, E);
    }
    SEAM(9);
    if (IN(10)) {
        for (int r = gw; r < ML; r += NGW) row_norm_f32(a.out + (size_t)r * 1024, a.g_final, lane);
    }
#ifdef EXTRA_SYNCS
    if (hi - lo > 5) { for (int i_ = 0; i_ < EXTRA_SYNCS; ++i_) grid.sync(); }
#endif
#ifdef PROBE_PHASE
    if (a.ph_lo == 11) {
        for (int u = blockIdx.x; u < 512; u += G) {
            int bh, qb;
            if (G == 256) { const int xcd = blockIdx.x & 7, cu = blockIdx.x >> 3, i = u >> 8; bh = xcd * 4 + i * 2 + (cu >> 4); qb = cu & 15; }
            else { bh = u >> 4; qb = u & 15; }
            const int b = bh >> 2, h = bh & 3;
            att::attn_body(Qb + ((size_t)bh * SEQ + qb * 256) * 192, Kb + (size_t)bh * KVL * 192, Vb + (size_t)bh * KVL * 128,
                           MIX + ((size_t)b * SEQ + qb * 256) * 1024 + h * 128, KVL, ldsc);
        }
    }
    if (a.ph_lo == 12) { for (int it = blockIdx.x; it < 2048; it += G) hgrn_passC(a, ldsc, it); }
    if (a.ph_lo == 13) { for (int it = blockIdx.x; it < 2 * 32 * NCH; it += G) hgrn_passA(a, ldsc, it); }
#endif
#undef IN
#undef SEAM
}

#ifndef PROBE_REPS
#define PROBE_REPS 1
#endif
#ifndef MK_PER_PHASE
#define MK_PER_PHASE 0
#endif
extern "C" void kernel_launch(void* const* d_in, const int* in_sizes, int n_in, void* d_out, int out_size, void* d_ws, size_t ws_size, hipStream_t stream) {
    static int grid = 0;
    if (grid == 0) {
        if (n_in != 21 || out_size != ML * DM || ws_size < WS_END) { fprintf(stderr, "kernel_launch: unexpected shapes (n_in %d out %d ws %zu)\n", n_in, out_size, ws_size); grid = -1; return; }
        int dev = 0, cus = 0, per_cu = 0;
        hipGetDevice(&dev); hipDeviceGetAttribute(&cus, hipDeviceAttributeMultiprocessorCount, dev);
        if (hipFuncSetAttribute((const void*)fwd_megakernel, hipFuncAttributeMaxDynamicSharedMemorySize, LDS_BYTES) != hipSuccess) { fprintf(stderr, "kernel_launch: hipFuncSetAttribute failed\n"); grid = -1; return; }
        if (hipOccupancyMaxActiveBlocksPerMultiprocessor(&per_cu, (const void*)fwd_megakernel, 512, LDS_BYTES) != hipSuccess || per_cu < 1) { fprintf(stderr, "kernel_launch: occupancy query says %d\n", per_cu); per_cu = 1; }
        (void)hipGetLastError();
        grid = cus * 1;
        fprintf(stderr, "kernel_launch: grid %d (per_cu %d)\n", grid, per_cu);
    }
    if (grid < 0) return;
    (void)hipMemsetAsync((char*)d_ws + WS_BAR, 0, 16384, stream);
    Args a{};
    const float** ap = (const float**)&a;
    for (int i = 0; i < 21; ++i) ap[i] = (const float*)d_in[i];
    a.out = (float*)d_out; a.ws = (unsigned char*)d_ws;
#if MK_PER_PHASE
    for (int ph = 0; ph < 11; ++ph) {
        a.ph_lo = ph; a.ph_hi = ph + 1;
        hipLaunchKernelGGL(fwd_megakernel, dim3(grid), dim3(512), LDS_BYTES, stream, a);
    }
#else
#ifdef PROBE_PHASE
    for (int pr_ = 0; pr_ < PROBE_REPS; ++pr_) { a.ph_lo = PROBE_PHASE; a.ph_hi = PROBE_PHASE + 1; hipLaunchKernelGGL(fwd_megakernel, dim3(grid), dim3(512), LDS_BYTES, stream, a); }
#endif
    a.ph_lo = 0; a.ph_hi = 11;
    void* args[] = {&a};
    hipError_t e = hipLaunchCooperativeKernel((const void*)fwd_megakernel, dim3(grid), dim3(512), args, LDS_BYTES, stream);
    if (e != hipSuccess) fprintf(stderr, "cooperative launch failed: %s (grid %d)\n", hipGetErrorString(e), grid);
#endif
}
```

```cpp
#include <hip/hip_runtime.h>
#include <hip/hip_cooperative_groups.h>
#include <hip/hip_bf16.h>
#include <cstdio>
#include <cstdint>
namespace cg = cooperative_groups;
namespace pg8 {
#define PG8_LAS __attribute__((address_space(3)))
typedef unsigned short bf16_t;
typedef short bf16x8 __attribute__((ext_vector_type(8)));
typedef float f32x4 __attribute__((ext_vector_type(4)));
typedef unsigned u32x4 __attribute__((ext_vector_type(4)));
constexpr int BM = 256, BK = 64, HALF = 128, HTB = HALF * BK * 2  , STAGE_BYTES = 8 * HTB, NXCD = 8, WGM = 8;

__host__ __device__ __forceinline__ int lds_byte(int r, int c) { const int st = (r >> 4) * 2 + (c >> 5), rr = r & 15, cc = c & 31, ob = rr * 64 + cc * 2; return st * 1024 + (ob ^ (((ob >> 9) & 1) << 5)); }
__host__ __device__ __forceinline__ void stage_rc(int b, int& R, int& C) { const int st = b / 1024, sb = b % 1024, swz = sb ^ (((sb >> 9) & 1) << 5); R = (st >> 1) * 16 + swz / 64; C = (st & 1) * 32 + (swz % 64) / 2; }
__host__ __device__ __forceinline__ int perm32(int rho) { const int n = rho >> 4, i = rho & 15; return 8 * (i >> 2) + 4 * n + (i & 3); }

struct Unit { int pm, pn; };
struct Gemm { const bf16_t* A; const bf16_t* Bt; int M, N, K; };

struct StaticOrder {
    int nM, nN, nwg, G, c;
    __host__ __device__ void init(int M, int N, int G_, int c_) { nM = M / BM; nN = N / BM; nwg = nM * nN; G = G_; c = c_; }
    __host__ __device__ bool next(int i, Unit& u) const {
        const long L = (long)i * G + c; if (L >= nwg) return false;
        int wgid = (int)L; { const int q = nwg / NXCD, r = nwg % NXCD, xcd = wgid % NXCD, off = wgid / NXCD; wgid = (xcd < r ? xcd * (q + 1) : r * (q + 1) + (xcd - r) * q) + off; }
        const int nig = WGM * nN, gid = wgid / nig, fm = gid * WGM, gsz = (nM - fm) < WGM ? (nM - fm) : WGM;
        u.pm = fm + ((wgid % nig) % gsz); u.pn = (wgid % nig) / gsz; return true;
    }
    __device__ __forceinline__ void a_ready(const Unit&) const {}
    __device__ __forceinline__ void done(const Unit&) const {}
};

__device__ __forceinline__ unsigned cvt_pk_bf16(float lo, float hi) { unsigned r; asm volatile("v_cvt_pk_bf16_f32 %0, %1, %2" : "=v"(r) : "v"(lo), "v"(hi)); return r; }
typedef float f32x2 __attribute__((ext_vector_type(2)));
template <class Epi, class Sched, bool ALIGN_EPI = false, bool SP2 = false>
__device__ __forceinline__ void gemm_phase(PG8_LAS unsigned char* lds, const Gemm g, const Sched& S, const Epi& E) {
    const int tid = threadIdx.x, wid = __builtin_amdgcn_readfirstlane(tid >> 6), lane = tid & 63, wr = wid >> 2, wc = wid & 3, fr = lane & 15, fq = lane >> 4;
    const int K = g.K, nt = K / BK;
    unsigned voffA[2], voffB[2];
#pragma unroll
    for (int i = 0; i < 2; ++i) { int R, C; stage_rc(tid * 16 + i * 8192, R, C); const int Rb = Epi::PERM ? ((R & ~31) + perm32(R & 31)) : R;
        voffA[i] = (unsigned)(R * K + C) * 2u; voffB[i] = (unsigned)(Rb * K + C) * 2u; }
    const size_t kstep = (size_t)(BK * 2);
    const size_t hstep = (size_t)HALF * K * 2;
    const size_t tstep = 2 * hstep;
    const unsigned ldsw = (unsigned)wid * 1024u;
    const int aoff = lds_byte(wr * 64 + fr, fq * 8), boff = lds_byte(wc * 32 + fr, fq * 8);
#define PG8_SA(b, h) (((b) * 2 + (h)) * HTB)
#define PG8_SB(b, h) ((4 + (b) * 2 + (h)) * HTB)
#define PG8_STAGE(bufoff, gbase, voff) do { _Pragma("unroll") for (int _i = 0; _i < 2; ++_i) \
        __builtin_amdgcn_global_load_lds((const unsigned*)((const char*)(gbase) + (voff)[_i]), (PG8_LAS unsigned*)(lds + (bufoff) + ldsw + _i * 8192), 16, 0, 0); } while (0)
#define PG8_LDA(dst, b, h) do { _Pragma("unroll") for (int m = 0; m < 4; ++m) _Pragma("unroll") for (int k = 0; k < 2; ++k) dst[m][k] = *(const PG8_LAS bf16x8*)(lds + PG8_SA(b, h) + aoff + m * 2048 + k * 1024); } while (0)
#define PG8_LDB(dst, b, h) do { _Pragma("unroll") for (int n = 0; n < 2; ++n) _Pragma("unroll") for (int k = 0; k < 2; ++k) dst[n][k] = *(const PG8_LAS bf16x8*)(lds + PG8_SB(b, h) + boff + n * 2048 + k * 1024); } while (0)
#define PG8_MMA(ai, bj, At, Bt) do { __builtin_amdgcn_s_setprio(1); _Pragma("unroll") for (int m = 0; m < 4; ++m) _Pragma("unroll") for (int n = 0; n < 2; ++n) _Pragma("unroll") for (int k = 0; k < 2; ++k) \
        acc[ai][bj][m][n] = __builtin_amdgcn_mfma_f32_16x16x32_bf16(Bt[n][k], At[m][k], acc[ai][bj][m][n], 0, 0, 0); __builtin_amdgcn_s_setprio(0); } while (0)
#define PG8_WAIT_V(n) asm volatile("s_waitcnt vmcnt(" #n ")" ::: "memory")
#define PG8_WAIT_L(n) asm volatile("s_waitcnt lgkmcnt(" #n ")" ::: "memory")
#define PG8_BAR __builtin_amdgcn_s_barrier()
#define PG8_SCHED __builtin_amdgcn_sched_barrier(0)
    Unit cur, nxt; int ui = 0;
    if (!S.next(0, cur)) return;
    f32x4 acc[2][2][4][2];
#pragma unroll
    for (int a = 0; a < 2; ++a)
#pragma unroll
        for (int b = 0; b < 2; ++b)
#pragma unroll
            for (int m = 0; m < 4; ++m)
#pragma unroll
                for (int n = 0; n < 2; ++n) acc[a][b][m][n] = (f32x4){0.f, 0.f, 0.f, 0.f};
    bf16x8 At[4][2], B0[2][2], B1[2][2];
    const char* cA = (const char*)g.A + (size_t)cur.pm * tstep; const char* cB = (const char*)g.Bt + (size_t)cur.pn * tstep;
    S.a_ready(cur);
    if constexpr (SP2) {
        PG8_STAGE(PG8_SB(0, 0), cB, voffB); PG8_STAGE(PG8_SB(0, 1), cB + hstep, voffB); PG8_STAGE(PG8_SA(0, 0), cA, voffA); PG8_STAGE(PG8_SA(0, 1), cA + hstep, voffA);
        if (wr == 1) PG8_BAR;
        PG8_WAIT_V(2); PG8_BAR;
        PG8_STAGE(PG8_SB(1, 0), cB + kstep, voffB); PG8_STAGE(PG8_SA(1, 0), cA + kstep, voffA); PG8_STAGE(PG8_SB(1, 1), cB + hstep + kstep, voffB);
        PG8_WAIT_V(6); PG8_BAR;
    } else {
        PG8_STAGE(PG8_SB(0, 0), cB, voffB); PG8_STAGE(PG8_SA(0, 0), cA, voffA); PG8_STAGE(PG8_SB(0, 1), cB + hstep, voffB); PG8_STAGE(PG8_SA(0, 1), cA + hstep, voffA);
        if (wr == 1) PG8_BAR;
        PG8_WAIT_V(4); PG8_BAR;
        PG8_STAGE(PG8_SB(1, 0), cB + kstep, voffB); PG8_STAGE(PG8_SA(1, 0), cA + kstep, voffA); PG8_STAGE(PG8_SB(1, 1), cB + hstep + kstep, voffB);
        PG8_WAIT_V(6); PG8_BAR;
    }
    for (;;) {
        const bool has_next = S.next(ui + 1, nxt);
        const char* nA = has_next ? (const char*)g.A + (size_t)nxt.pm * tstep : cA; const char* nB = has_next ? (const char*)g.Bt + (size_t)nxt.pn * tstep : cB;
#pragma unroll 1
        for (int t = 0; t < nt; t += 2) {
            const bool last = (t == nt - 2);
            const char* a1 = cA + (size_t)(t + 1) * kstep;
            const char* a2 = last ? nA : cA + (size_t)(t + 2) * kstep; const char* b2 = last ? nB : cB + (size_t)(t + 2) * kstep;
            const char* a3 = a2 + kstep; const char* b3 = b2 + kstep;
            if (last && has_next) S.a_ready(nxt);
            if constexpr (SP2) {
            PG8_LDB(B0, 0, 0); PG8_LDB(B1, 0, 1); PG8_SCHED; PG8_LDA(At, 0, 0); PG8_STAGE(PG8_SA(1, 1), a1 + hstep, voffA);
            PG8_WAIT_V(8); PG8_WAIT_L(0); PG8_BAR; PG8_MMA(0, 0, At, B0); PG8_MMA(0, 1, At, B1); PG8_BAR; PG8_SCHED;
            PG8_LDA(At, 0, 1); PG8_STAGE(PG8_SB(0, 0), b2, voffB); PG8_STAGE(PG8_SB(0, 1), b2 + hstep, voffB); PG8_STAGE(PG8_SA(0, 0), a2, voffA);
            PG8_WAIT_V(8); PG8_WAIT_L(0); PG8_BAR; PG8_MMA(1, 0, At, B0); PG8_MMA(1, 1, At, B1); PG8_BAR; PG8_SCHED;
            PG8_LDB(B0, 1, 0); PG8_LDB(B1, 1, 1); PG8_SCHED; PG8_LDA(At, 1, 0); PG8_STAGE(PG8_SA(0, 1), a2 + hstep, voffA);
            PG8_WAIT_V(8); PG8_WAIT_L(0); PG8_BAR; PG8_MMA(0, 0, At, B0); PG8_MMA(0, 1, At, B1); PG8_BAR; PG8_SCHED;
            PG8_LDA(At, 1, 1); PG8_STAGE(PG8_SB(1, 0), b3, voffB); PG8_STAGE(PG8_SB(1, 1), b3 + hstep, voffB); PG8_STAGE(PG8_SA(1, 0), a3, voffA);
            PG8_WAIT_V(8); PG8_WAIT_L(0); PG8_BAR; PG8_MMA(1, 0, At, B0); PG8_MMA(1, 1, At, B1); PG8_BAR; PG8_SCHED;
            } else {
            PG8_LDB(B0, 0, 0); PG8_SCHED; PG8_LDA(At, 0, 0); PG8_STAGE(PG8_SA(1, 1), a1 + hstep, voffA);
            PG8_WAIT_L(8); PG8_BAR; PG8_WAIT_L(0); PG8_MMA(0, 0, At, B0); PG8_BAR; PG8_SCHED;
            PG8_LDB(B1, 0, 1); PG8_STAGE(PG8_SB(0, 0), b2, voffB);
            PG8_BAR; PG8_WAIT_L(0); PG8_MMA(0, 1, At, B1); PG8_BAR;
            PG8_LDA(At, 0, 1); PG8_STAGE(PG8_SA(0, 0), a2, voffA);
            PG8_BAR; PG8_WAIT_L(0); PG8_MMA(1, 0, At, B0); PG8_BAR; PG8_SCHED;
            PG8_STAGE(PG8_SB(0, 1), b2 + hstep, voffB);
            PG8_WAIT_V(6); PG8_BAR; PG8_MMA(1, 1, At, B1); PG8_BAR;
            PG8_LDB(B0, 1, 0); PG8_SCHED; PG8_LDA(At, 1, 0); PG8_STAGE(PG8_SA(0, 1), a2 + hstep, voffA);
            PG8_WAIT_L(8); PG8_BAR; PG8_WAIT_L(0); PG8_MMA(0, 0, At, B0); PG8_BAR; PG8_SCHED;
            PG8_LDB(B1, 1, 1); PG8_STAGE(PG8_SB(1, 0), b3, voffB);
            PG8_BAR; PG8_WAIT_L(0); PG8_MMA(0, 1, At, B1); PG8_BAR;
            PG8_LDA(At, 1, 1); PG8_STAGE(PG8_SA(1, 0), a3, voffA);
            PG8_BAR; PG8_WAIT_L(0); PG8_MMA(1, 0, At, B0); PG8_BAR; PG8_SCHED;
            PG8_STAGE(PG8_SB(1, 1), b3 + hstep, voffB);
            PG8_WAIT_V(6); PG8_BAR; PG8_MMA(1, 1, At, B1); PG8_BAR;
            }
        }
        if constexpr (ALIGN_EPI) { if (wr == 0) PG8_BAR; }
        if constexpr (!Epi::AFTER_DRAIN) { E(acc, cur, wr, wc, fr, fq); S.done(cur); }
        if (!has_next) break;
#pragma unroll
        for (int a = 0; a < 2; ++a)
#pragma unroll
            for (int b = 0; b < 2; ++b)
#pragma unroll
                for (int m = 0; m < 4; ++m)
#pragma unroll
                    for (int n = 0; n < 2; ++n) acc[a][b][m][n] = (f32x4){0.f, 0.f, 0.f, 0.f};
        cur = nxt; cA = nA; cB = nB; ++ui;
        if constexpr (ALIGN_EPI) { if (wr == 1) PG8_BAR; }
    }
    PG8_WAIT_V(0);
    if constexpr (!ALIGN_EPI) { if (wr == 0) PG8_BAR; }
    PG8_BAR;
    if constexpr (Epi::AFTER_DRAIN) { E.fused(acc, cur, wr, wc, fr, fq, lds, wid, lane); S.done(cur); }
#undef PG8_SA
#undef PG8_SB
#undef PG8_STAGE
#undef PG8_LDA
#undef PG8_LDB
#undef PG8_MMA
#undef PG8_WAIT_V
#undef PG8_WAIT_L
#undef PG8_BAR
#undef PG8_SCHED
}
}

#define LAS __attribute__((address_space(3)))
typedef unsigned short bf16_t;
typedef short bf16x8 __attribute__((ext_vector_type(8)));
typedef short s16x4 __attribute__((ext_vector_type(4)));
typedef float f32x4 __attribute__((ext_vector_type(4)));
typedef float f32x16 __attribute__((ext_vector_type(16)));
typedef unsigned u32x4 __attribute__((ext_vector_type(4)));
typedef unsigned u32x2 __attribute__((ext_vector_type(2)));

constexpr int NB = 8, SEQ = 4096, DM = 1024, CTXL = 256;
constexpr int ML = NB * SEQ, MC = NB * CTXL, MT = ML + MC;
constexpr int NIN = 3136, NINP = 3328, DFF = 2816, KVL = CTXL + SEQ;
constexpr int NCH = 68;
constexpr float EPS = 1e-6f;
constexpr size_t MiB = 1u << 20;
constexpr size_t WS_MOD = 0, WS_LBF = 256 * 1024, WS_LBB = 258 * 1024, WS_RCOS = 260 * 1024, WS_RSIN = 264 * 1024, WS_ROWSS = 512 * 1024;
constexpr size_t WS_WIN = 1 * MiB, WS_WUQ = 8 * MiB, WS_WUKV = 8 * MiB + 512 * 1024, WS_WOUT = 9 * MiB, WS_WGU = 11 * MiB, WS_WDN = 22 * MiB, WS_DG = 28 * MiB;
constexpr size_t WS_A = 32 * MiB;
constexpr size_t WS_CQ = 169 * MiB, WS_CKV = 186 * MiB, WS_HQ = 203 * MiB, WS_HI = 237 * MiB, WS_HG = 271 * MiB, WS_GF = 305 * MiB, WS_GB = 339 * MiB;
constexpr size_t WS_V = 373 * MiB, WS_MIX = 407 * MiB, WS_ACT = 169 * MiB, WS_RSSP = 471 * MiB, WS_BAR = 480 * MiB, WS_END = 481 * MiB;
constexpr int LDS_BYTES = 147456;

__device__ __forceinline__ unsigned f2bf(float f) { unsigned u = __builtin_bit_cast(unsigned, f); return (u + 0x7fffu + ((u >> 16) & 1u)) >> 16; }
__device__ __forceinline__ float bf2f(unsigned h) { return __builtin_bit_cast(float, h << 16); }
typedef __bf16 bf16v2_t __attribute__((ext_vector_type(2)));
__device__ __forceinline__ unsigned pk2(float lo, float hi) { bf16v2_t v; v.x = (__bf16)lo; v.y = (__bf16)hi; return __builtin_bit_cast(unsigned, v); }
__device__ __forceinline__ float wave_sum(float v) {
#pragma unroll
    for (int o = 1; o < 64; o <<= 1) v += __shfl_xor(v, o);
    return v;
}
__device__ __forceinline__ float sigmoidf_(float x) { return 1.f / (1.f + __expf(-x)); }
#define LDS_WAIT() asm volatile("s_waitcnt lgkmcnt(0)" ::: "memory")

struct Args {
    const float *x, *c, *ctx, *c_ctx, *w_mod, *b_mod, *g_mix, *g_ffn, *w_in, *g_qn, *w_uq, *g_kvn, *w_ukv, *lb_fwd, *lb_bwd, *g_on, *w_out, *w_gate, *w_up, *w_down, *g_final;
    float* out; unsigned char* ws; int ph_lo, ph_hi;
};

__device__ __forceinline__ void p0_mod_item(const Args& a, char* ldsc, int item) {
    float* sl = (float*)ldsc;
    float* red = sl + 9216;
    const int tid = threadIdx.x, wave = tid >> 6, lane = tid & 63;
    for (int i = tid; i < 9216; i += 512) { const float v = (i < 8192) ? a.c[i] : a.c_ctx[i - 8192]; sl[i] = v * sigmoidf_(v); }
    __syncthreads();
    float acc[9];
#pragma unroll
    for (int r = 0; r < 9; ++r) acc[r] = 0.f;
    const float* wp = a.w_mod + (size_t)(wave * 128) * 6144 + item * 64 + lane;
#pragma unroll 4
    for (int k = 0; k < 128; ++k) {
        const float w = wp[(size_t)k * 6144];
#pragma unroll
        for (int r = 0; r < 9; ++r) acc[r] += sl[r * 1024 + wave * 128 + k] * w;
    }
#pragma unroll
    for (int r = 0; r < 9; ++r) red[(wave * 9 + r) * 64 + lane] = acc[r];
    __syncthreads();
    float* MOD = (float*)(a.ws + WS_MOD);
    for (int i = tid; i < 576; i += 512) {
        const int r = i >> 6, l = i & 63; float s = 0.f;
#pragma unroll
        for (int w = 0; w < 8; ++w) s += red[(w * 9 + r) * 64 + l];
        MOD[r * 6144 + item * 64 + l] = s + a.b_mod[item * 64 + l];
    }
    __syncthreads();
}
__device__ __forceinline__ void p0_transpose_item(const float* W, int N, bf16_t* WT, int Kd, int drow0, const float* kscale, float* scr, int k0, int n0, int lane) {
#pragma unroll 8
    for (int i = 0; i < 32; ++i) { const int kk = 2 * i + (lane >> 5); float v = W[(size_t)(k0 + kk) * N + n0 + (lane & 31)]; if (kscale) v *= kscale[k0 + kk]; scr[kk * 33 + (lane & 31)] = v; }
    LDS_WAIT(); asm volatile("" ::: "memory");
    const int c = lane & 7;
#pragma unroll
    for (int j = 0; j < 4; ++j) { const int n = (lane >> 3) + 8 * j; const float* s = scr + (8 * c) * 33 + n;
        u32x4 o; o.x = pk2(s[0 * 33], s[1 * 33]); o.y = pk2(s[2 * 33], s[3 * 33]); o.z = pk2(s[4 * 33], s[5 * 33]); o.w = pk2(s[6 * 33], s[7 * 33]);
        *(u32x4*)(WT + (size_t)(drow0 + n) * Kd + k0 + 8 * c) = o; }
    LDS_WAIT(); asm volatile("" ::: "memory");
}
__device__ __forceinline__ void p0_prologue(const Args& a, char* ldsc, int G) {
    const int tid = threadIdx.x, wave = tid >> 6, lane = tid & 63;
    unsigned char* ws = a.ws;
    if (blockIdx.x < 96) p0_mod_item(a, ldsc, blockIdx.x);
    if ((int)blockIdx.x == G - 1) {
        float* LBF = (float*)(ws + WS_LBF); float* LBB = (float*)(ws + WS_LBB);
        LBF[tid] = 1.f / (1.f + __expf(a.lb_fwd[512 + tid] - a.lb_fwd[tid]));
        LBB[tid] = 1.f / (1.f + __expf(a.lb_bwd[512 + tid] - a.lb_bwd[tid]));
        float* RC = (float*)(ws + WS_RCOS); float* RS = (float*)(ws + WS_RSIN);
        for (int i = tid; i < 1024; i += 512) {
            const int pos = i >> 4, fi = i & 15;
            const float inv = exp2f(-(float)fi * (13.287712379549449f / 16.f));
            const float ang = (float)pos * inv;
            const float kq = rintf(ang * 0.15915494309189535f);
            float r = fmaf(-kq, 6.28125f, ang); r = fmaf(-kq, 0.0019353071795864769f, r);
            RC[i] = __cosf(r); RS[i] = __sinf(r);
        }
    }
    { u32x4* pz = (u32x4*)(ws + WS_WIN + (size_t)NIN * 1024 * 2); const u32x4 z = {0u, 0u, 0u, 0u};
      for (int i = blockIdx.x * 512 + tid; i < (NINP - NIN) * 1024 * 2 / 16; i += G * 512) pz[i] = z; }
    float* scr = (float*)(ldsc + wave * 16384);
    const int gw = blockIdx.x * 8 + wave, NGW = G * 8;
    constexpr int I_IN = 16 * 98, I_UQ = 4 * 24, I_UKV = 4 * 32, I_OUT = 16 * 32, I_G = 16 * 88, I_DN = 44 * 32;
    constexpr int NITEMS = I_IN + I_UQ + I_UKV + I_OUT + 2 * I_G + I_DN;
    for (int it = gw; it < NITEMS; it += NGW) {
        int r = it;
        if (r < I_IN) { const int kb = r / 98, nb = r % 98; p0_transpose_item(a.w_in, NIN, (bf16_t*)(ws + WS_WIN), 1024, 32 * nb, nullptr, scr, 64 * kb, 32 * nb, lane); continue; } r -= I_IN;
        if (r < I_UQ) { const int kb = r / 24, nb = r % 24; p0_transpose_item(a.w_uq, 768, (bf16_t*)(ws + WS_WUQ), 256, 32 * nb, a.g_qn, scr, 64 * kb, 32 * nb, lane); continue; } r -= I_UQ;
        if (r < I_UKV) { const int kb = r / 32, nb = r % 32; p0_transpose_item(a.w_ukv, 1024, (bf16_t*)(ws + WS_WUKV), 256, 32 * nb, a.g_kvn, scr, 64 * kb, 32 * nb, lane); continue; } r -= I_UKV;
        if (r < I_OUT) { const int kb = r / 32, nb = r % 32; p0_transpose_item(a.w_out, 1024, (bf16_t*)(ws + WS_WOUT), 1024, 32 * nb, nullptr, scr, 64 * kb, 32 * nb, lane); continue; } r -= I_OUT;
        if (r < 2 * I_G) { const int up = r >= I_G; if (up) r -= I_G; const int kb = r / 88, nb = r % 88, n0 = 32 * nb;
            const int drow = (n0 >> 7) * 256 + (n0 & 127) + (up ? 128 : 0);
            p0_transpose_item(up ? a.w_up : a.w_gate, DFF, (bf16_t*)(ws + WS_WGU), 1024, drow, nullptr, scr, 64 * kb, n0, lane); continue; } r -= 2 * I_G;
        { const int kb = r / 32, nb = r % 32; p0_transpose_item(a.w_down, 1024, (bf16_t*)(ws + WS_WDN), DFF, 32 * nb, nullptr, scr, 64 * kb, 32 * nb, lane); }
    }
}

template <int NR>
__device__ __forceinline__ void rows_norm_mod_bf16(const float* const (&src)[NR], const float* g, const float* const (&md)[NR], int shoff, bf16_t* const (&dst)[NR], const bool (&ok)[NR], int lane) {
    f32x4 v[NR][4]; float s[NR];
#pragma unroll
    for (int i = 0; i < NR; ++i) { s[i] = 0.f; if (ok[i]) {
#pragma unroll
        for (int j = 0; j < 4; ++j) v[i][j] = ((const f32x4*)src[i])[lane + 64 * j]; } }
#pragma unroll
    for (int i = 0; i < NR; ++i) if (ok[i]) {
#pragma unroll
        for (int j = 0; j < 4; ++j) s[i] += (v[i][j].x * v[i][j].x + v[i][j].y * v[i][j].y) + (v[i][j].z * v[i][j].z + v[i][j].w * v[i][j].w); }
#pragma unroll
    for (int o = 1; o < 64; o <<= 1) {
#pragma unroll
        for (int i = 0; i < NR; ++i) s[i] += __shfl_xor(s[i], o); }
#pragma unroll
    for (int i = 0; i < NR; ++i) if (ok[i]) {
        const float rstd = rsqrtf(s[i] * (1.f / 1024.f) + EPS);
        u32x2* o8 = (u32x2*)dst[i] + lane;
#pragma unroll
        for (int j = 0; j < 4; ++j) {
            const f32x4 gg = ((const f32x4*)g)[lane + 64 * j], s1 = ((const f32x4*)(md[i] + shoff + 1024))[lane + 64 * j], s0 = ((const f32x4*)(md[i] + shoff))[lane + 64 * j];
            const f32x4 y = v[i][j] * rstd * gg * (s1 + 1.f) + s0;
            u32x2 w; w.x = pk2(y.x, y.y); w.y = pk2(y.z, y.w); o8[64 * j] = w;
        }
    }
}
template <int NR>
__device__ __forceinline__ void rows_norm_f32(float* const (&row)[NR], const float* g, int lane) {
    f32x4 v[NR][4]; float s[NR];
#pragma unroll
    for (int i = 0; i < NR; ++i) { s[i] = 0.f;
#pragma unroll
        for (int j = 0; j < 4; ++j) v[i][j] = ((const f32x4*)row[i])[lane + 64 * j]; }
#pragma unroll
    for (int i = 0; i < NR; ++i) {
#pragma unroll
        for (int j = 0; j < 4; ++j) s[i] += (v[i][j].x * v[i][j].x + v[i][j].y * v[i][j].y) + (v[i][j].z * v[i][j].z + v[i][j].w * v[i][j].w); }
#pragma unroll
    for (int o = 1; o < 64; o <<= 1) {
#pragma unroll
        for (int i = 0; i < NR; ++i) s[i] += __shfl_xor(s[i], o); }
#pragma unroll
    for (int i = 0; i < NR; ++i) {
        const float rstd = rsqrtf(s[i] * (1.f / 1024.f) + EPS);
#pragma unroll
        for (int j = 0; j < 4; ++j) { f32x4 o = v[i][j] * rstd * ((const f32x4*)g)[lane + 64 * j];
#ifdef SANITIZE
            o.x = __builtin_isfinite(o.x) ? o.x : 1000.f; o.y = __builtin_isfinite(o.y) ? o.y : 1000.f; o.z = __builtin_isfinite(o.z) ? o.z : 1000.f; o.w = __builtin_isfinite(o.w) ? o.w : 1000.f;
#endif
            ((f32x4*)row[i])[lane + 64 * j] = o; }
    }
}

__device__ __forceinline__ void rope8(float (&v)[8], int fq, const float* rc, const float* rs, int pos, bool apply) {
    const int ib = pos * 16 + 8 * (fq & 1);
#pragma unroll
    for (int e = 0; e < 8; ++e) {
        const float partner = __shfl_xor(v[e], 32);
        const float cs = rc[ib + e], sn = rs[ib + e];
        const float r = (fq < 2) ? (v[e] * cs - partner * sn) : (v[e] * cs + partner * sn);
        v[e] = apply ? r : v[e];
    }
}
__device__ __forceinline__ u32x4 pack8(const float (&v)[8]) { u32x4 w; w.x = pk2(v[0], v[1]); w.y = pk2(v[2], v[3]); w.z = pk2(v[4], v[5]); w.w = pk2(v[6], v[7]); return w; }

struct EpiInProj {
    static constexpr bool PERM = true, AFTER_DRAIN = false;
    unsigned char* ws; bf16_t* Kb;
    __device__ __forceinline__ void operator()(const pg8::f32x4 (&acc)[2][2][4][2], const pg8::Unit& u, int wr, int wc, int fr, int fq) const {
        float* RSS = (float*)(ws + WS_RSSP); const float* RC = (const float*)(ws + WS_RCOS); const float* RS = (const float*)(ws + WS_RSIN);
#pragma unroll
        for (int bj = 0; bj < 2; ++bj) {
            const int cbase = u.pn * 256 + bj * 128 + wc * 32;
            if (cbase >= NIN) continue;
            const int c0 = cbase + 8 * fq;
#pragma unroll
            for (int ai = 0; ai < 2; ++ai)
#pragma unroll
                for (int m = 0; m < 4; ++m) {
                    const int row = u.pm * 256 + ai * 128 + wr * 64 + m * 16 + fr;
                    float v[8];
#pragma unroll
                    for (int e = 0; e < 4; ++e) { v[e] = acc[ai][bj][m][0][e]; v[4 + e] = acc[ai][bj][m][1][e]; }
                    if (cbase < 512) {
                        bf16_t* dst = (bf16_t*)(ws + WS_CQ + (cbase < 256 ? (size_t)0 : (WS_CKV - WS_CQ))) + (size_t)row * 256 + (c0 & 255);
                        *(u32x4*)dst = pack8(v);
                        float ss = 0.f;
#pragma unroll
                        for (int e = 0; e < 8; ++e) ss += v[e] * v[e];
                        ss += __shfl_xor(ss, 16); ss += __shfl_xor(ss, 32);
                        if (fq == 0) RSS[((size_t)row * 2 + (cbase < 256 ? 0 : 1)) * 8 + bj * 4 + wc] = ss;
                    } else if (cbase < 576) {
                        const int axis = (cbase - 512) >> 5;
                        const bool lat = row < ML;
                        const int n = row & 4095;
                        const int pos = axis ? (n & 63) : (n >> 6);
                        rope8(v, fq, RC, RS, lat ? pos : 0, lat);
                        const int b = lat ? (row >> 12) : ((row - ML) >> 8);
                        const int kvpos = lat ? (CTXL + n) : ((row - ML) & 255);
                        const u32x4 w = pack8(v);
#pragma unroll
                        for (int h = 0; h < 4; ++h) *(u32x4*)(Kb + ((size_t)(b * 4 + h) * KVL + kvpos) * 192 + 128 + axis * 32 + 8 * fq) = w;
                    } else if (cbase < 2112) {
                        const int seg = (cbase - 576) >> 9;
                        bf16_t* base = (bf16_t*)(ws + WS_HQ + (size_t)seg * (WS_HI - WS_HQ));
                        *(u32x4*)(base + (size_t)row * 512 + (c0 - 576 - seg * 512)) = pack8(v);
                    } else {
                        const int dirn = (cbase - 2112) >> 9, j = c0 - 2112 - dirn * 512;
                        const float* lbp = (const float*)(ws + WS_LBF + (size_t)dirn * (WS_LBB - WS_LBF)) + j;
                        typedef _Float16 h8 __attribute__((ext_vector_type(8)));
                        h8 o;
#pragma unroll
                        for (int e = 0; e < 8; ++e) { const float lb = lbp[e]; const float f = lb + (1.f - lb) * sigmoidf_(v[e]); o[e] = (_Float16)__logf(f); }
                        *(h8*)((_Float16*)(ws + WS_GF + (size_t)dirn * (WS_GB - WS_GF)) + (size_t)row * 512 + j) = o;
                    }
                }
        }
    }
};
struct EpiQ {
    static constexpr bool PERM = true, AFTER_DRAIN = false;
    bf16_t* Q; const float* RSS; const float *RC, *RS;
    __device__ __forceinline__ void operator()(const pg8::f32x4 (&acc)[2][2][4][2], const pg8::Unit& u, int wr, int wc, int fr, int fq) const {
#pragma unroll
        for (int bj = 0; bj < 2; ++bj) {
            const int cbase = u.pn * 256 + bj * 128 + wc * 32;
            const int h = cbase / 192, d0 = cbase - h * 192;
            const bool rope = d0 >= 128; const int axis = (d0 - 128) >> 5;
#pragma unroll
            for (int ai = 0; ai < 2; ++ai)
#pragma unroll
                for (int m = 0; m < 4; ++m) {
                    const int row = u.pm * 256 + ai * 128 + wr * 64 + m * 16 + fr;
                    const f32x4 s0 = *(const f32x4*)(RSS + (size_t)row * 16), s1 = *(const f32x4*)(RSS + (size_t)row * 16 + 4);
                    const float rstd = rsqrtf((((s0.x + s0.y) + (s0.z + s0.w)) + ((s1.x + s1.y) + (s1.z + s1.w))) * (1.f / 256.f) + EPS);
                    float v[8];
#pragma unroll
                    for (int e = 0; e < 4; ++e) { v[e] = acc[ai][bj][m][0][e] * rstd; v[4 + e] = acc[ai][bj][m][1][e] * rstd; }
                    const int b = row >> 12, n = row & 4095;
                    if (rope) { const int pos = axis ? (n & 63) : (n >> 6); rope8(v, fq, RC, RS, pos, true); }
                    *(u32x4*)(Q + ((size_t)(b * 4 + h) * SEQ + n) * 192 + d0 + 8 * fq) = pack8(v);
                    asm volatile("" ::: "memory");
                }
        }
    }
};
struct EpiKV {
    static constexpr bool PERM = true, AFTER_DRAIN = false;
    bf16_t *Kb, *Vb; const float* RSS;
    __device__ __forceinline__ void operator()(const pg8::f32x4 (&acc)[2][2][4][2], const pg8::Unit& u, int wr, int wc, int fr, int fq) const {
#pragma unroll
        for (int bj = 0; bj < 2; ++bj) {
            const int cbase = u.pn * 256 + bj * 128 + wc * 32;
            const int h = cbase >> 8, j0 = cbase & 255;
#pragma unroll
            for (int ai = 0; ai < 2; ++ai)
#pragma unroll
                for (int m = 0; m < 4; ++m) {
                    const int row = u.pm * 256 + ai * 128 + wr * 64 + m * 16 + fr;
                    const f32x4 s0 = *(const f32x4*)(RSS + (size_t)row * 16 + 8), s1 = *(const f32x4*)(RSS + (size_t)row * 16 + 12);
                    const float rstd = rsqrtf((((s0.x + s0.y) + (s0.z + s0.w)) + ((s1.x + s1.y) + (s1.z + s1.w))) * (1.f / 256.f) + EPS);
                    float v[8];
#pragma unroll
                    for (int e = 0; e < 4; ++e) { v[e] = acc[ai][bj][m][0][e] * rstd; v[4 + e] = acc[ai][bj][m][1][e] * rstd; }
                    const bool lat = row < ML;
                    const int b = lat ? (row >> 12) : ((row - ML) >> 8);
                    const int kvpos = lat ? (CTXL + (row & 4095)) : ((row - ML) & 255);
                    const size_t r = (size_t)(b * 4 + h) * KVL + kvpos;
                    if (j0 < 128) *(u32x4*)(Kb + r * 192 + j0 + 8 * fq) = pack8(v);
                    else          *(u32x4*)(Vb + r * 128 + (j0 - 128) + 8 * fq) = pack8(v);
                    asm volatile("" ::: "memory");
                }
        }
    }
};
struct EpiRes {
    static constexpr bool PERM = false, AFTER_DRAIN = false;
    const float* base; float* out; const float* gate;
    __device__ __forceinline__ void operator()(const pg8::f32x4 (&acc)[2][2][4][2], const pg8::Unit& u, int wr, int wc, int fr, int fq) const {
#pragma unroll
        for (int ai = 0; ai < 2; ++ai)
#pragma unroll
            for (int m = 0; m < 4; ++m) {
                const int row = u.pm * 256 + ai * 128 + wr * 64 + m * 16 + fr;
                const float* gp = gate + (size_t)(row >> 12) * 6144;
#pragma unroll
                for (int bj = 0; bj < 2; ++bj)
#pragma unroll
                    for (int n = 0; n < 2; ++n) {
                        const int c = u.pn * 256 + bj * 128 + wc * 32 + 16 * n + 4 * fq;
                        const f32x4 g = *(const f32x4*)(gp + c), bs = *(const f32x4*)(base + (size_t)row * 1024 + c);
                        const pg8::f32x4 a4 = acc[ai][bj][m][n];
                        f32x4 o; o.x = bs.x + g.x * a4[0]; o.y = bs.y + g.y * a4[1]; o.z = bs.z + g.z * a4[2]; o.w = bs.w + g.w * a4[3];
                        *(f32x4*)(out + (size_t)row * 1024 + c) = o;
                    }
            }
    }
};
struct EpiSwiglu {
    static constexpr bool PERM = true, AFTER_DRAIN = false;
    bf16_t* ACT;
    __device__ __forceinline__ void operator()(const pg8::f32x4 (&acc)[2][2][4][2], const pg8::Unit& u, int wr, int wc, int fr, int fq) const {
#pragma unroll
        for (int ai = 0; ai < 2; ++ai)
#pragma unroll
            for (int m = 0; m < 4; ++m) {
                const int row = u.pm * 256 + ai * 128 + wr * 64 + m * 16 + fr;
                float v[8];
#pragma unroll
                for (int n = 0; n < 2; ++n)
#pragma unroll
                    for (int e = 0; e < 4; ++e) { const float g = acc[ai][0][m][n][e], uu = acc[ai][1][m][n][e]; v[4 * n + e] = g * sigmoidf_(g) * uu; }
                *(u32x4*)(ACT + (size_t)row * DFF + u.pn * 128 + wc * 32 + 8 * fq) = pack8(v);
            }
    }
};

#ifndef ATT_QREG
#define ATT_QREG 2
#endif
namespace att {
constexpr int NW = 8, QBLK = 32, KVBLK = 64;
constexpr float SCALE = 0.07216878364870322f;
constexpr float THR = 8.f;
constexpr int LDQ = 192, LDK = 192, LDV = 128, LDO = 1024;
constexpr int SHM_V = KVBLK * 128 * 2, SHM_K = KVBLK * 192 * 2, SHM_ATTN = 2 * SHM_V + 2 * SHM_K;
static_assert(SHM_ATTN <= 163840, "attention LDS");
#define KSWZ(row, colB) ((row) * 384 + ((colB) ^ (((row) & 7) << 4)))
#define SBAR() __builtin_amdgcn_sched_barrier(0)
__device__ __forceinline__ int crow(int r, int hi) { return (r & 3) + 8 * (r >> 2) + 4 * hi; }
__device__ __forceinline__ unsigned cvtpk(float lo, float hi) { return pk2(lo, hi); }
__device__ __forceinline__ void partialSM(f32x16& p0, f32x16& p1, float& m_reg, float& mn, float& alpha) {
  constexpr float C = SCALE * 1.4426950408889634f;
  float pmax = p0[0];
#pragma unroll
  for (int r = 1; r < 16; ++r) pmax = fmaxf(pmax, p0[r]);
#pragma unroll
  for (int r = 0; r < 16; ++r) pmax = fmaxf(pmax, p1[r]);
  { auto rr = __builtin_amdgcn_permlane32_swap(__float_as_uint(pmax), __float_as_uint(pmax), false, false);
    pmax = fmaxf(__uint_as_float(rr[0]), __uint_as_float(rr[1])); }
  if (__builtin_expect(__all(pmax - m_reg <= THR / SCALE), 1)) { mn = m_reg; alpha = 1.f; }
  else { mn = fmaxf(m_reg, pmax); alpha = __builtin_amdgcn_exp2f((m_reg - mn) * C); m_reg = mn; }
  float mnC = -mn * C;
#pragma unroll
  for (int r = 0; r < 16; ++r) p0[r] = fmaf(p0[r], C, mnC);
#pragma unroll
  for (int r = 0; r < 16; ++r) p1[r] = fmaf(p1[r], C, mnC);
#pragma unroll
  for (int r = 0; r < 16; ++r) p0[r] = __builtin_amdgcn_exp2f(p0[r]);
}
__device__ __forceinline__ void finishSM(f32x16& p0, f32x16& p1, float alpha, float& l_reg, bf16x8& pa0, bf16x8& pa1, bf16x8& pa2, bf16x8& pa3) {
#pragma unroll
  for (int r = 0; r < 16; ++r) p1[r] = __builtin_amdgcn_exp2f(p1[r]);
  float ps = 0;
#pragma unroll
  for (int r = 0; r < 16; ++r) ps += p0[r];
#pragma unroll
  for (int r = 0; r < 16; ++r) ps += p1[r];
  { auto rr = __builtin_amdgcn_permlane32_swap(__float_as_uint(ps), __float_as_uint(ps), false, false);
    ps = __uint_as_float(rr[0]) + __uint_as_float(rr[1]); }
  l_reg = l_reg * alpha + ps;
#define PK4(P, BASE, OUT) do { unsigned a0 = cvtpk(P[BASE + 0], P[BASE + 1]), a1 = cvtpk(P[BASE + 2], P[BASE + 3]);   \
    unsigned b0 = cvtpk(P[BASE + 4], P[BASE + 5]), b1 = cvtpk(P[BASE + 6], P[BASE + 7]);                              \
    auto r0 = __builtin_amdgcn_permlane32_swap(a0, b0, false, false); auto r1 = __builtin_amdgcn_permlane32_swap(a1, b1, false, false); \
    u32x4 w = {r0[0], r1[0], r0[1], r1[1]}; OUT = *reinterpret_cast<bf16x8*>(&w); } while (0)
  PK4(p0, 0, pa0); PK4(p0, 8, pa1); PK4(p1, 0, pa2); PK4(p1, 8, pa3);
#undef PK4
}
__device__ __forceinline__ void qkt(f32x16& p0, f32x16& p1, const char* Ks, const bf16x8* qr, int r32, int hi) {
  p0 = f32x16{}; p1 = f32x16{};
#pragma unroll
  for (int d0 = 0; d0 < 12; ++d0) { int cb = (d0 * 16 + hi * 8) * 2;
    bf16x8 b0 = *reinterpret_cast<const bf16x8*>(Ks + KSWZ(r32, cb));
    bf16x8 b1 = *reinterpret_cast<const bf16x8*>(Ks + KSWZ(32 + r32, cb));
    p0 = __builtin_amdgcn_mfma_f32_32x32x16_bf16(b0, qr[d0], p0, 0, 0, 0);
    p1 = __builtin_amdgcn_mfma_f32_32x32x16_bf16(b1, qr[d0], p1, 0, 0, 0); }
}
__device__ __forceinline__ int v_st(int k, int c) { const int kk = (k & ~0xC) | ((k & 4) << 1) | ((k & 8) >> 1); return ((kk >> 3) * 4 + (c >> 5)) * 512 + ((kk & 7) * 32 + (c & 31)) * 2; }
__device__ __forceinline__ int v_rd_base(int lane) { return ((lane & 3) << 3) | (((lane >> 2) & 3) << 6) | (((lane >> 4) & 1) << 5) | (((lane >> 5) & 1) << 8); }
constexpr int v_rd_off(int d0, int ks, int half) { return d0 * 512 + ks * 4096 + half * 2048; }
template <int OFF> __device__ __forceinline__ s16x4 tr_read(int vb) {
  s16x4 r; asm volatile("ds_read_b64_tr_b16 %0, %1 offset:%2" : "=&v"(r) : "v"(vb), "i"(OFF) : "memory"); return r;
}
template <int D0> __device__ __forceinline__ void pv_one(f32x16& od, int vb, bf16x8 pa0, bf16x8 pa1, bf16x8 pa2, bf16x8 pa3) {
  const s16x4 l0 = tr_read<v_rd_off(D0, 0, 0)>(vb), h0 = tr_read<v_rd_off(D0, 0, 1)>(vb), l1 = tr_read<v_rd_off(D0, 1, 0)>(vb), h1 = tr_read<v_rd_off(D0, 1, 1)>(vb);
  const s16x4 l2 = tr_read<v_rd_off(D0, 2, 0)>(vb), h2 = tr_read<v_rd_off(D0, 2, 1)>(vb), l3 = tr_read<v_rd_off(D0, 3, 0)>(vb), h3 = tr_read<v_rd_off(D0, 3, 1)>(vb);
  asm volatile("s_waitcnt lgkmcnt(0)" ::: "memory"); SBAR();
#define PK(L, H) (bf16x8){L[0], L[1], L[2], L[3], H[0], H[1], H[2], H[3]}
  od = __builtin_amdgcn_mfma_f32_32x32x16_bf16(pa0, PK(l0, h0), od, 0, 0, 0);
  od = __builtin_amdgcn_mfma_f32_32x32x16_bf16(pa1, PK(l1, h1), od, 0, 0, 0);
  od = __builtin_amdgcn_mfma_f32_32x32x16_bf16(pa2, PK(l2, h2), od, 0, 0, 0);
  od = __builtin_amdgcn_mfma_f32_32x32x16_bf16(pa3, PK(l3, h3), od, 0, 0, 0);
#undef PK
}
__device__ __forceinline__ void pv_d0(f32x16* o, int vb, bf16x8 pa0, bf16x8 pa1, bf16x8 pa2, bf16x8 pa3) {
  pv_one<0>(o[0], vb, pa0, pa1, pa2, pa3); pv_one<1>(o[1], vb, pa0, pa1, pa2, pa3); pv_one<2>(o[2], vb, pa0, pa1, pa2, pa3); pv_one<3>(o[3], vb, pa0, pa1, pa2, pa3);
}
__device__ __forceinline__ void attn_body(const bf16_t* __restrict__ Qb, const bf16_t* __restrict__ Kh, const bf16_t* __restrict__ Vh, bf16_t* __restrict__ Ob, int seq, char* lds) {
  const int tid = threadIdx.x, wid = tid >> 6, lane = tid & 63, r32 = lane & 31, hi = lane >> 5;
  char* V_lds = lds; char* K_lds = lds + 2 * SHM_V;
  float m_reg = -1e30f, l_reg = 0; f32x16 o[4] = {}; bf16x8 qr[12];
  const bf16_t* Qw = Qb + (long)(wid * QBLK + r32) * LDQ + hi * 8;
#pragma unroll
  for (int d0 = 0; d0 < 12; ++d0) qr[d0] = *reinterpret_cast<const bf16x8*>(Qw + d0 * 16);
  const int sr = tid >> 4, sc = (tid & 15) * 8, vst0 = v_st(sr, sc), vst1 = v_st(32 + sr, sc);
  const int kid0 = tid, kid1 = tid + 512, kid2 = tid + 1024;
  const int kr0 = kid0 / 24, kc0 = kid0 % 24, kr1 = kid1 / 24, kc1 = kid1 % 24, kr2 = kid2 / 24, kc2 = kid2 % 24;
  const int kg0 = kr0 * LDK + kc0 * 8, kg1 = kr1 * LDK + kc1 * 8, kg2 = kr2 * LDK + kc2 * 8;
  const int kl0 = KSWZ(kr0, kc0 * 16), kl1 = KSWZ(kr1, kc1 * 16), kl2 = KSWZ(kr2, kc2 * 16);
  const int vb0 = (int)(uintptr_t)V_lds + v_rd_base(lane);
  bf16x8 sA_v0, sA_v1, sA_k0, sA_k1, sA_k2;
#define SLOADA(k0) do { sA_v0 = *(const bf16x8*)&Vh[(long)((k0) + sr) * LDV + sc]; sA_v1 = *(const bf16x8*)&Vh[(long)((k0) + 32 + sr) * LDV + sc]; \
    sA_k0 = *(const bf16x8*)&Kh[(long)(k0) * LDK + kg0]; sA_k1 = *(const bf16x8*)&Kh[(long)(k0) * LDK + kg1]; sA_k2 = *(const bf16x8*)&Kh[(long)(k0) * LDK + kg2]; } while (0)
#define SWRITEA(b) do { *(bf16x8*)(V_lds + (b) * SHM_V + vst0) = sA_v0; *(bf16x8*)(V_lds + (b) * SHM_V + vst1) = sA_v1; \
    *(bf16x8*)(K_lds + (b) * SHM_K + kl0) = sA_k0; *(bf16x8*)(K_lds + (b) * SHM_K + kl1) = sA_k1; *(bf16x8*)(K_lds + (b) * SHM_K + kl2) = sA_k2; } while (0)
#define SWAIT() asm volatile("s_waitcnt vmcnt(0)" ::: "memory")
#define RESC(a) do { if (__any((a) < 1.f)) { \
    _Pragma("unroll") for (int r = 0; r < 16; ++r) { const float al_ = __shfl((a), crow(r, hi)); _Pragma("unroll") for (int d = 0; d < 4; ++d) o[d][r] *= al_; } } } while (0)
  const int NT = seq / KVBLK;
  SLOADA(0); SWAIT(); SWRITEA(0); __syncthreads();
#pragma unroll 1
  for (int j = 0; j < NT; ++j) {
    const int b = j & 1;
    if (j + 1 < NT) SLOADA((j + 1) * KVBLK);
    f32x16 p0, p1; float mn, al; bf16x8 pa0, pa1, pa2, pa3;
    SBAR(); qkt(p0, p1, K_lds + b * SHM_K, qr, r32, hi);
    partialSM(p0, p1, m_reg, mn, al);
    RESC(al);
    finishSM(p0, p1, al, l_reg, pa0, pa1, pa2, pa3); SBAR();
    pv_d0(o, vb0 + b * SHM_V, pa0, pa1, pa2, pa3);
    if (j + 1 < NT) { SWAIT(); SWRITEA(b ^ 1); }
    __syncthreads();
  }
  float rli[16];
#pragma unroll
  for (int r = 0; r < 16; ++r) rli[r] = __builtin_amdgcn_rcpf(__shfl(l_reg, crow(r, hi)));
  bf16_t* Ow = Ob + (long)(wid * QBLK) * LDO;
#pragma unroll
  for (int r = 0; r < 16; ++r) { int orow = crow(r, hi);
#pragma unroll
    for (int d0 = 0; d0 < 4; ++d0) Ow[(long)orow * LDO + d0 * 32 + r32] = (bf16_t)f2bf(o[d0][r] * rli[r]); }
  asm volatile("s_waitcnt vmcnt(0)" ::: "memory");
  __syncthreads();
#undef SLOADA
#undef SWRITEA
#undef SWAIT
#undef RESC
}
}

__device__ __forceinline__ int hgrn_chunk_row0(int dir, int b, int p) {
    if (p < 4) return ML + b * CTXL + 64 * (dir ? 3 - p : p);
    return b * SEQ + 64 * (dir ? 63 - (p - 4) : p - 4);
}
__device__ __forceinline__ void passA_ptrs(const Args& a, int item, int& dir, int& bh, int& p, size_t& goff) {
    dir = item / (32 * NCH); const int rem = item % (32 * NCH); bh = rem / NCH; p = rem % NCH;
    const int row0 = hgrn_chunk_row0(dir, bh >> 2, p);
    goff = (size_t)row0 * 512 + (bh & 3) * 128;
}
__device__ __forceinline__ void passA_load(const Args& a, int item, int k, int qd, unsigned (&graw)[16], unsigned (&vraw)[16]) {
    int dir, bh, p; size_t goff; passA_ptrs(a, item, dir, bh, p, goff);
    const unsigned short* G = (const unsigned short*)(a.ws + (dir ? WS_GB : WS_GF)) + goff;
    const bf16_t* Vp = (const bf16_t*)(a.ws + WS_HI) + goff;
#pragma unroll
    for (int i = 0; i < 16; ++i) { graw[i] = G[(size_t)(16 * qd + i) * 512 + k]; vraw[i] = Vp[(size_t)(16 * qd + i) * 512 + k]; }
}
__device__ __forceinline__ void hgrn_passA_loop(const Args& a, char* lds, int G_) {
    const int tid = threadIdx.x, wave = tid >> 6, lane = tid & 63, r32 = lane & 31, hi = lane >> 5;
    char* Kt = lds; char* Vt = lds + 128 * 144; float* qt = (float*)(lds + 2 * 128 * 144);
    const int k = tid & 127, qd = tid >> 7;
    constexpr int NIT = 2 * 32 * NCH;
    unsigned graw[16], vraw[16];
    if ((int)blockIdx.x < NIT) passA_load(a, blockIdx.x, k, qd, graw, vraw);
    for (int item = blockIdx.x; item < NIT; item += G_) {
        int dir, bh, p; size_t goff; passA_ptrs(a, item, dir, bh, p, goff);
        float gv[16], bl[16];
#pragma unroll
        for (int i = 0; i < 16; ++i) gv[i] = (float)__builtin_bit_cast(_Float16, (unsigned short)graw[i]);
        float run = 0.f;
        if (dir == 0) {
#pragma unroll
            for (int i = 0; i < 16; ++i) { run += gv[i]; bl[i] = run; }
        } else {
#pragma unroll
            for (int i = 15; i >= 0; --i) { run += gv[i]; bl[i] = run; }
        }
        qt[qd * 128 + k] = run;
        __syncthreads();
        const float q0 = qt[k], q1 = qt[128 + k], q2 = qt[256 + k], q3 = qt[384 + k];
        const float tot = (q0 + q1) + (q2 + q3);
        float off;
        if (dir == 0) off = (qd > 0 ? q0 : 0.f) + (qd > 1 ? q1 : 0.f) + (qd > 2 ? q2 : 0.f);
        else          off = (qd < 3 ? q3 : 0.f) + (qd < 2 ? q2 : 0.f) + (qd < 1 ? q1 : 0.f);
        unsigned short* Gw = (unsigned short*)(a.ws + (dir ? WS_GB : WS_GF)) + goff;
        unsigned kw[8], vw[8];
#pragma unroll
        for (int i = 0; i < 16; ++i) { bl[i] += off; Gw[(size_t)(16 * qd + i) * 512 + k] = (unsigned short)fminf(65535.f, rintf(bl[i] * -1024.f)); }
#pragma unroll
        for (int i = 0; i < 8; ++i) {
            const float k0 = (1.f - __expf(gv[2 * i])) * __expf(tot - bl[2 * i]), k1 = (1.f - __expf(gv[2 * i + 1])) * __expf(tot - bl[2 * i + 1]);
            kw[i] = pk2(k0, k1);
            vw[i] = vraw[2 * i] | (vraw[2 * i + 1] << 16);
        }
        *(u32x4*)(Kt + k * 144 + qd * 32) = (u32x4){kw[0], kw[1], kw[2], kw[3]}; *(u32x4*)(Kt + k * 144 + qd * 32 + 16) = (u32x4){kw[4], kw[5], kw[6], kw[7]};
        *(u32x4*)(Vt + k * 144 + qd * 32) = (u32x4){vw[0], vw[1], vw[2], vw[3]}; *(u32x4*)(Vt + k * 144 + qd * 32 + 16) = (u32x4){vw[4], vw[5], vw[6], vw[7]};
        const size_t slot = (size_t)(dir * 32 + bh) * NCH + p;
        if (qd == 0) ((float*)(a.ws + WS_DG))[slot * 128 + k] = __expf(tot);
        if (item + G_ < NIT) passA_load(a, item + G_, k, qd, graw, vraw);
        __syncthreads();
        const int kb = wave >> 1, vb0 = (wave & 1) * 2;
        f32x16 acc0 = {}, acc1 = {};
#pragma unroll
        for (int ks = 0; ks < 4; ++ks) {
            const bf16x8 af = *(const bf16x8*)(Kt + (32 * kb + r32) * 144 + ks * 32 + hi * 16);
            const bf16x8 b0 = *(const bf16x8*)(Vt + (32 * vb0 + r32) * 144 + ks * 32 + hi * 16);
            const bf16x8 b1 = *(const bf16x8*)(Vt + (32 * (vb0 + 1) + r32) * 144 + ks * 32 + hi * 16);
            acc0 = __builtin_amdgcn_mfma_f32_32x32x16_bf16(af, b0, acc0, 0, 0, 0);
            acc1 = __builtin_amdgcn_mfma_f32_32x32x16_bf16(af, b1, acc1, 0, 0, 0);
        }
        bf16_t* Lt = (bf16_t*)(a.ws + WS_A) + slot * 16384;
#pragma unroll
        for (int rg = 0; rg < 4; ++rg) {
            const int k4 = 32 * kb + 8 * rg + 4 * hi;
            u32x2 w0, w1; w0.x = pk2(acc0[4 * rg], acc0[4 * rg + 1]); w0.y = pk2(acc0[4 * rg + 2], acc0[4 * rg + 3]);
            w1.x = pk2(acc1[4 * rg], acc1[4 * rg + 1]); w1.y = pk2(acc1[4 * rg + 2], acc1[4 * rg + 3]);
            *(u32x2*)(Lt + (size_t)(32 * vb0 + r32) * 128 + k4) = w0;
            *(u32x2*)(Lt + (size_t)(32 * (vb0 + 1) + r32) * 128 + k4) = w1;
        }
        __syncthreads();
    }
}
__device__ __forceinline__ void hgrn_passB(const Args& a, int G) {
    bf16_t* LS = (bf16_t*)(a.ws + WS_A); const float* DG = (const float*)(a.ws + WS_DG);
    for (int it = blockIdx.x * 512 + threadIdx.x; it < 64 * 2048; it += G * 512) {
        const int dbh = it >> 11, e8 = it & 2047, k0 = (e8 & 15) * 8;
        bf16_t* base = LS + (size_t)dbh * NCH * 16384 + e8 * 8; const float* dp = DG + (size_t)dbh * NCH * 128 + k0;
        float S[8];
#pragma unroll
        for (int e = 0; e < 8; ++e) S[e] = 0.f;
#pragma unroll 4
        for (int p = 0; p < NCH; ++p) {
            const u32x4 L = *(const u32x4*)(base + (size_t)p * 16384);
            const f32x4 d0 = *(const f32x4*)(dp + p * 128), d1 = *(const f32x4*)(dp + p * 128 + 4);
            if (p >= 4) { u32x4 w; w.x = pk2(S[0], S[1]); w.y = pk2(S[2], S[3]); w.z = pk2(S[4], S[5]); w.w = pk2(S[6], S[7]); *(u32x4*)(base + (size_t)p * 16384) = w; }
            S[0] = d0.x * S[0] + bf2f(L.x & 0xffffu); S[1] = d0.y * S[1] + bf2f(L.x >> 16);
            S[2] = d0.z * S[2] + bf2f(L.y & 0xffffu); S[3] = d0.w * S[3] + bf2f(L.y >> 16);
            S[4] = d1.x * S[4] + bf2f(L.z & 0xffffu); S[5] = d1.y * S[5] + bf2f(L.z >> 16);
            S[6] = d1.z * S[6] + bf2f(L.w & 0xffffu); S[7] = d1.w * S[7] + bf2f(L.w >> 16);
        }
    }
}
__device__ __forceinline__ float b16f(unsigned v) { return (float)v * (-1.f / 1024.f); }
__device__ __forceinline__ unsigned u16at(const u32x4 (&v)[2], int e) { const unsigned w = v[e >> 3][(e & 7) >> 1]; return (e & 1) ? (w >> 16) : (w & 0xffffu); }
struct PassCDir { u32x4 bt[2], bn[2], br[2], S[4]; };
__device__ __forceinline__ void passC_load_dir(const Args& a, int dir, int bh, int lc, int row0, int h, int tok, int ks, int tid, PassCDir& D) {
    const unsigned short* B = (const unsigned short*)(a.ws + (dir ? WS_GB : WS_GF)) + (size_t)row0 * 512 + h * 128 + ks;
    const int nb = dir ? (tok < 63 ? tok + 1 : 63) : (tok > 0 ? tok - 1 : 0), rf = dir ? 32 : 31;
    D.bt[0] = *(const u32x4*)(B + (size_t)tok * 512); D.bt[1] = *(const u32x4*)(B + (size_t)tok * 512 + 8);
    D.bn[0] = *(const u32x4*)(B + (size_t)nb * 512);  D.bn[1] = *(const u32x4*)(B + (size_t)nb * 512 + 8);
    D.br[0] = *(const u32x4*)(B + (size_t)rf * 512);  D.br[1] = *(const u32x4*)(B + (size_t)rf * 512 + 8);
    const int p = dir ? 4 + 63 - lc : 4 + lc;
    const u32x4* Sg = (const u32x4*)((const bf16_t*)(a.ws + WS_A) + ((size_t)(dir * 32 + bh) * NCH + p) * 16384);
#pragma unroll
    for (int i = 0; i < 4; ++i) D.S[i] = Sg[tid + 512 * i];
}
__device__ __forceinline__ void passC_ops(const PassCDir& D, bool has_nb, const u32x4 (&q)[2], char* St, char* Qd, char* Qd2, char* Kd2, int tok, int ks, int tid) {
    float qd_[16], qd2_[16], kd2_[16];
#pragma unroll
    for (int e = 0; e < 16; ++e) {
        const float b = b16f(u16at(D.bt, e)), nbv = has_nb ? b16f(u16at(D.bn, e)) : 0.f, bref = b16f(u16at(D.br, e));
        const float g = b - nbv, d = b - bref, qv = bf2f(u16at(q, e));
        qd_[e] = qv * __expf(b); qd2_[e] = qv * __expf(d); kd2_[e] = (1.f - __expf(g)) * __expf(-d);
    }
#pragma unroll
    for (int hlf = 0; hlf < 2; ++hlf) {
        u32x4 w;
        w.x = pk2(qd_[8 * hlf + 0], qd_[8 * hlf + 1]); w.y = pk2(qd_[8 * hlf + 2], qd_[8 * hlf + 3]); w.z = pk2(qd_[8 * hlf + 4], qd_[8 * hlf + 5]); w.w = pk2(qd_[8 * hlf + 6], qd_[8 * hlf + 7]);
        *(u32x4*)(Qd + tok * 272 + ks * 2 + hlf * 16) = w;
        w.x = pk2(qd2_[8 * hlf + 0], qd2_[8 * hlf + 1]); w.y = pk2(qd2_[8 * hlf + 2], qd2_[8 * hlf + 3]); w.z = pk2(qd2_[8 * hlf + 4], qd2_[8 * hlf + 5]); w.w = pk2(qd2_[8 * hlf + 6], qd2_[8 * hlf + 7]);
        *(u32x4*)(Qd2 + tok * 272 + ks * 2 + hlf * 16) = w;
        w.x = pk2(kd2_[8 * hlf + 0], kd2_[8 * hlf + 1]); w.y = pk2(kd2_[8 * hlf + 2], kd2_[8 * hlf + 3]); w.z = pk2(kd2_[8 * hlf + 4], kd2_[8 * hlf + 5]); w.w = pk2(kd2_[8 * hlf + 6], kd2_[8 * hlf + 7]);
        *(u32x4*)(Kd2 + tok * 272 + ks * 2 + hlf * 16) = w;
    }
#pragma unroll
    for (int i = 0; i < 4; ++i) { const int id = tid + 512 * i; *(u32x4*)(St + (id >> 4) * 272 + (id & 15) * 16) = D.S[i]; }
}
__device__ __forceinline__ void passC_mma1(f32x16& o, int dir, const char* St, const char* Qd, const char* Qd2, const char* Kd2, char* Pb, int wave, int r32, int hi) {
    const int rb = wave >> 2, cb = wave & 3, tr = (wave & 3) >> 1, tc = wave & 1;
    f32x16 pacc = {};
#pragma unroll
    for (int kk = 0; kk < 8; ++kk) {
        const bf16x8 af = *(const bf16x8*)(Qd + (32 * rb + r32) * 272 + kk * 32 + hi * 16);
        const bf16x8 bf = *(const bf16x8*)(St + (32 * cb + r32) * 272 + kk * 32 + hi * 16);
        o = __builtin_amdgcn_mfma_f32_32x32x16_bf16(af, bf, o, 0, 0, 0);
        const bf16x8 a2 = *(const bf16x8*)(Qd2 + (32 * tr + r32) * 272 + kk * 32 + hi * 16);
        const bf16x8 b2 = *(const bf16x8*)(Kd2 + (32 * tc + r32) * 272 + kk * 32 + hi * 16);
        pacc = __builtin_amdgcn_mfma_f32_32x32x16_bf16(a2, b2, pacc, 0, 0, 0);
    }
    if (wave < 4) {
#pragma unroll
        for (int r = 0; r < 16; ++r) {
            const int t = 32 * tr + att::crow(r, hi), s_ = 32 * tc + r32;
            const bool keep = dir ? (s_ >= t) : (s_ <= t);
            *(bf16_t*)(Pb + t * 144 + s_ * 2) = (bf16_t)f2bf(keep ? pacc[r] : 0.f);
        }
    }
}
__device__ __forceinline__ void passC_mma2(f32x16& o, const char* Pb, const char* Vt, int wave, int r32, int hi) {
    const int rb = wave >> 2, cb = wave & 3;
#pragma unroll
    for (int ks = 0; ks < 4; ++ks) {
        const bf16x8 af = *(const bf16x8*)(Pb + (32 * rb + r32) * 144 + ks * 32 + hi * 16);
        const bf16x8 bf = *(const bf16x8*)(Vt + (32 * cb + r32) * 144 + ks * 32 + hi * 16);
        o = __builtin_amdgcn_mfma_f32_32x32x16_bf16(af, bf, o, 0, 0, 0);
    }
}
__device__ __forceinline__ void hgrn_passC(const Args& a, char* lds, int item) {
    const int tid = threadIdx.x, wave = tid >> 6, lane = tid & 63, r32 = lane & 31, hi = lane >> 5;
    const int bh = item >> 6, lc = item & 63, b = bh >> 2, h = bh & 3;
    const int row0 = b * SEQ + 64 * lc;
    char* St = lds; char* Qd = lds + 34816; char* Qd2 = lds + 52224; char* Kd2 = lds + 69632; char* Vt = lds + 87040; char* Pb = lds + 105472; float* Os = (float*)(lds + 34816);
    const int tok = tid >> 3, ks = (tid & 7) * 16;
    const size_t roff = (size_t)(row0 + tok) * 512 + h * 128 + ks;
    u32x4 q[2], vv[2], hg[2];
    { const bf16_t* Qp = (const bf16_t*)(a.ws + WS_HQ) + roff; q[0] = *(const u32x4*)Qp; q[1] = *(const u32x4*)(Qp + 8);
      const bf16_t* Vp = (const bf16_t*)(a.ws + WS_HI) + roff; vv[0] = *(const u32x4*)Vp; vv[1] = *(const u32x4*)(Vp + 8);
      const bf16_t* Hp = (const bf16_t*)(a.ws + WS_HG) + roff; hg[0] = *(const u32x4*)Hp; hg[1] = *(const u32x4*)(Hp + 8); }
    PassCDir D0, D1;
    passC_load_dir(a, 0, bh, lc, row0, h, tok, ks, tid, D0);
    passC_load_dir(a, 1, bh, lc, row0, h, tok, ks, tid, D1);
#pragma unroll
    for (int e = 0; e < 16; ++e) *(bf16_t*)(Vt + (ks + e) * 144 + tok * 2) = (bf16_t)u16at(vv, e);
    passC_ops(D0, tok > 0, q, St, Qd, Qd2, Kd2, tok, ks, tid);
    __syncthreads();
    f32x16 o = {};
    passC_mma1(o, 0, St, Qd, Qd2, Kd2, Pb, wave, r32, hi);
    __syncthreads();
    passC_mma2(o, Pb, Vt, wave, r32, hi);
    passC_ops(D1, tok < 63, q, St, Qd, Qd2, Kd2, tok, ks, tid);
    __syncthreads();
    passC_mma1(o, 1, St, Qd, Qd2, Kd2, Pb, wave, r32, hi);
    __syncthreads();
    passC_mma2(o, Pb, Vt, wave, r32, hi);
    {
        const int rb = wave >> 2, cb = wave & 3;
#pragma unroll
        for (int r = 0; r < 16; ++r) Os[(32 * rb + att::crow(r, hi)) * 128 + 32 * cb + r32] = o[r];
    }
    __syncthreads();
    {
        float ov[16]; float ss = 0.f;
#pragma unroll
        for (int e = 0; e < 16; ++e) { ov[e] = Os[tok * 128 + ks + e]; ss += ov[e] * ov[e]; }
        ss += __shfl_xor(ss, 1); ss += __shfl_xor(ss, 2); ss += __shfl_xor(ss, 4);
        const float rstd = rsqrtf(ss * (1.f / 128.f) + EPS);
        float res[16];
#pragma unroll
        for (int e = 0; e < 16; ++e) { const float hv = bf2f(u16at(hg, e)); res[e] = ov[e] * rstd * a.g_on[ks + e] * (hv * sigmoidf_(hv)); }
        bf16_t* Mx = (bf16_t*)(a.ws + WS_MIX) + (size_t)(row0 + tok) * 1024 + 512 + h * 128 + ks;
        u32x4 w;
        w.x = pk2(res[0], res[1]); w.y = pk2(res[2], res[3]); w.z = pk2(res[4], res[5]); w.w = pk2(res[6], res[7]); *(u32x4*)Mx = w;
        w.x = pk2(res[8], res[9]); w.y = pk2(res[10], res[11]); w.z = pk2(res[12], res[13]); w.w = pk2(res[14], res[15]); *(u32x4*)(Mx + 8) = w;
    }
    __syncthreads();
}

#define XB_TMO      128
#define XB_XCNT(j)  (256  + 64 * (j))
#define XB_XSUB(j)  (1280 + 64 * (j))
#define XB_XGEN(j)  (2304 + 64 * (j))
#define XB_TOP      3328
#define XB_TOPGEN   3392
#define XCD_BAR_WORDS 3456
#define XB_SPIN_CAP (1u << 18)

__device__ __forceinline__ unsigned xb_ld(unsigned* p)              { return __hip_atomic_load(p, __ATOMIC_RELAXED, __HIP_MEMORY_SCOPE_AGENT); }
__device__ __forceinline__ unsigned xb_add(unsigned* p, unsigned v) { return __hip_atomic_fetch_add(p, v, __ATOMIC_RELAXED, __HIP_MEMORY_SCOPE_AGENT); }
__device__ __forceinline__ unsigned xb_xcc_id() { return (unsigned)__builtin_amdgcn_s_getreg((3 << 11) | 20) & 0xFu; }
#define XB_SPIN(cond, bar) do { unsigned _sp = 0; while (cond) { __builtin_amdgcn_s_sleep(1); \
    if ((++_sp & 255u) == 0u) { if (xb_ld(&(bar)[XB_TMO])) break; if (_sp > XB_SPIN_CAP) { atomicAdd(&(bar)[XB_TMO], 1u); break; } } } } while (0)

struct XcdBarrier {
    unsigned* bar; unsigned x;
    volatile LAS unsigned* st;
};

__device__ __forceinline__ XcdBarrier xcd_barrier_post(unsigned* bar, volatile LAS unsigned* st) {
    XcdBarrier b; b.bar = bar; b.x = xb_xcc_id(); b.st = st;
    if (threadIdx.x == 0) (void)xb_add(&bar[XB_XCNT(b.x)], 1u);
    return b;
}
__device__ __forceinline__ void xcd_barrier_complete(unsigned* bar, unsigned x, unsigned& nloc, unsigned& nx) {
    const unsigned G = gridDim.x * gridDim.y * gridDim.z;
    unsigned sum, cnt, mine, sp = 0u;
    for (;;) {
        sum = 0u; cnt = 0u; mine = 0u;
#pragma unroll
        for (unsigned j = 0; j < 16; ++j) { const unsigned c = xb_ld(&bar[XB_XCNT(j)]); sum += c; cnt += (c > 0u) ? 1u : 0u; mine = (j == x) ? c : mine; }
        if (sum == G) break;
        __builtin_amdgcn_s_sleep(1);
        if ((++sp & 255u) == 0u) { if (xb_ld(&bar[XB_TMO])) break; if (sp > XB_SPIN_CAP) { atomicAdd(&bar[XB_TMO], 1u); break; } }
    }
    nloc = mine > 0u ? mine : 1u; nx = cnt > 0u ? cnt : 1u;
}

__device__ __forceinline__ void xcd_barrier(const XcdBarrier& b) {
    asm volatile("s_waitcnt vmcnt(0)" ::: "memory");
    __syncthreads();
    if (threadIdx.x == 0) {
        unsigned* bar = b.bar;
        __builtin_amdgcn_s_waitcnt(0);
        unsigned nloc = b.st[0], nx = b.st[1];
        if (nloc == 0u) { xcd_barrier_complete(bar, b.x, nloc, nx); b.st[0] = nloc; b.st[1] = nx; }
        const unsigned old = xb_add(&bar[XB_XSUB(b.x)], 1u);
        const unsigned gen = old / nloc;
        if (old + 1u == (gen + 1u) * nloc) {
            __builtin_amdgcn_fence(__ATOMIC_RELEASE, "agent");
            asm volatile("s_waitcnt vmcnt(0)" ::: "memory");
            const unsigned og = xb_add(&bar[XB_TOP], 1u);
            const unsigned tg = og / nx;
            if (og + 1u == (tg + 1u) * nx) xb_add(&bar[XB_TOPGEN], 1u);
            else XB_SPIN(xb_ld(&bar[XB_TOPGEN]) == tg, bar);
            __builtin_amdgcn_fence(__ATOMIC_ACQUIRE, "agent");
            xb_add(&bar[XB_XGEN(b.x)], 1u);
            asm volatile("s_waitcnt vmcnt(0)" ::: "memory");
        } else {
            XB_SPIN(xb_ld(&bar[XB_XGEN(b.x)]) == gen, bar);
            __builtin_amdgcn_fence(__ATOMIC_ACQUIRE, "agent");
            asm volatile("s_waitcnt vmcnt(0)" ::: "memory");
        }
    }
    __syncthreads();
}

__global__ void __launch_bounds__(512, 2) fwd_megakernel(Args a) {
    extern __shared__ __attribute__((aligned(16))) unsigned char lds[];
    cg::grid_group grid = cg::this_grid();
    const int tid = threadIdx.x, wave = __builtin_amdgcn_readfirstlane(tid >> 6), lane = tid & 63;
    const int G = gridDim.x;
    unsigned char* ws = a.ws;
    LAS unsigned char* ldsl = (LAS unsigned char*)lds;
    char* ldsc = (char*)lds;
    const int lo = a.ph_lo, hi = a.ph_hi;
#ifndef SKIPMASK
#define SKIPMASK 0
#endif
#ifndef REPMASK
#define REPMASK 0
#endif
#define REPN(k) (((REPMASK >> (k)) & 1) ? 2 : 1)
#define IN(k) (!((SKIPMASK >> (k)) & 1) && lo <= (k) && (k) < hi)
#define SEAM(k) do { if (lo <= (k) && (k) + 1 < hi) { if ((k) == 0) grid.sync(); else xcd_barrier(xbar); } } while (0)
    volatile LAS unsigned* xst = (volatile LAS unsigned*)(ldsl + LDS_BYTES - 16);
    if (tid < 4) xst[tid] = 0u;
    __syncthreads();
    XcdBarrier xbar; xbar.bar = (unsigned*)(ws + WS_BAR); xbar.x = 0; xbar.st = xst;
    if (hi - lo > 1) xbar = xcd_barrier_post((unsigned*)(ws + WS_BAR), xst);
    float* MOD = (float*)(ws + WS_MOD);
    float* RSS = (float*)(ws + WS_RSSP);
    const float* RC = (const float*)(ws + WS_RCOS); const float* RS = (const float*)(ws + WS_RSIN);
    bf16_t* Hb = (bf16_t*)(ws + WS_A);
    bf16_t* Qb = (bf16_t*)a.out;
    bf16_t* Kb = (bf16_t*)((char*)a.out + 48 * MiB);
    bf16_t* Vb = (bf16_t*)(ws + WS_V);
    bf16_t* MIX = (bf16_t*)(ws + WS_MIX);
    const int gw = blockIdx.x * 8 + wave, NGW = G * 8;

    if (IN(0)) { p0_prologue(a, ldsc, G); }
    SEAM(0);
    if (IN(1)) {
        for (int r0 = gw; r0 < MT; r0 += 4 * NGW) {
            const float* src[4]; const float* md[4]; bf16_t* dst[4]; bool ok[4];
#pragma unroll
            for (int i = 0; i < 4; ++i) { const int r = r0 + i * NGW; ok[i] = r < MT; const int rr = ok[i] ? r : r0; const bool lat = rr < ML;
                src[i] = lat ? a.x + (size_t)rr * 1024 : a.ctx + (size_t)(rr - ML) * 1024; md[i] = MOD + (size_t)(lat ? (rr >> 12) : 8) * 6144; dst[i] = Hb + (size_t)rr * 1024; }
            rows_norm_mod_bf16<4>(src, a.g_mix, md, 0, dst, ok, lane);
        }
    }
#ifdef ZERO_MIX
    if (IN(1)) { u32x4* mz = (u32x4*)(ws + WS_MIX); const u32x4 z = {0u, 0u, 0u, 0u}; for (size_t i = (size_t)blockIdx.x * 512 + tid; i < (size_t)ML * 1024 * 2 / 16; i += (size_t)G * 512) mz[i] = z; }
#endif
    SEAM(1);
    if (IN(2)) {
        pg8::Gemm g{Hb, (const bf16_t*)(ws + WS_WIN), MT, NINP, 1024}; pg8::StaticOrder S; S.init(MT, NINP, G, (int)blockIdx.x);
        EpiInProj E{ws, Kb};
        pg8::gemm_phase<EpiInProj, pg8::StaticOrder, true, true>(ldsl, g, S, E);
    }
    SEAM(2);
    if (IN(3)) {
#ifndef SKIP3A
        { pg8::Gemm g{(const bf16_t*)(ws + WS_CQ), (const bf16_t*)(ws + WS_WUQ), ML, 768, 256}; pg8::StaticOrder S; S.init(ML, 768, G, (int)blockIdx.x);
          EpiQ E{Qb, RSS, RC, RS};
          pg8::gemm_phase<EpiQ, pg8::StaticOrder, true, true>(ldsl, g, S, E); }
#endif
#ifndef SKIP3B
        { pg8::Gemm g{(const bf16_t*)(ws + WS_CKV), (const bf16_t*)(ws + WS_WUKV), MT, 1024, 256}; pg8::StaticOrder S; S.init(MT, 1024, G, (int)blockIdx.x);
          EpiKV E{Kb, Vb, RSS};
          pg8::gemm_phase<EpiKV, pg8::StaticOrder, true, true>(ldsl, g, S, E); }
#endif
#ifndef SKIP3C
        hgrn_passA_loop(a, ldsc, G);
#endif
    }
#ifdef EXPJ
    if (IN(3)) {
        const u32x4* srcA = (const u32x4*)(ws + EXPJ_A); const u32x4* srcB = (const u32x4*)(ws + EXPJ_B); u32x4* dst = (u32x4*)MIX;
        for (size_t i = (size_t)blockIdx.x * 512 + tid; i < (size_t)ML * 64; i += (size_t)G * 512) { const size_t r = i >> 6, c = i & 63; dst[r * 128 + c] = srcA[r * 64 + c]; dst[r * 128 + 64 + c] = srcB[r * 64 + c]; }
    }
#endif
    SEAM(3);
    if (IN(4)) { hgrn_passB(a, G); }
    SEAM(4);
    if (IN(5)) {
#ifndef SKIP5A
        for (int u = blockIdx.x; u < 512; u += G) {
            int bh, qb;
            if (G == 256) { const int xcd = blockIdx.x & 7, cu = blockIdx.x >> 3, i = u >> 8; bh = xcd * 4 + i * 2 + (cu >> 4); qb = cu & 15; }
            else { bh = u >> 4; qb = u & 15; }
            const int b = bh >> 2, h = bh & 3;
            att::attn_body(Qb + ((size_t)bh * SEQ + qb * 256) * 192, Kb + (size_t)bh * KVL * 192, Vb + (size_t)bh * KVL * 128,
                           MIX + ((size_t)b * SEQ + qb * 256) * 1024 + h * 128, KVL, ldsc);
        }
#endif
#ifndef SKIP5B
        for (int it = blockIdx.x; it < 2048; it += G) hgrn_passC(a, ldsc, it);
#endif
    }
#ifdef EXPM
    if (IN(5)) { const u32x4* src = (const u32x4*)(ws + WS_A); u32x4* dst = (u32x4*)MIX;
        for (size_t i = (size_t)blockIdx.x * 512 + tid; i < (size_t)ML * 128; i += (size_t)G * 512) dst[i] = src[i]; }
#endif
    SEAM(5);
    if (IN(6)) {
        pg8::Gemm g{MIX, (const bf16_t*)(ws + WS_WOUT), ML, 1024, 1024}; pg8::StaticOrder S; S.init(ML, 1024, G, (int)blockIdx.x);
        EpiRes E{a.x, a.out, MOD + 2048};
        pg8::gemm_phase<EpiRes, pg8::StaticOrder, true, true>(ldsl, g, S, E);
    }
    SEAM(6);
    if (IN(7)) {
        for (int r0 = gw; r0 < ML; r0 += 4 * NGW) {
            const float* src[4]; const float* md[4]; bf16_t* dst[4]; bool ok[4];
#pragma unroll
            for (int i = 0; i < 4; ++i) { const int r = r0 + i * NGW; ok[i] = r < ML; const int rr = ok[i] ? r : r0;
                src[i] = a.out + (size_t)rr * 1024; md[i] = MOD + (size_t)(rr >> 12) * 6144; dst[i] = Hb + (size_t)rr * 1024; }
            rows_norm_mod_bf16<4>(src, a.g_ffn, md, 3072, dst, ok, lane);
        }
    }
    SEAM(7);
    if (IN(8)) {
        pg8::Gemm g{Hb, (const bf16_t*)(ws + WS_WGU), ML, 2 * DFF, 1024}; pg8::StaticOrder S; S.init(ML, 2 * DFF, G, (int)blockIdx.x);
        EpiSwiglu E{(bf16_t*)(ws + WS_ACT)};
        pg8::gemm_phase<EpiSwiglu, pg8::StaticOrder, true, true>(ldsl, g, S, E);
    }
    SEAM(8);
    if (IN(9)) {
        pg8::Gemm g{(const bf16_t*)(ws + WS_ACT), (const bf16_t*)(ws + WS_WDN), ML, 1024, DFF}; pg8::StaticOrder S; S.init(ML, 1024, G, (int)blockIdx.x);
        EpiRes E{a.out, a.out, MOD + 5120};
        pg8::gemm_phase<EpiRes, pg8::StaticOrder, true, true>(ldsl, g, S, E);
    }
    SEAM(9);
    if (IN(10)) {
        if (ML % (4 * NGW) == 0) { for (int r0 = gw; r0 < ML; r0 += 4 * NGW) { float* rows[4];
#pragma unroll
            for (int i = 0; i < 4; ++i) rows[i] = a.out + (size_t)(r0 + i * NGW) * 1024;
            rows_norm_f32<4>(rows, a.g_final, lane); } }
        else { for (int r = gw; r < ML; r += NGW) { float* rows[1] = {a.out + (size_t)r * 1024}; rows_norm_f32<1>(rows, a.g_final, lane); } }
    }
#ifdef EXTRA_SYNCS
    if (hi - lo > 5) { for (int i_ = 0; i_ < EXTRA_SYNCS; ++i_) grid.sync(); }
#endif
#ifdef PROBE_PHASE
    if (a.ph_lo == 11) {
        for (int u = blockIdx.x; u < 512; u += G) {
            int bh, qb;
            if (G == 256) { const int xcd = blockIdx.x & 7, cu = blockIdx.x >> 3, i = u >> 8; bh = xcd * 4 + i * 2 + (cu >> 4); qb = cu & 15; }
            else { bh = u >> 4; qb = u & 15; }
            const int b = bh >> 2, h = bh & 3;
            att::attn_body(Qb + ((size_t)bh * SEQ + qb * 256) * 192, Kb + (size_t)bh * KVL * 192, Vb + (size_t)bh * KVL * 128,
                           MIX + ((size_t)b * SEQ + qb * 256) * 1024 + h * 128, KVL, ldsc);
        }
    }
    if (a.ph_lo == 12) { for (int it = blockIdx.x; it < 2048; it += G) hgrn_passC(a, ldsc, it); }
    if (a.ph_lo == 13) { hgrn_passA_loop(a, ldsc, G); }
#endif
#undef IN
#undef SEAM
}

#ifndef PROBE_REPS
#define PROBE_REPS 1
#endif
#ifndef MK_PER_PHASE
#define MK_PER_PHASE 0
#endif
extern "C" void kernel_launch(void* const* d_in, const int* in_sizes, int n_in, void* d_out, int out_size, void* d_ws, size_t ws_size, hipStream_t stream) {
    static int grid = 0;
    if (grid == 0) {
        if (n_in != 21 || out_size != ML * DM || ws_size < WS_END) { fprintf(stderr, "kernel_launch: unexpected shapes (n_in %d out %d ws %zu)\n", n_in, out_size, ws_size); grid = -1; return; }
        int dev = 0, cus = 0, per_cu = 0;
        hipGetDevice(&dev); hipDeviceGetAttribute(&cus, hipDeviceAttributeMultiprocessorCount, dev);
        if (hipFuncSetAttribute((const void*)fwd_megakernel, hipFuncAttributeMaxDynamicSharedMemorySize, LDS_BYTES) != hipSuccess) { fprintf(stderr, "kernel_launch: hipFuncSetAttribute failed\n"); grid = -1; return; }
        if (hipOccupancyMaxActiveBlocksPerMultiprocessor(&per_cu, (const void*)fwd_megakernel, 512, LDS_BYTES) != hipSuccess || per_cu < 1) { fprintf(stderr, "kernel_launch: occupancy query says %d\n", per_cu); per_cu = 1; }
        (void)hipGetLastError();
        grid = cus * 1;
        fprintf(stderr, "kernel_launch: grid %d (per_cu %d)\n", grid, per_cu);
    }
    if (grid < 0) return;
    (void)hipMemsetAsync((char*)d_ws + WS_BAR, 0, 16384, stream);
    Args a{};
    const float** ap = (const float**)&a;
    for (int i = 0; i < 21; ++i) ap[i] = (const float*)d_in[i];
    a.out = (float*)d_out; a.ws = (unsigned char*)d_ws;
#if MK_PER_PHASE
    for (int ph = 0; ph < 11; ++ph) {
        a.ph_lo = ph; a.ph_hi = ph + 1;
        hipLaunchKernelGGL(fwd_megakernel, dim3(grid), dim3(512), LDS_BYTES, stream, a);
    }
#else
#ifdef PROBE_PHASE
    for (int pr_ = 0; pr_ < PROBE_REPS; ++pr_) { a.ph_lo = PROBE_PHASE; a.ph_hi = PROBE_PHASE + 1; hipLaunchKernelGGL(fwd_megakernel, dim3(grid), dim3(512), LDS_BYTES, stream, a); }
#endif
    a.ph_lo = 0; a.ph_hi = 11;
    void* args[] = {&a};
    hipError_t e = hipLaunchCooperativeKernel((const void*)fwd_megakernel, dim3(grid), dim3(512), args, LDS_BYTES, stream);
    if (e != hipSuccess) fprintf(stderr, "cooperative launch failed: %s (grid %d)\n", hipGetErrorString(e), grid);
#endif
}
```

```cpp
#include <hip/hip_runtime.h>
#include <hip/hip_cooperative_groups.h>
#include <hip/hip_bf16.h>
#include <cstdio>
#include <cstdint>
namespace cg = cooperative_groups;
namespace pg8 {
#define PG8_LAS __attribute__((address_space(3)))
typedef unsigned short bf16_t;
typedef short bf16x8 __attribute__((ext_vector_type(8)));
typedef float f32x4 __attribute__((ext_vector_type(4)));
typedef unsigned u32x4 __attribute__((ext_vector_type(4)));
constexpr int BM = 256, BK = 64, HALF = 128, HTB = HALF * BK * 2  , STAGE_BYTES = 8 * HTB, NXCD = 8, WGM = 8;

__host__ __device__ __forceinline__ int lds_byte(int r, int c) { const int st = (r >> 4) * 2 + (c >> 5), rr = r & 15, cc = c & 31, ob = rr * 64 + cc * 2; return st * 1024 + (ob ^ (((ob >> 9) & 1) << 5)); }
__host__ __device__ __forceinline__ void stage_rc(int b, int& R, int& C) { const int st = b / 1024, sb = b % 1024, swz = sb ^ (((sb >> 9) & 1) << 5); R = (st >> 1) * 16 + swz / 64; C = (st & 1) * 32 + (swz % 64) / 2; }
__host__ __device__ __forceinline__ int perm32(int rho) { const int n = rho >> 4, i = rho & 15; return 8 * (i >> 2) + 4 * n + (i & 3); }

struct Unit { int pm, pn; };
struct Gemm { const bf16_t* A; const bf16_t* Bt; int M, N, K; };

struct StaticOrder {
    int nM, nN, nwg, G, c;
    __host__ __device__ void init(int M, int N, int G_, int c_) { nM = M / BM; nN = N / BM; nwg = nM * nN; G = G_; c = c_; }
    __host__ __device__ bool next(int i, Unit& u) const {
        const long L = (long)i * G + c; if (L >= nwg) return false;
        int wgid = (int)L; { const int q = nwg / NXCD, r = nwg % NXCD, xcd = wgid % NXCD, off = wgid / NXCD; wgid = (xcd < r ? xcd * (q + 1) : r * (q + 1) + (xcd - r) * q) + off; }
        const int nig = WGM * nN, gid = wgid / nig, fm = gid * WGM, gsz = (nM - fm) < WGM ? (nM - fm) : WGM;
        u.pm = fm + ((wgid % nig) % gsz); u.pn = (wgid % nig) / gsz; return true;
    }
    __device__ __forceinline__ void a_ready(const Unit&) const {}
    __device__ __forceinline__ void done(const Unit&) const {}
};

__device__ __forceinline__ unsigned cvt_pk_bf16(float lo, float hi) { unsigned r; asm volatile("v_cvt_pk_bf16_f32 %0, %1, %2" : "=v"(r) : "v"(lo), "v"(hi)); return r; }
typedef float f32x2 __attribute__((ext_vector_type(2)));
template <class Epi, class Sched, bool ALIGN_EPI = false, bool SP2 = false>
__device__ __forceinline__ void gemm_phase(PG8_LAS unsigned char* lds, const Gemm g, const Sched& S, const Epi& E) {
    const int tid = threadIdx.x, wid = __builtin_amdgcn_readfirstlane(tid >> 6), lane = tid & 63, wr = wid >> 2, wc = wid & 3, fr = lane & 15, fq = lane >> 4;
    const int K = g.K, nt = K / BK;
    unsigned voffA[2], voffB[2];
#pragma unroll
    for (int i = 0; i < 2; ++i) { int R, C; stage_rc(tid * 16 + i * 8192, R, C); const int Rb = Epi::PERM ? ((R & ~31) + perm32(R & 31)) : R;
        voffA[i] = (unsigned)(R * K + C) * 2u; voffB[i] = (unsigned)(Rb * K + C) * 2u; }
    const size_t kstep = (size_t)(BK * 2);
    const size_t hstep = (size_t)HALF * K * 2;
    const size_t tstep = 2 * hstep;
    const unsigned ldsw = (unsigned)wid * 1024u;
    const int aoff = lds_byte(wr * 64 + fr, fq * 8), boff = lds_byte(wc * 32 + fr, fq * 8);
#define PG8_SA(b, h) (((b) * 2 + (h)) * HTB)
#define PG8_SB(b, h) ((4 + (b) * 2 + (h)) * HTB)
#define PG8_STAGE(bufoff, gbase, voff) do { _Pragma("unroll") for (int _i = 0; _i < 2; ++_i) \
        __builtin_amdgcn_global_load_lds((const unsigned*)((const char*)(gbase) + (voff)[_i]), (PG8_LAS unsigned*)(lds + (bufoff) + ldsw + _i * 8192), 16, 0, 0); } while (0)
#define PG8_LDA(dst, b, h) do { _Pragma("unroll") for (int m = 0; m < 4; ++m) _Pragma("unroll") for (int k = 0; k < 2; ++k) dst[m][k] = *(const PG8_LAS bf16x8*)(lds + PG8_SA(b, h) + aoff + m * 2048 + k * 1024); } while (0)
#define PG8_LDB(dst, b, h) do { _Pragma("unroll") for (int n = 0; n < 2; ++n) _Pragma("unroll") for (int k = 0; k < 2; ++k) dst[n][k] = *(const PG8_LAS bf16x8*)(lds + PG8_SB(b, h) + boff + n * 2048 + k * 1024); } while (0)
#define PG8_MMA(ai, bj, At, Bt) do { __builtin_amdgcn_s_setprio(1); _Pragma("unroll") for (int m = 0; m < 4; ++m) _Pragma("unroll") for (int n = 0; n < 2; ++n) _Pragma("unroll") for (int k = 0; k < 2; ++k) \
        acc[ai][bj][m][n] = __builtin_amdgcn_mfma_f32_16x16x32_bf16(Bt[n][k], At[m][k], acc[ai][bj][m][n], 0, 0, 0); __builtin_amdgcn_s_setprio(0); } while (0)
#define PG8_WAIT_V(n) asm volatile("s_waitcnt vmcnt(" #n ")" ::: "memory")
#define PG8_WAIT_L(n) asm volatile("s_waitcnt lgkmcnt(" #n ")" ::: "memory")
#define PG8_BAR __builtin_amdgcn_s_barrier()
#define PG8_SCHED __builtin_amdgcn_sched_barrier(0)
    Unit cur, nxt; int ui = 0;
    if (!S.next(0, cur)) return;
    f32x4 acc[2][2][4][2];
#pragma unroll
    for (int a = 0; a < 2; ++a)
#pragma unroll
        for (int b = 0; b < 2; ++b)
#pragma unroll
            for (int m = 0; m < 4; ++m)
#pragma unroll
                for (int n = 0; n < 2; ++n) acc[a][b][m][n] = (f32x4){0.f, 0.f, 0.f, 0.f};
    bf16x8 At[4][2], B0[2][2], B1[2][2];
    const char* cA = (const char*)g.A + (size_t)cur.pm * tstep; const char* cB = (const char*)g.Bt + (size_t)cur.pn * tstep;
    S.a_ready(cur);
    if constexpr (SP2) {
        PG8_STAGE(PG8_SB(0, 0), cB, voffB); PG8_STAGE(PG8_SB(0, 1), cB + hstep, voffB); PG8_STAGE(PG8_SA(0, 0), cA, voffA); PG8_STAGE(PG8_SA(0, 1), cA + hstep, voffA);
        if (wr == 1) PG8_BAR;
        PG8_WAIT_V(2); PG8_BAR;
        PG8_STAGE(PG8_SB(1, 0), cB + kstep, voffB); PG8_STAGE(PG8_SA(1, 0), cA + kstep, voffA); PG8_STAGE(PG8_SB(1, 1), cB + hstep + kstep, voffB);
        PG8_WAIT_V(6); PG8_BAR;
    } else {
        PG8_STAGE(PG8_SB(0, 0), cB, voffB); PG8_STAGE(PG8_SA(0, 0), cA, voffA); PG8_STAGE(PG8_SB(0, 1), cB + hstep, voffB); PG8_STAGE(PG8_SA(0, 1), cA + hstep, voffA);
        if (wr == 1) PG8_BAR;
        PG8_WAIT_V(4); PG8_BAR;
        PG8_STAGE(PG8_SB(1, 0), cB + kstep, voffB); PG8_STAGE(PG8_SA(1, 0), cA + kstep, voffA); PG8_STAGE(PG8_SB(1, 1), cB + hstep + kstep, voffB);
        PG8_WAIT_V(6); PG8_BAR;
    }
    for (;;) {
        const bool has_next = S.next(ui + 1, nxt);
        const char* nA = has_next ? (const char*)g.A + (size_t)nxt.pm * tstep : cA; const char* nB = has_next ? (const char*)g.Bt + (size_t)nxt.pn * tstep : cB;
#pragma unroll 1
        for (int t = 0; t < nt; t += 2) {
            const bool last = (t == nt - 2);
            const char* a1 = cA + (size_t)(t + 1) * kstep;
            const char* a2 = last ? nA : cA + (size_t)(t + 2) * kstep; const char* b2 = last ? nB : cB + (size_t)(t + 2) * kstep;
            const char* a3 = a2 + kstep; const char* b3 = b2 + kstep;
            if (last && has_next) S.a_ready(nxt);
            if constexpr (SP2) {
            PG8_LDB(B0, 0, 0); PG8_LDB(B1, 0, 1); PG8_SCHED; PG8_LDA(At, 0, 0); PG8_STAGE(PG8_SA(1, 1), a1 + hstep, voffA);
            PG8_WAIT_V(8); PG8_WAIT_L(0); PG8_BAR; PG8_MMA(0, 0, At, B0); PG8_MMA(0, 1, At, B1); PG8_BAR; PG8_SCHED;
            PG8_LDA(At, 0, 1); PG8_STAGE(PG8_SB(0, 0), b2, voffB); PG8_STAGE(PG8_SB(0, 1), b2 + hstep, voffB); PG8_STAGE(PG8_SA(0, 0), a2, voffA);
            PG8_WAIT_V(8); PG8_WAIT_L(0); PG8_BAR; PG8_MMA(1, 0, At, B0); PG8_MMA(1, 1, At, B1); PG8_BAR; PG8_SCHED;
            PG8_LDB(B0, 1, 0); PG8_LDB(B1, 1, 1); PG8_SCHED; PG8_LDA(At, 1, 0); PG8_STAGE(PG8_SA(0, 1), a2 + hstep, voffA);
            PG8_WAIT_V(8); PG8_WAIT_L(0); PG8_BAR; PG8_MMA(0, 0, At, B0); PG8_MMA(0, 1, At, B1); PG8_BAR; PG8_SCHED;
            PG8_LDA(At, 1, 1); PG8_STAGE(PG8_SB(1, 0), b3, voffB); PG8_STAGE(PG8_SB(1, 1), b3 + hstep, voffB); PG8_STAGE(PG8_SA(1, 0), a3, voffA);
            PG8_WAIT_V(8); PG8_WAIT_L(0); PG8_BAR; PG8_MMA(1, 0, At, B0); PG8_MMA(1, 1, At, B1); PG8_BAR; PG8_SCHED;
            } else {
            PG8_LDB(B0, 0, 0); PG8_SCHED; PG8_LDA(At, 0, 0); PG8_STAGE(PG8_SA(1, 1), a1 + hstep, voffA);
            PG8_WAIT_L(8); PG8_BAR; PG8_WAIT_L(0); PG8_MMA(0, 0, At, B0); PG8_BAR; PG8_SCHED;
            PG8_LDB(B1, 0, 1); PG8_STAGE(PG8_SB(0, 0), b2, voffB);
            PG8_BAR; PG8_WAIT_L(0); PG8_MMA(0, 1, At, B1); PG8_BAR;
            PG8_LDA(At, 0, 1); PG8_STAGE(PG8_SA(0, 0), a2, voffA);
            PG8_BAR; PG8_WAIT_L(0); PG8_MMA(1, 0, At, B0); PG8_BAR; PG8_SCHED;
            PG8_STAGE(PG8_SB(0, 1), b2 + hstep, voffB);
            PG8_WAIT_V(6); PG8_BAR; PG8_MMA(1, 1, At, B1); PG8_BAR;
            PG8_LDB(B0, 1, 0); PG8_SCHED; PG8_LDA(At, 1, 0); PG8_STAGE(PG8_SA(0, 1), a2 + hstep, voffA);
            PG8_WAIT_L(8); PG8_BAR; PG8_WAIT_L(0); PG8_MMA(0, 0, At, B0); PG8_BAR; PG8_SCHED;
            PG8_LDB(B1, 1, 1); PG8_STAGE(PG8_SB(1, 0), b3, voffB);
            PG8_BAR; PG8_WAIT_L(0); PG8_MMA(0, 1, At, B1); PG8_BAR;
            PG8_LDA(At, 1, 1); PG8_STAGE(PG8_SA(1, 0), a3, voffA);
            PG8_BAR; PG8_WAIT_L(0); PG8_MMA(1, 0, At, B0); PG8_BAR; PG8_SCHED;
            PG8_STAGE(PG8_SB(1, 1), b3 + hstep, voffB);
            PG8_WAIT_V(6); PG8_BAR; PG8_MMA(1, 1, At, B1); PG8_BAR;
            }
        }
        if constexpr (ALIGN_EPI) { if (wr == 0) PG8_BAR; }
        if constexpr (!Epi::AFTER_DRAIN) { E(acc, cur, wr, wc, fr, fq); S.done(cur); }
        if (!has_next) break;
#pragma unroll
        for (int a = 0; a < 2; ++a)
#pragma unroll
            for (int b = 0; b < 2; ++b)
#pragma unroll
                for (int m = 0; m < 4; ++m)
#pragma unroll
                    for (int n = 0; n < 2; ++n) acc[a][b][m][n] = (f32x4){0.f, 0.f, 0.f, 0.f};
        cur = nxt; cA = nA; cB = nB; ++ui;
        if constexpr (ALIGN_EPI) { if (wr == 1) PG8_BAR; }
    }
    PG8_WAIT_V(0);
    if constexpr (!ALIGN_EPI) { if (wr == 0) PG8_BAR; }
    PG8_BAR;
    if constexpr (Epi::AFTER_DRAIN) { E.fused(acc, cur, wr, wc, fr, fq, lds, wid, lane); S.done(cur); }
#undef PG8_SA
#undef PG8_SB
#undef PG8_STAGE
#undef PG8_LDA
#undef PG8_LDB
#undef PG8_MMA
#undef PG8_WAIT_V
#undef PG8_WAIT_L
#undef PG8_BAR
#undef PG8_SCHED
}
}

#define LAS __attribute__((address_space(3)))
typedef unsigned short bf16_t;
typedef short bf16x8 __attribute__((ext_vector_type(8)));
typedef short s16x4 __attribute__((ext_vector_type(4)));
typedef float f32x4 __attribute__((ext_vector_type(4)));
typedef float f32x16 __attribute__((ext_vector_type(16)));
typedef unsigned u32x4 __attribute__((ext_vector_type(4)));
typedef unsigned u32x2 __attribute__((ext_vector_type(2)));

constexpr int NB = 8, SEQ = 4096, DM = 1024, CTXL = 256;
constexpr int ML = NB * SEQ, MC = NB * CTXL, MT = ML + MC;
constexpr int NIN = 3136, NINP = 3328, DFF = 2816, KVL = CTXL + SEQ;
constexpr int NCH = 68;
constexpr float EPS = 1e-6f;
constexpr size_t MiB = 1u << 20;
constexpr size_t WS_MOD = 0, WS_LBF = 256 * 1024, WS_LBB = 258 * 1024, WS_RCOS = 260 * 1024, WS_RSIN = 264 * 1024, WS_ROWSS = 512 * 1024;
constexpr size_t WS_WIN = 1 * MiB, WS_WUQ = 8 * MiB, WS_WUKV = 8 * MiB + 512 * 1024, WS_WOUT = 9 * MiB, WS_WGU = 11 * MiB, WS_WDN = 22 * MiB, WS_DG = 28 * MiB;
constexpr size_t WS_A = 32 * MiB;
constexpr size_t WS_CQ = 169 * MiB, WS_CKV = 186 * MiB, WS_HQ = 203 * MiB, WS_HI = 237 * MiB, WS_HG = 271 * MiB, WS_GF = 305 * MiB, WS_GB = 339 * MiB;
constexpr size_t WS_V = 373 * MiB, WS_MIX = 407 * MiB, WS_ACT = 169 * MiB, WS_RSSP = 471 * MiB, WS_BAR = 480 * MiB, WS_END = 481 * MiB;
constexpr int LDS_BYTES = 147456;

__device__ __forceinline__ unsigned f2bf(float f) { unsigned u = __builtin_bit_cast(unsigned, f); return (u + 0x7fffu + ((u >> 16) & 1u)) >> 16; }
__device__ __forceinline__ float bf2f(unsigned h) { return __builtin_bit_cast(float, h << 16); }
typedef __bf16 bf16v2_t __attribute__((ext_vector_type(2)));
__device__ __forceinline__ unsigned pk2(float lo, float hi) { bf16v2_t v; v.x = (__bf16)lo; v.y = (__bf16)hi; return __builtin_bit_cast(unsigned, v); }
__device__ __forceinline__ float wave_sum(float v) {
#pragma unroll
    for (int o = 1; o < 64; o <<= 1) v += __shfl_xor(v, o);
    return v;
}
__device__ __forceinline__ float sigmoidf_(float x) { return 1.f / (1.f + __expf(-x)); }
#define LDS_WAIT() asm volatile("s_waitcnt lgkmcnt(0)" ::: "memory")

struct Args {
    const float *x, *c, *ctx, *c_ctx, *w_mod, *b_mod, *g_mix, *g_ffn, *w_in, *g_qn, *w_uq, *g_kvn, *w_ukv, *lb_fwd, *lb_bwd, *g_on, *w_out, *w_gate, *w_up, *w_down, *g_final;
    float* out; unsigned char* ws; int ph_lo, ph_hi;
};

__device__ __forceinline__ void p0_mod_item(const Args& a, char* ldsc, int item) {
    float* sl = (float*)ldsc;
    float* red = sl + 9216;
    const int tid = threadIdx.x, wave = tid >> 6, lane = tid & 63;
    for (int i = tid; i < 9216; i += 512) { const float v = (i < 8192) ? a.c[i] : a.c_ctx[i - 8192]; sl[i] = v * sigmoidf_(v); }
    __syncthreads();
    float acc[9];
#pragma unroll
    for (int r = 0; r < 9; ++r) acc[r] = 0.f;
    const float* wp = a.w_mod + (size_t)(wave * 128) * 6144 + item * 64 + lane;
#pragma unroll 4
    for (int k = 0; k < 128; ++k) {
        const float w = wp[(size_t)k * 6144];
#pragma unroll
        for (int r = 0; r < 9; ++r) acc[r] += sl[r * 1024 + wave * 128 + k] * w;
    }
#pragma unroll
    for (int r = 0; r < 9; ++r) red[(wave * 9 + r) * 64 + lane] = acc[r];
    __syncthreads();
    float* MOD = (float*)(a.ws + WS_MOD);
    for (int i = tid; i < 576; i += 512) {
        const int r = i >> 6, l = i & 63; float s = 0.f;
#pragma unroll
        for (int w = 0; w < 8; ++w) s += red[(w * 9 + r) * 64 + l];
        MOD[r * 6144 + item * 64 + l] = s + a.b_mod[item * 64 + l];
    }
    __syncthreads();
}
__device__ __forceinline__ void p0_transpose_item(const float* W, int N, bf16_t* WT, int Kd, int drow0, const float* kscale, float* scr, int k0, int n0, int lane) {
#pragma unroll 8
    for (int i = 0; i < 32; ++i) { const int kk = 2 * i + (lane >> 5); float v = W[(size_t)(k0 + kk) * N + n0 + (lane & 31)]; if (kscale) v *= kscale[k0 + kk]; scr[kk * 33 + (lane & 31)] = v; }
    LDS_WAIT(); asm volatile("" ::: "memory");
    const int c = lane & 7;
#pragma unroll
    for (int j = 0; j < 4; ++j) { const int n = (lane >> 3) + 8 * j; const float* s = scr + (8 * c) * 33 + n;
        u32x4 o; o.x = pk2(s[0 * 33], s[1 * 33]); o.y = pk2(s[2 * 33], s[3 * 33]); o.z = pk2(s[4 * 33], s[5 * 33]); o.w = pk2(s[6 * 33], s[7 * 33]);
        *(u32x4*)(WT + (size_t)(drow0 + n) * Kd + k0 + 8 * c) = o; }
    LDS_WAIT(); asm volatile("" ::: "memory");
}
__device__ __forceinline__ void p0_prologue(const Args& a, char* ldsc, int G) {
    const int tid = threadIdx.x, wave = tid >> 6, lane = tid & 63;
    unsigned char* ws = a.ws;
    if (blockIdx.x < 96) p0_mod_item(a, ldsc, blockIdx.x);
    if ((int)blockIdx.x == G - 1) {
        float* LBF = (float*)(ws + WS_LBF); float* LBB = (float*)(ws + WS_LBB);
        LBF[tid] = 1.f / (1.f + __expf(a.lb_fwd[512 + tid] - a.lb_fwd[tid]));
        LBB[tid] = 1.f / (1.f + __expf(a.lb_bwd[512 + tid] - a.lb_bwd[tid]));
        float* RC = (float*)(ws + WS_RCOS); float* RS = (float*)(ws + WS_RSIN);
        for (int i = tid; i < 1024; i += 512) {
            const int pos = i >> 4, fi = i & 15;
            const float inv = exp2f(-(float)fi * (13.287712379549449f / 16.f));
            const float ang = (float)pos * inv;
            const float kq = rintf(ang * 0.15915494309189535f);
            float r = fmaf(-kq, 6.28125f, ang); r = fmaf(-kq, 0.0019353071795864769f, r);
            RC[i] = __cosf(r); RS[i] = __sinf(r);
        }
    }
    { u32x4* pz = (u32x4*)(ws + WS_WIN + (size_t)NIN * 1024 * 2); const u32x4 z = {0u, 0u, 0u, 0u};
      for (int i = blockIdx.x * 512 + tid; i < (NINP - NIN) * 1024 * 2 / 16; i += G * 512) pz[i] = z; }
    float* scr = (float*)(ldsc + wave * 16384);
    const int gw = blockIdx.x * 8 + wave, NGW = G * 8;
    constexpr int I_IN = 16 * 98, I_UQ = 4 * 24, I_UKV = 4 * 32, I_OUT = 16 * 32, I_G = 16 * 88, I_DN = 44 * 32;
    constexpr int NITEMS = I_IN + I_UQ + I_UKV + I_OUT + 2 * I_G + I_DN;
    for (int it = gw; it < NITEMS; it += NGW) {
        int r = it;
        if (r < I_IN) { const int kb = r / 98, nb = r % 98; p0_transpose_item(a.w_in, NIN, (bf16_t*)(ws + WS_WIN), 1024, 32 * nb, nullptr, scr, 64 * kb, 32 * nb, lane); continue; } r -= I_IN;
        if (r < I_UQ) { const int kb = r / 24, nb = r % 24; p0_transpose_item(a.w_uq, 768, (bf16_t*)(ws + WS_WUQ), 256, 32 * nb, a.g_qn, scr, 64 * kb, 32 * nb, lane); continue; } r -= I_UQ;
        if (r < I_UKV) { const int kb = r / 32, nb = r % 32; p0_transpose_item(a.w_ukv, 1024, (bf16_t*)(ws + WS_WUKV), 256, 32 * nb, a.g_kvn, scr, 64 * kb, 32 * nb, lane); continue; } r -= I_UKV;
        if (r < I_OUT) { const int kb = r / 32, nb = r % 32; p0_transpose_item(a.w_out, 1024, (bf16_t*)(ws + WS_WOUT), 1024, 32 * nb, nullptr, scr, 64 * kb, 32 * nb, lane); continue; } r -= I_OUT;
        if (r < 2 * I_G) { const int up = r >= I_G; if (up) r -= I_G; const int kb = r / 88, nb = r % 88, n0 = 32 * nb;
            const int drow = (n0 >> 7) * 256 + (n0 & 127) + (up ? 128 : 0);
            p0_transpose_item(up ? a.w_up : a.w_gate, DFF, (bf16_t*)(ws + WS_WGU), 1024, drow, nullptr, scr, 64 * kb, n0, lane); continue; } r -= 2 * I_G;
        { const int kb = r / 32, nb = r % 32; p0_transpose_item(a.w_down, 1024, (bf16_t*)(ws + WS_WDN), DFF, 32 * nb, nullptr, scr, 64 * kb, 32 * nb, lane); }
    }
}

template <int NR>
__device__ __forceinline__ void rows_norm_mod_bf16(const float* const (&src)[NR], const float* g, const float* const (&md)[NR], int shoff, bf16_t* const (&dst)[NR], const bool (&ok)[NR], int lane) {
    f32x4 v[NR][4]; float s[NR];
#pragma unroll
    for (int i = 0; i < NR; ++i) { s[i] = 0.f; if (ok[i]) {
#pragma unroll
        for (int j = 0; j < 4; ++j) v[i][j] = ((const f32x4*)src[i])[lane + 64 * j]; } }
#pragma unroll
    for (int i = 0; i < NR; ++i) if (ok[i]) {
#pragma unroll
        for (int j = 0; j < 4; ++j) s[i] += (v[i][j].x * v[i][j].x + v[i][j].y * v[i][j].y) + (v[i][j].z * v[i][j].z + v[i][j].w * v[i][j].w); }
#pragma unroll
    for (int o = 1; o < 64; o <<= 1) {
#pragma unroll
        for (int i = 0; i < NR; ++i) s[i] += __shfl_xor(s[i], o); }
#pragma unroll
    for (int i = 0; i < NR; ++i) if (ok[i]) {
        const float rstd = rsqrtf(s[i] * (1.f / 1024.f) + EPS);
        u32x2* o8 = (u32x2*)dst[i] + lane;
#pragma unroll
        for (int j = 0; j < 4; ++j) {
            const f32x4 gg = ((const f32x4*)g)[lane + 64 * j], s1 = ((const f32x4*)(md[i] + shoff + 1024))[lane + 64 * j], s0 = ((const f32x4*)(md[i] + shoff))[lane + 64 * j];
            const f32x4 y = v[i][j] * rstd * gg * (s1 + 1.f) + s0;
            u32x2 w; w.x = pk2(y.x, y.y); w.y = pk2(y.z, y.w); o8[64 * j] = w;
        }
    }
}
template <int NR>
__device__ __forceinline__ void rows_norm_mod_pre(const float* const (&src)[NR], const f32x4 (&A)[4], const f32x4 (&B)[4], bf16_t* const (&dst)[NR], int lane) {
    f32x4 v[NR][4]; float s[NR];
#pragma unroll
    for (int i = 0; i < NR; ++i) { s[i] = 0.f;
#pragma unroll
        for (int j = 0; j < 4; ++j) v[i][j] = ((const f32x4*)src[i])[lane + 64 * j]; }
#pragma unroll
    for (int i = 0; i < NR; ++i) {
#pragma unroll
        for (int j = 0; j < 4; ++j) s[i] += (v[i][j].x * v[i][j].x + v[i][j].y * v[i][j].y) + (v[i][j].z * v[i][j].z + v[i][j].w * v[i][j].w); }
#pragma unroll
    for (int o = 1; o < 64; o <<= 1) {
#pragma unroll
        for (int i = 0; i < NR; ++i) s[i] += __shfl_xor(s[i], o); }
#pragma unroll
    for (int i = 0; i < NR; ++i) {
        const float rstd = rsqrtf(s[i] * (1.f / 1024.f) + EPS);
        u32x2* o8 = (u32x2*)dst[i] + lane;
#pragma unroll
        for (int j = 0; j < 4; ++j) { const f32x4 y = v[i][j] * rstd * A[j] + B[j]; u32x2 w; w.x = pk2(y.x, y.y); w.y = pk2(y.z, y.w); o8[64 * j] = w; }
    }
}
__device__ __forceinline__ void load_mod_params(const float* g, const float* md, int shoff, f32x4 (&A)[4], f32x4 (&B)[4], int lane) {
#pragma unroll
    for (int j = 0; j < 4; ++j) { const f32x4 gg = ((const f32x4*)g)[lane + 64 * j], s1 = ((const f32x4*)(md + shoff + 1024))[lane + 64 * j]; A[j] = gg * (s1 + 1.f); B[j] = ((const f32x4*)(md + shoff))[lane + 64 * j]; }
}
template <int NR>
__device__ __forceinline__ void rows_norm_f32(float* const (&row)[NR], const float* g, int lane) {
    f32x4 v[NR][4]; float s[NR];
#pragma unroll
    for (int i = 0; i < NR; ++i) { s[i] = 0.f;
#pragma unroll
        for (int j = 0; j < 4; ++j) v[i][j] = ((const f32x4*)row[i])[lane + 64 * j]; }
#pragma unroll
    for (int i = 0; i < NR; ++i) {
#pragma unroll
        for (int j = 0; j < 4; ++j) s[i] += (v[i][j].x * v[i][j].x + v[i][j].y * v[i][j].y) + (v[i][j].z * v[i][j].z + v[i][j].w * v[i][j].w); }
#pragma unroll
    for (int o = 1; o < 64; o <<= 1) {
#pragma unroll
        for (int i = 0; i < NR; ++i) s[i] += __shfl_xor(s[i], o); }
#pragma unroll
    for (int i = 0; i < NR; ++i) {
        const float rstd = rsqrtf(s[i] * (1.f / 1024.f) + EPS);
#pragma unroll
        for (int j = 0; j < 4; ++j) { f32x4 o = v[i][j] * rstd * ((const f32x4*)g)[lane + 64 * j];
#ifdef SANITIZE
            o.x = __builtin_isfinite(o.x) ? o.x : 1000.f; o.y = __builtin_isfinite(o.y) ? o.y : 1000.f; o.z = __builtin_isfinite(o.z) ? o.z : 1000.f; o.w = __builtin_isfinite(o.w) ? o.w : 1000.f;
#endif
            ((f32x4*)row[i])[lane + 64 * j] = o; }
    }
}

__device__ __forceinline__ void rope8(float (&v)[8], int fq, const float* rc, const float* rs, int pos, bool apply) {
    const int ib = pos * 16 + 8 * (fq & 1);
#pragma unroll
    for (int e = 0; e < 8; ++e) {
        const float partner = __shfl_xor(v[e], 32);
        const float cs = rc[ib + e], sn = rs[ib + e];
        const float r = (fq < 2) ? (v[e] * cs - partner * sn) : (v[e] * cs + partner * sn);
        v[e] = apply ? r : v[e];
    }
}
__device__ __forceinline__ u32x4 pack8(const float (&v)[8]) { u32x4 w; w.x = pk2(v[0], v[1]); w.y = pk2(v[2], v[3]); w.z = pk2(v[4], v[5]); w.w = pk2(v[6], v[7]); return w; }

struct EpiInProj {
    static constexpr bool PERM = true, AFTER_DRAIN = false;
    unsigned char* ws; bf16_t* Kb;
    __device__ __forceinline__ void operator()(const pg8::f32x4 (&acc)[2][2][4][2], const pg8::Unit& u, int wr, int wc, int fr, int fq) const {
        float* RSS = (float*)(ws + WS_RSSP); const float* RC = (const float*)(ws + WS_RCOS); const float* RS = (const float*)(ws + WS_RSIN);
#pragma unroll
        for (int bj = 0; bj < 2; ++bj) {
            const int cbase = u.pn * 256 + bj * 128 + wc * 32;
            if (cbase >= NIN) continue;
            const int c0 = cbase + 8 * fq;
#pragma unroll
            for (int ai = 0; ai < 2; ++ai)
#pragma unroll
                for (int m = 0; m < 4; ++m) {
                    const int row = u.pm * 256 + ai * 128 + wr * 64 + m * 16 + fr;
                    float v[8];
#pragma unroll
                    for (int e = 0; e < 4; ++e) { v[e] = acc[ai][bj][m][0][e]; v[4 + e] = acc[ai][bj][m][1][e]; }
                    if (cbase < 512) {
                        bf16_t* dst = (bf16_t*)(ws + WS_CQ + (cbase < 256 ? (size_t)0 : (WS_CKV - WS_CQ))) + (size_t)row * 256 + (c0 & 255);
                        *(u32x4*)dst = pack8(v);
                        float ss = 0.f;
#pragma unroll
                        for (int e = 0; e < 8; ++e) ss += v[e] * v[e];
                        ss += __shfl_xor(ss, 16); ss += __shfl_xor(ss, 32);
                        if (fq == 0) RSS[((size_t)row * 2 + (cbase < 256 ? 0 : 1)) * 8 + bj * 4 + wc] = ss;
                    } else if (cbase < 576) {
                        const int axis = (cbase - 512) >> 5;
                        const bool lat = row < ML;
                        const int n = row & 4095;
                        const int pos = axis ? (n & 63) : (n >> 6);
                        rope8(v, fq, RC, RS, lat ? pos : 0, lat);
                        const int b = lat ? (row >> 12) : ((row - ML) >> 8);
                        const int kvpos = lat ? (CTXL + n) : ((row - ML) & 255);
                        const u32x4 w = pack8(v);
#pragma unroll
                        for (int h = 0; h < 4; ++h) *(u32x4*)(Kb + ((size_t)(b * 4 + h) * KVL + kvpos) * 192 + 128 + axis * 32 + 8 * fq) = w;
                    } else if (cbase < 2112) {
                        const int seg = (cbase - 576) >> 9;
                        bf16_t* base = (bf16_t*)(ws + WS_HQ + (size_t)seg * (WS_HI - WS_HQ));
                        *(u32x4*)(base + (size_t)row * 512 + (c0 - 576 - seg * 512)) = pack8(v);
                    } else {
                        const int dirn = (cbase - 2112) >> 9, j = c0 - 2112 - dirn * 512;
                        const float* lbp = (const float*)(ws + WS_LBF + (size_t)dirn * (WS_LBB - WS_LBF)) + j;
                        typedef _Float16 h8 __attribute__((ext_vector_type(8)));
                        h8 o;
#pragma unroll
                        for (int e = 0; e < 8; ++e) { const float lb = lbp[e]; const float f = lb + (1.f - lb) * sigmoidf_(v[e]); o[e] = (_Float16)__logf(f); }
                        *(h8*)((_Float16*)(ws + WS_GF + (size_t)dirn * (WS_GB - WS_GF)) + (size_t)row * 512 + j) = o;
                    }
                }
        }
    }
};
struct EpiQ {
    static constexpr bool PERM = true, AFTER_DRAIN = false;
    bf16_t* Q; const float* RSS; const float *RC, *RS;
    __device__ __forceinline__ void operator()(const pg8::f32x4 (&acc)[2][2][4][2], const pg8::Unit& u, int wr, int wc, int fr, int fq) const {
#pragma unroll
        for (int bj = 0; bj < 2; ++bj) {
            const int cbase = u.pn * 256 + bj * 128 + wc * 32;
            const int h = cbase / 192, d0 = cbase - h * 192;
            const bool rope = d0 >= 128; const int axis = (d0 - 128) >> 5;
#pragma unroll
            for (int ai = 0; ai < 2; ++ai)
#pragma unroll
                for (int m = 0; m < 4; ++m) {
                    const int row = u.pm * 256 + ai * 128 + wr * 64 + m * 16 + fr;
                    const f32x4 s0 = *(const f32x4*)(RSS + (size_t)row * 16), s1 = *(const f32x4*)(RSS + (size_t)row * 16 + 4);
                    const float rstd = rsqrtf((((s0.x + s0.y) + (s0.z + s0.w)) + ((s1.x + s1.y) + (s1.z + s1.w))) * (1.f / 256.f) + EPS);
                    float v[8];
#pragma unroll
                    for (int e = 0; e < 4; ++e) { v[e] = acc[ai][bj][m][0][e] * rstd; v[4 + e] = acc[ai][bj][m][1][e] * rstd; }
                    const int b = row >> 12, n = row & 4095;
                    if (rope) { const int pos = axis ? (n & 63) : (n >> 6); rope8(v, fq, RC, RS, pos, true); }
                    *(u32x4*)(Q + ((size_t)(b * 4 + h) * SEQ + n) * 192 + d0 + 8 * fq) = pack8(v);
                    asm volatile("" ::: "memory");
                }
        }
    }
};
struct EpiKV {
    static constexpr bool PERM = true, AFTER_DRAIN = false;
    bf16_t *Kb, *Vb; const float* RSS;
    __device__ __forceinline__ void operator()(const pg8::f32x4 (&acc)[2][2][4][2], const pg8::Unit& u, int wr, int wc, int fr, int fq) const {
#pragma unroll
        for (int bj = 0; bj < 2; ++bj) {
            const int cbase = u.pn * 256 + bj * 128 + wc * 32;
            const int h = cbase >> 8, j0 = cbase & 255;
#pragma unroll
            for (int ai = 0; ai < 2; ++ai)
#pragma unroll
                for (int m = 0; m < 4; ++m) {
                    const int row = u.pm * 256 + ai * 128 + wr * 64 + m * 16 + fr;
                    const f32x4 s0 = *(const f32x4*)(RSS + (size_t)row * 16 + 8), s1 = *(const f32x4*)(RSS + (size_t)row * 16 + 12);
                    const float rstd = rsqrtf((((s0.x + s0.y) + (s0.z + s0.w)) + ((s1.x + s1.y) + (s1.z + s1.w))) * (1.f / 256.f) + EPS);
                    float v[8];
#pragma unroll
                    for (int e = 0; e < 4; ++e) { v[e] = acc[ai][bj][m][0][e] * rstd; v[4 + e] = acc[ai][bj][m][1][e] * rstd; }
                    const bool lat = row < ML;
                    const int b = lat ? (row >> 12) : ((row - ML) >> 8);
                    const int kvpos = lat ? (CTXL + (row & 4095)) : ((row - ML) & 255);
                    const size_t r = (size_t)(b * 4 + h) * KVL + kvpos;
                    if (j0 < 128) *(u32x4*)(Kb + r * 192 + j0 + 8 * fq) = pack8(v);
                    else          *(u32x4*)(Vb + r * 128 + (j0 - 128) + 8 * fq) = pack8(v);
                    asm volatile("" ::: "memory");
                }
        }
    }
};
struct EpiRes {
    static constexpr bool PERM = false, AFTER_DRAIN = false;
    const float* base; float* out; const float* gate;
    __device__ __forceinline__ void operator()(const pg8::f32x4 (&acc)[2][2][4][2], const pg8::Unit& u, int wr, int wc, int fr, int fq) const {
#pragma unroll
        for (int ai = 0; ai < 2; ++ai)
#pragma unroll
            for (int m = 0; m < 4; ++m) {
                const int row = u.pm * 256 + ai * 128 + wr * 64 + m * 16 + fr;
                const float* gp = gate + (size_t)(row >> 12) * 6144;
#pragma unroll
                for (int bj = 0; bj < 2; ++bj)
#pragma unroll
                    for (int n = 0; n < 2; ++n) {
                        const int c = u.pn * 256 + bj * 128 + wc * 32 + 16 * n + 4 * fq;
                        const f32x4 g = *(const f32x4*)(gp + c), bs = *(const f32x4*)(base + (size_t)row * 1024 + c);
                        const pg8::f32x4 a4 = acc[ai][bj][m][n];
                        f32x4 o; o.x = bs.x + g.x * a4[0]; o.y = bs.y + g.y * a4[1]; o.z = bs.z + g.z * a4[2]; o.w = bs.w + g.w * a4[3];
                        *(f32x4*)(out + (size_t)row * 1024 + c) = o;
                    }
            }
    }
};
struct EpiSwiglu {
    static constexpr bool PERM = true, AFTER_DRAIN = false;
    bf16_t* ACT;
    __device__ __forceinline__ void operator()(const pg8::f32x4 (&acc)[2][2][4][2], const pg8::Unit& u, int wr, int wc, int fr, int fq) const {
#pragma unroll
        for (int ai = 0; ai < 2; ++ai)
#pragma unroll
            for (int m = 0; m < 4; ++m) {
                const int row = u.pm * 256 + ai * 128 + wr * 64 + m * 16 + fr;
                float v[8];
#pragma unroll
                for (int n = 0; n < 2; ++n)
#pragma unroll
                    for (int e = 0; e < 4; ++e) { const float g = acc[ai][0][m][n][e], uu = acc[ai][1][m][n][e]; v[4 * n + e] = g * sigmoidf_(g) * uu; }
                *(u32x4*)(ACT + (size_t)row * DFF + u.pn * 128 + wc * 32 + 8 * fq) = pack8(v);
            }
    }
};

#ifndef ATT_QREG
#define ATT_QREG 2
#endif
namespace att {
constexpr int NW = 8, QBLK = 32, KVBLK = 64;
constexpr float SCALE = 0.07216878364870322f;
constexpr float THR = 8.f;
constexpr int LDQ = 192, LDK = 192, LDV = 128, LDO = 1024;
constexpr int SHM_V = KVBLK * 128 * 2, SHM_K = KVBLK * 192 * 2, SHM_ATTN = 2 * SHM_V + 2 * SHM_K;
static_assert(SHM_ATTN <= 163840, "attention LDS");
#define KSWZ(row, colB) ((row) * 384 + ((colB) ^ (((row) & 7) << 4)))
#define SBAR() __builtin_amdgcn_sched_barrier(0)
__device__ __forceinline__ int crow(int r, int hi) { return (r & 3) + 8 * (r >> 2) + 4 * hi; }
__device__ __forceinline__ unsigned cvtpk(float lo, float hi) { return pk2(lo, hi); }
__device__ __forceinline__ void partialSM(f32x16& p0, f32x16& p1, float& m_reg, float& mn, float& alpha) {
  constexpr float C = SCALE * 1.4426950408889634f;
  float pmax = p0[0];
#pragma unroll
  for (int r = 1; r < 16; ++r) pmax = fmaxf(pmax, p0[r]);
#pragma unroll
  for (int r = 0; r < 16; ++r) pmax = fmaxf(pmax, p1[r]);
  { auto rr = __builtin_amdgcn_permlane32_swap(__float_as_uint(pmax), __float_as_uint(pmax), false, false);
    pmax = fmaxf(__uint_as_float(rr[0]), __uint_as_float(rr[1])); }
  if (__builtin_expect(__all(pmax - m_reg <= THR / SCALE), 1)) { mn = m_reg; alpha = 1.f; }
  else { mn = fmaxf(m_reg, pmax); alpha = __builtin_amdgcn_exp2f((m_reg - mn) * C); m_reg = mn; }
  float mnC = -mn * C;
#pragma unroll
  for (int r = 0; r < 16; ++r) p0[r] = fmaf(p0[r], C, mnC);
#pragma unroll
  for (int r = 0; r < 16; ++r) p1[r] = fmaf(p1[r], C, mnC);
#pragma unroll
  for (int r = 0; r < 16; ++r) p0[r] = __builtin_amdgcn_exp2f(p0[r]);
}
__device__ __forceinline__ void finishSM(f32x16& p0, f32x16& p1, float alpha, float& l_reg, bf16x8& pa0, bf16x8& pa1, bf16x8& pa2, bf16x8& pa3) {
#pragma unroll
  for (int r = 0; r < 16; ++r) p1[r] = __builtin_amdgcn_exp2f(p1[r]);
  float ps = 0;
#pragma unroll
  for (int r = 0; r < 16; ++r) ps += p0[r];
#pragma unroll
  for (int r = 0; r < 16; ++r) ps += p1[r];
  { auto rr = __builtin_amdgcn_permlane32_swap(__float_as_uint(ps), __float_as_uint(ps), false, false);
    ps = __uint_as_float(rr[0]) + __uint_as_float(rr[1]); }
  l_reg = l_reg * alpha + ps;
#define PK4(P, BASE, OUT) do { unsigned a0 = cvtpk(P[BASE + 0], P[BASE + 1]), a1 = cvtpk(P[BASE + 2], P[BASE + 3]);   \
    unsigned b0 = cvtpk(P[BASE + 4], P[BASE + 5]), b1 = cvtpk(P[BASE + 6], P[BASE + 7]);                              \
    auto r0 = __builtin_amdgcn_permlane32_swap(a0, b0, false, false); auto r1 = __builtin_amdgcn_permlane32_swap(a1, b1, false, false); \
    u32x4 w = {r0[0], r1[0], r0[1], r1[1]}; OUT = *reinterpret_cast<bf16x8*>(&w); } while (0)
  PK4(p0, 0, pa0); PK4(p0, 8, pa1); PK4(p1, 0, pa2); PK4(p1, 8, pa3);
#undef PK4
}
__device__ __forceinline__ void qkt(f32x16& p0, f32x16& p1, const char* Ks, const bf16x8* qr, int r32, int hi) {
  p0 = f32x16{}; p1 = f32x16{};
#pragma unroll
  for (int d0 = 0; d0 < 12; ++d0) { int cb = (d0 * 16 + hi * 8) * 2;
    bf16x8 b0 = *reinterpret_cast<const bf16x8*>(Ks + KSWZ(r32, cb));
    bf16x8 b1 = *reinterpret_cast<const bf16x8*>(Ks + KSWZ(32 + r32, cb));
    p0 = __builtin_amdgcn_mfma_f32_32x32x16_bf16(b0, qr[d0], p0, 0, 0, 0);
    p1 = __builtin_amdgcn_mfma_f32_32x32x16_bf16(b1, qr[d0], p1, 0, 0, 0); }
}
__device__ __forceinline__ int v_st(int k, int c) { const int kk = (k & ~0xC) | ((k & 4) << 1) | ((k & 8) >> 1); return ((kk >> 3) * 4 + (c >> 5)) * 512 + ((kk & 7) * 32 + (c & 31)) * 2; }
__device__ __forceinline__ int v_rd_base(int lane) { return ((lane & 3) << 3) | (((lane >> 2) & 3) << 6) | (((lane >> 4) & 1) << 5) | (((lane >> 5) & 1) << 8); }
constexpr int v_rd_off(int d0, int ks, int half) { return d0 * 512 + ks * 4096 + half * 2048; }
template <int OFF> __device__ __forceinline__ s16x4 tr_read(int vb) {
  s16x4 r; asm volatile("ds_read_b64_tr_b16 %0, %1 offset:%2" : "=&v"(r) : "v"(vb), "i"(OFF) : "memory"); return r;
}
template <int D0> __device__ __forceinline__ void pv_one(f32x16& od, int vb, bf16x8 pa0, bf16x8 pa1, bf16x8 pa2, bf16x8 pa3) {
  const s16x4 l0 = tr_read<v_rd_off(D0, 0, 0)>(vb), h0 = tr_read<v_rd_off(D0, 0, 1)>(vb), l1 = tr_read<v_rd_off(D0, 1, 0)>(vb), h1 = tr_read<v_rd_off(D0, 1, 1)>(vb);
  const s16x4 l2 = tr_read<v_rd_off(D0, 2, 0)>(vb), h2 = tr_read<v_rd_off(D0, 2, 1)>(vb), l3 = tr_read<v_rd_off(D0, 3, 0)>(vb), h3 = tr_read<v_rd_off(D0, 3, 1)>(vb);
  asm volatile("s_waitcnt lgkmcnt(0)" ::: "memory"); SBAR();
#define PK(L, H) (bf16x8){L[0], L[1], L[2], L[3], H[0], H[1], H[2], H[3]}
  od = __builtin_amdgcn_mfma_f32_32x32x16_bf16(pa0, PK(l0, h0), od, 0, 0, 0);
  od = __builtin_amdgcn_mfma_f32_32x32x16_bf16(pa1, PK(l1, h1), od, 0, 0, 0);
  od = __builtin_amdgcn_mfma_f32_32x32x16_bf16(pa2, PK(l2, h2), od, 0, 0, 0);
  od = __builtin_amdgcn_mfma_f32_32x32x16_bf16(pa3, PK(l3, h3), od, 0, 0, 0);
#undef PK
}
__device__ __forceinline__ void pv_d0(f32x16* o, int vb, bf16x8 pa0, bf16x8 pa1, bf16x8 pa2, bf16x8 pa3) {
  pv_one<0>(o[0], vb, pa0, pa1, pa2, pa3); pv_one<1>(o[1], vb, pa0, pa1, pa2, pa3); pv_one<2>(o[2], vb, pa0, pa1, pa2, pa3); pv_one<3>(o[3], vb, pa0, pa1, pa2, pa3);
}
__device__ __forceinline__ void attn_body(const bf16_t* __restrict__ Qb, const bf16_t* __restrict__ Kh, const bf16_t* __restrict__ Vh, bf16_t* __restrict__ Ob, int seq, char* lds) {
  const int tid = threadIdx.x, wid = tid >> 6, lane = tid & 63, r32 = lane & 31, hi = lane >> 5;
  char* V_lds = lds; char* K_lds = lds + 2 * SHM_V;
  float m_reg = -1e30f, l_reg = 0; f32x16 o[4] = {}; bf16x8 qr[12];
  const bf16_t* Qw = Qb + (long)(wid * QBLK + r32) * LDQ + hi * 8;
#pragma unroll
  for (int d0 = 0; d0 < 12; ++d0) qr[d0] = *reinterpret_cast<const bf16x8*>(Qw + d0 * 16);
  const int sr = tid >> 4, sc = (tid & 15) * 8, vst0 = v_st(sr, sc), vst1 = v_st(32 + sr, sc);
  const int kid0 = tid, kid1 = tid + 512, kid2 = tid + 1024;
  const int kr0 = kid0 / 24, kc0 = kid0 % 24, kr1 = kid1 / 24, kc1 = kid1 % 24, kr2 = kid2 / 24, kc2 = kid2 % 24;
  const int kg0 = kr0 * LDK + kc0 * 8, kg1 = kr1 * LDK + kc1 * 8, kg2 = kr2 * LDK + kc2 * 8;
  const int kl0 = KSWZ(kr0, kc0 * 16), kl1 = KSWZ(kr1, kc1 * 16), kl2 = KSWZ(kr2, kc2 * 16);
  const int vb0 = (int)(uintptr_t)V_lds + v_rd_base(lane);
  bf16x8 sA_v0, sA_v1, sA_k0, sA_k1, sA_k2;
#define SLOADA(k0) do { sA_v0 = *(const bf16x8*)&Vh[(long)((k0) + sr) * LDV + sc]; sA_v1 = *(const bf16x8*)&Vh[(long)((k0) + 32 + sr) * LDV + sc]; \
    sA_k0 = *(const bf16x8*)&Kh[(long)(k0) * LDK + kg0]; sA_k1 = *(const bf16x8*)&Kh[(long)(k0) * LDK + kg1]; sA_k2 = *(const bf16x8*)&Kh[(long)(k0) * LDK + kg2]; } while (0)
#define SWRITEA(b) do { *(bf16x8*)(V_lds + (b) * SHM_V + vst0) = sA_v0; *(bf16x8*)(V_lds + (b) * SHM_V + vst1) = sA_v1; \
    *(bf16x8*)(K_lds + (b) * SHM_K + kl0) = sA_k0; *(bf16x8*)(K_lds + (b) * SHM_K + kl1) = sA_k1; *(bf16x8*)(K_lds + (b) * SHM_K + kl2) = sA_k2; } while (0)
#define SWAIT() asm volatile("s_waitcnt vmcnt(0)" ::: "memory")
#define RESC(a) do { if (__any((a) < 1.f)) { \
    _Pragma("unroll") for (int r = 0; r < 16; ++r) { const float al_ = __shfl((a), crow(r, hi)); _Pragma("unroll") for (int d = 0; d < 4; ++d) o[d][r] *= al_; } } } while (0)
  const int NT = seq / KVBLK;
  SLOADA(0); SWAIT(); SWRITEA(0); __syncthreads();
#pragma unroll 1
  for (int j = 0; j < NT; ++j) {
    const int b = j & 1;
    if (j + 1 < NT) SLOADA((j + 1) * KVBLK);
    f32x16 p0, p1; float mn, al; bf16x8 pa0, pa1, pa2, pa3;
    SBAR(); qkt(p0, p1, K_lds + b * SHM_K, qr, r32, hi);
    partialSM(p0, p1, m_reg, mn, al);
    RESC(al);
    finishSM(p0, p1, al, l_reg, pa0, pa1, pa2, pa3); SBAR();
    pv_d0(o, vb0 + b * SHM_V, pa0, pa1, pa2, pa3);
    if (j + 1 < NT) { SWAIT(); SWRITEA(b ^ 1); }
    __syncthreads();
  }
  float rli[16];
#pragma unroll
  for (int r = 0; r < 16; ++r) rli[r] = __builtin_amdgcn_rcpf(__shfl(l_reg, crow(r, hi)));
  bf16_t* Ow = Ob + (long)(wid * QBLK) * LDO;
#pragma unroll
  for (int r = 0; r < 16; ++r) { int orow = crow(r, hi);
#pragma unroll
    for (int d0 = 0; d0 < 4; ++d0) Ow[(long)orow * LDO + d0 * 32 + r32] = (bf16_t)f2bf(o[d0][r] * rli[r]); }
  asm volatile("s_waitcnt vmcnt(0)" ::: "memory");
  __syncthreads();
#undef SLOADA
#undef SWRITEA
#undef SWAIT
#undef RESC
}
}

__device__ __forceinline__ int hgrn_chunk_row0(int dir, int b, int p) {
    if (p < 4) return ML + b * CTXL + 64 * (dir ? 3 - p : p);
    return b * SEQ + 64 * (dir ? 63 - (p - 4) : p - 4);
}
__device__ __forceinline__ void passA_ptrs(const Args& a, int item, int& dir, int& bh, int& p, size_t& goff) {
    dir = item / (32 * NCH); const int rem = item % (32 * NCH); bh = rem / NCH; p = rem % NCH;
    const int row0 = hgrn_chunk_row0(dir, bh >> 2, p);
    goff = (size_t)row0 * 512 + (bh & 3) * 128;
}
__device__ __forceinline__ void passA_load(const Args& a, int item, int k, int qd, unsigned (&graw)[16], unsigned (&vraw)[16]) {
    int dir, bh, p; size_t goff; passA_ptrs(a, item, dir, bh, p, goff);
    const unsigned short* G = (const unsigned short*)(a.ws + (dir ? WS_GB : WS_GF)) + goff;
    const bf16_t* Vp = (const bf16_t*)(a.ws + WS_HI) + goff;
#pragma unroll
    for (int i = 0; i < 16; ++i) { graw[i] = G[(size_t)(16 * qd + i) * 512 + k]; vraw[i] = Vp[(size_t)(16 * qd + i) * 512 + k]; }
}
__device__ __forceinline__ void hgrn_passA_loop(const Args& a, char* lds, int G_) {
    const int tid = threadIdx.x, wave = tid >> 6, lane = tid & 63, r32 = lane & 31, hi = lane >> 5;
    char* Kt = lds; char* Vt = lds + 128 * 144; float* qt = (float*)(lds + 2 * 128 * 144);
    const int k = tid & 127, qd = tid >> 7;
    constexpr int NIT = 2 * 32 * NCH;
    unsigned graw[16], vraw[16];
    if ((int)blockIdx.x < NIT) passA_load(a, blockIdx.x, k, qd, graw, vraw);
    for (int item = blockIdx.x; item < NIT; item += G_) {
        int dir, bh, p; size_t goff; passA_ptrs(a, item, dir, bh, p, goff);
        float gv[16], bl[16];
#pragma unroll
        for (int i = 0; i < 16; ++i) gv[i] = (float)__builtin_bit_cast(_Float16, (unsigned short)graw[i]);
        float run = 0.f;
        if (dir == 0) {
#pragma unroll
            for (int i = 0; i < 16; ++i) { run += gv[i]; bl[i] = run; }
        } else {
#pragma unroll
            for (int i = 15; i >= 0; --i) { run += gv[i]; bl[i] = run; }
        }
        qt[qd * 128 + k] = run;
        __syncthreads();
        const float q0 = qt[k], q1 = qt[128 + k], q2 = qt[256 + k], q3 = qt[384 + k];
        const float tot = (q0 + q1) + (q2 + q3);
        float off;
        if (dir == 0) off = (qd > 0 ? q0 : 0.f) + (qd > 1 ? q1 : 0.f) + (qd > 2 ? q2 : 0.f);
        else          off = (qd < 3 ? q3 : 0.f) + (qd < 2 ? q2 : 0.f) + (qd < 1 ? q1 : 0.f);
        unsigned short* Gw = (unsigned short*)(a.ws + (dir ? WS_GB : WS_GF)) + goff;
        unsigned kw[8], vw[8];
#pragma unroll
        for (int i = 0; i < 16; ++i) { bl[i] += off; Gw[(size_t)(16 * qd + i) * 512 + k] = (unsigned short)fminf(65535.f, rintf(bl[i] * -1024.f)); }
#pragma unroll
        for (int i = 0; i < 8; ++i) {
            const float k0 = (1.f - __expf(gv[2 * i])) * __expf(tot - bl[2 * i]), k1 = (1.f - __expf(gv[2 * i + 1])) * __expf(tot - bl[2 * i + 1]);
            kw[i] = pk2(k0, k1);
            vw[i] = vraw[2 * i] | (vraw[2 * i + 1] << 16);
        }
        *(u32x4*)(Kt + k * 144 + qd * 32) = (u32x4){kw[0], kw[1], kw[2], kw[3]}; *(u32x4*)(Kt + k * 144 + qd * 32 + 16) = (u32x4){kw[4], kw[5], kw[6], kw[7]};
        *(u32x4*)(Vt + k * 144 + qd * 32) = (u32x4){vw[0], vw[1], vw[2], vw[3]}; *(u32x4*)(Vt + k * 144 + qd * 32 + 16) = (u32x4){vw[4], vw[5], vw[6], vw[7]};
        const size_t slot = (size_t)(dir * 32 + bh) * NCH + p;
        if (qd == 0) ((float*)(a.ws + WS_DG))[slot * 128 + k] = __expf(tot);
        if (item + G_ < NIT) passA_load(a, item + G_, k, qd, graw, vraw);
        __syncthreads();
        const int kb = wave >> 1, vb0 = (wave & 1) * 2;
        f32x16 acc0 = {}, acc1 = {};
#pragma unroll
        for (int ks = 0; ks < 4; ++ks) {
            const bf16x8 af = *(const bf16x8*)(Kt + (32 * kb + r32) * 144 + ks * 32 + hi * 16);
            const bf16x8 b0 = *(const bf16x8*)(Vt + (32 * vb0 + r32) * 144 + ks * 32 + hi * 16);
            const bf16x8 b1 = *(const bf16x8*)(Vt + (32 * (vb0 + 1) + r32) * 144 + ks * 32 + hi * 16);
            acc0 = __builtin_amdgcn_mfma_f32_32x32x16_bf16(af, b0, acc0, 0, 0, 0);
            acc1 = __builtin_amdgcn_mfma_f32_32x32x16_bf16(af, b1, acc1, 0, 0, 0);
        }
        bf16_t* Lt = (bf16_t*)(a.ws + WS_A) + slot * 16384;
        char* Ls = lds + 40960;
#pragma unroll
        for (int rg = 0; rg < 4; ++rg) {
            const int k4 = 32 * kb + 8 * rg + 4 * hi;
            u32x2 w0, w1; w0.x = pk2(acc0[4 * rg], acc0[4 * rg + 1]); w0.y = pk2(acc0[4 * rg + 2], acc0[4 * rg + 3]);
            w1.x = pk2(acc1[4 * rg], acc1[4 * rg + 1]); w1.y = pk2(acc1[4 * rg + 2], acc1[4 * rg + 3]);
            *(u32x2*)(Ls + (32 * vb0 + r32) * 272 + k4 * 2) = w0;
            *(u32x2*)(Ls + (32 * (vb0 + 1) + r32) * 272 + k4 * 2) = w1;
        }
        __syncthreads();
#pragma unroll
        for (int i = 0; i < 4; ++i) { const int id = tid + 512 * i; *(u32x4*)(Lt + (size_t)(id >> 4) * 128 + (id & 15) * 8) = *(const u32x4*)(Ls + (id >> 4) * 272 + (id & 15) * 16); }
        __syncthreads();
    }
}
__device__ __forceinline__ void hgrn_passB(const Args& a, int G) {
    bf16_t* LS = (bf16_t*)(a.ws + WS_A); const float* DG = (const float*)(a.ws + WS_DG);
    for (int it = blockIdx.x * 512 + threadIdx.x; it < 64 * 2048; it += G * 512) {
        const int dbh = it >> 11, e8 = it & 2047, k0 = (e8 & 15) * 8;
        bf16_t* base = LS + (size_t)dbh * NCH * 16384 + e8 * 8; const float* dp = DG + (size_t)dbh * NCH * 128 + k0;
        float S[8];
#pragma unroll
        for (int e = 0; e < 8; ++e) S[e] = 0.f;
#pragma unroll 4
        for (int p = 0; p < NCH; ++p) {
            const u32x4 L = *(const u32x4*)(base + (size_t)p * 16384);
            const f32x4 d0 = *(const f32x4*)(dp + p * 128), d1 = *(const f32x4*)(dp + p * 128 + 4);
            if (p >= 4) { u32x4 w; w.x = pk2(S[0], S[1]); w.y = pk2(S[2], S[3]); w.z = pk2(S[4], S[5]); w.w = pk2(S[6], S[7]); *(u32x4*)(base + (size_t)p * 16384) = w; }
            S[0] = d0.x * S[0] + bf2f(L.x & 0xffffu); S[1] = d0.y * S[1] + bf2f(L.x >> 16);
            S[2] = d0.z * S[2] + bf2f(L.y & 0xffffu); S[3] = d0.w * S[3] + bf2f(L.y >> 16);
            S[4] = d1.x * S[4] + bf2f(L.z & 0xffffu); S[5] = d1.y * S[5] + bf2f(L.z >> 16);
            S[6] = d1.z * S[6] + bf2f(L.w & 0xffffu); S[7] = d1.w * S[7] + bf2f(L.w >> 16);
        }
    }
}
__device__ __forceinline__ float b16f(unsigned v) { return (float)v * (-1.f / 1024.f); }
__device__ __forceinline__ unsigned u16at(const u32x4 (&v)[2], int e) { const unsigned w = v[e >> 3][(e & 7) >> 1]; return (e & 1) ? (w >> 16) : (w & 0xffffu); }
struct PassCDir { u32x4 bt[2], bn[2], br[2], S[4]; };
__device__ __forceinline__ void passC_load_dir(const Args& a, int dir, int bh, int lc, int row0, int h, int tok, int ks, int tid, PassCDir& D) {
    const unsigned short* B = (const unsigned short*)(a.ws + (dir ? WS_GB : WS_GF)) + (size_t)row0 * 512 + h * 128 + ks;
    const int nb = dir ? (tok < 63 ? tok + 1 : 63) : (tok > 0 ? tok - 1 : 0), rf = dir ? 32 : 31;
    D.bt[0] = *(const u32x4*)(B + (size_t)tok * 512); D.bt[1] = *(const u32x4*)(B + (size_t)tok * 512 + 8);
    D.bn[0] = *(const u32x4*)(B + (size_t)nb * 512);  D.bn[1] = *(const u32x4*)(B + (size_t)nb * 512 + 8);
    D.br[0] = *(const u32x4*)(B + (size_t)rf * 512);  D.br[1] = *(const u32x4*)(B + (size_t)rf * 512 + 8);
    const int p = dir ? 4 + 63 - lc : 4 + lc;
    const u32x4* Sg = (const u32x4*)((const bf16_t*)(a.ws + WS_A) + ((size_t)(dir * 32 + bh) * NCH + p) * 16384);
#pragma unroll
    for (int i = 0; i < 4; ++i) D.S[i] = Sg[tid + 512 * i];
}
__device__ __forceinline__ void passC_ops(const PassCDir& D, bool has_nb, const u32x4 (&q)[2], char* St, char* Qd, char* Qd2, char* Kd2, int tok, int ks, int tid) {
    float qd_[16], qd2_[16], kd2_[16];
#pragma unroll
    for (int e = 0; e < 16; ++e) {
        const float b = b16f(u16at(D.bt, e)), nbv = has_nb ? b16f(u16at(D.bn, e)) : 0.f, bref = b16f(u16at(D.br, e));
        const float g = b - nbv, d = b - bref, qv = bf2f(u16at(q, e));
        qd_[e] = qv * __expf(b); qd2_[e] = qv * __expf(d); kd2_[e] = (1.f - __expf(g)) * __expf(-d);
    }
#pragma unroll
    for (int hlf = 0; hlf < 2; ++hlf) {
        u32x4 w;
        w.x = pk2(qd_[8 * hlf + 0], qd_[8 * hlf + 1]); w.y = pk2(qd_[8 * hlf + 2], qd_[8 * hlf + 3]); w.z = pk2(qd_[8 * hlf + 4], qd_[8 * hlf + 5]); w.w = pk2(qd_[8 * hlf + 6], qd_[8 * hlf + 7]);
        *(u32x4*)(Qd + tok * 272 + ks * 2 + hlf * 16) = w;
        w.x = pk2(qd2_[8 * hlf + 0], qd2_[8 * hlf + 1]); w.y = pk2(qd2_[8 * hlf + 2], qd2_[8 * hlf + 3]); w.z = pk2(qd2_[8 * hlf + 4], qd2_[8 * hlf + 5]); w.w = pk2(qd2_[8 * hlf + 6], qd2_[8 * hlf + 7]);
        *(u32x4*)(Qd2 + tok * 272 + ks * 2 + hlf * 16) = w;
        w.x = pk2(kd2_[8 * hlf + 0], kd2_[8 * hlf + 1]); w.y = pk2(kd2_[8 * hlf + 2], kd2_[8 * hlf + 3]); w.z = pk2(kd2_[8 * hlf + 4], kd2_[8 * hlf + 5]); w.w = pk2(kd2_[8 * hlf + 6], kd2_[8 * hlf + 7]);
        *(u32x4*)(Kd2 + tok * 272 + ks * 2 + hlf * 16) = w;
    }
#pragma unroll
    for (int i = 0; i < 4; ++i) { const int id = tid + 512 * i; *(u32x4*)(St + (id >> 4) * 272 + (id & 15) * 16) = D.S[i]; }
}
__device__ __forceinline__ void passC_mma1(f32x16& o, int dir, const char* St, const char* Qd, const char* Qd2, const char* Kd2, char* Pb, int wave, int r32, int hi) {
    const int rb = wave >> 2, cb = wave & 3, tr = (wave & 3) >> 1, tc = wave & 1;
    f32x16 pacc = {};
#pragma unroll
    for (int kk = 0; kk < 8; ++kk) {
        const bf16x8 af = *(const bf16x8*)(Qd + (32 * rb + r32) * 272 + kk * 32 + hi * 16);
        const bf16x8 bf = *(const bf16x8*)(St + (32 * cb + r32) * 272 + kk * 32 + hi * 16);
        o = __builtin_amdgcn_mfma_f32_32x32x16_bf16(af, bf, o, 0, 0, 0);
        const bf16x8 a2 = *(const bf16x8*)(Qd2 + (32 * tr + r32) * 272 + kk * 32 + hi * 16);
        const bf16x8 b2 = *(const bf16x8*)(Kd2 + (32 * tc + r32) * 272 + kk * 32 + hi * 16);
        pacc = __builtin_amdgcn_mfma_f32_32x32x16_bf16(a2, b2, pacc, 0, 0, 0);
    }
    if (wave < 4) {
#pragma unroll
        for (int r = 0; r < 16; ++r) {
            const int t = 32 * tr + att::crow(r, hi), s_ = 32 * tc + r32;
            const bool keep = dir ? (s_ >= t) : (s_ <= t);
            *(bf16_t*)(Pb + t * 144 + s_ * 2) = (bf16_t)f2bf(keep ? pacc[r] : 0.f);
        }
    }
}
__device__ __forceinline__ void passC_mma2(f32x16& o, const char* Pb, const char* Vt, int wave, int r32, int hi) {
    const int rb = wave >> 2, cb = wave & 3;
#pragma unroll
    for (int ks = 0; ks < 4; ++ks) {
        const bf16x8 af = *(const bf16x8*)(Pb + (32 * rb + r32) * 144 + ks * 32 + hi * 16);
        const bf16x8 bf = *(const bf16x8*)(Vt + (32 * cb + r32) * 144 + ks * 32 + hi * 16);
        o = __builtin_amdgcn_mfma_f32_32x32x16_bf16(af, bf, o, 0, 0, 0);
    }
}
__device__ __forceinline__ void hgrn_passC(const Args& a, char* lds, int item) {
    const int tid = threadIdx.x, wave = tid >> 6, lane = tid & 63, r32 = lane & 31, hi = lane >> 5;
    const int bh = item >> 6, lc = item & 63, b = bh >> 2, h = bh & 3;
    const int row0 = b * SEQ + 64 * lc;
    char* St = lds; char* Qd = lds + 34816; char* Qd2 = lds + 52224; char* Kd2 = lds + 69632; char* Vt = lds + 87040; char* Pb = lds + 105472; float* Os = (float*)(lds + 34816);
    const int tok = tid >> 3, ks = (tid & 7) * 16;
    const size_t roff = (size_t)(row0 + tok) * 512 + h * 128 + ks;
    u32x4 q[2], vv[2], hg[2];
    { const bf16_t* Qp = (const bf16_t*)(a.ws + WS_HQ) + roff; q[0] = *(const u32x4*)Qp; q[1] = *(const u32x4*)(Qp + 8);
      const bf16_t* Vp = (const bf16_t*)(a.ws + WS_HI) + roff; vv[0] = *(const u32x4*)Vp; vv[1] = *(const u32x4*)(Vp + 8);
      const bf16_t* Hp = (const bf16_t*)(a.ws + WS_HG) + roff; hg[0] = *(const u32x4*)Hp; hg[1] = *(const u32x4*)(Hp + 8); }
    PassCDir D0, D1;
    passC_load_dir(a, 0, bh, lc, row0, h, tok, ks, tid, D0);
    passC_load_dir(a, 1, bh, lc, row0, h, tok, ks, tid, D1);
#pragma unroll
    for (int e = 0; e < 16; ++e) *(bf16_t*)(Vt + (ks + e) * 144 + tok * 2) = (bf16_t)u16at(vv, e);
    passC_ops(D0, tok > 0, q, St, Qd, Qd2, Kd2, tok, ks, tid);
    __syncthreads();
    f32x16 o = {};
    passC_mma1(o, 0, St, Qd, Qd2, Kd2, Pb, wave, r32, hi);
    __syncthreads();
    passC_mma2(o, Pb, Vt, wave, r32, hi);
    passC_ops(D1, tok < 63, q, St, Qd, Qd2, Kd2, tok, ks, tid);
    __syncthreads();
    passC_mma1(o, 1, St, Qd, Qd2, Kd2, Pb, wave, r32, hi);
    __syncthreads();
    passC_mma2(o, Pb, Vt, wave, r32, hi);
    {
        const int rb = wave >> 2, cb = wave & 3;
#pragma unroll
        for (int r = 0; r < 16; ++r) Os[(32 * rb + att::crow(r, hi)) * 128 + 32 * cb + r32] = o[r];
    }
    __syncthreads();
    {
        float ov[16]; float ss = 0.f;
#pragma unroll
        for (int e = 0; e < 16; ++e) { ov[e] = Os[tok * 128 + ks + e]; ss += ov[e] * ov[e]; }
        ss += __shfl_xor(ss, 1); ss += __shfl_xor(ss, 2); ss += __shfl_xor(ss, 4);
        const float rstd = rsqrtf(ss * (1.f / 128.f) + EPS);
        float res[16];
#pragma unroll
        for (int e = 0; e < 16; ++e) { const float hv = bf2f(u16at(hg, e)); res[e] = ov[e] * rstd * a.g_on[ks + e] * (hv * sigmoidf_(hv)); }
        bf16_t* Mx = (bf16_t*)(a.ws + WS_MIX) + (size_t)(row0 + tok) * 1024 + 512 + h * 128 + ks;
        u32x4 w;
        w.x = pk2(res[0], res[1]); w.y = pk2(res[2], res[3]); w.z = pk2(res[4], res[5]); w.w = pk2(res[6], res[7]); *(u32x4*)Mx = w;
        w.x = pk2(res[8], res[9]); w.y = pk2(res[10], res[11]); w.z = pk2(res[12], res[13]); w.w = pk2(res[14], res[15]); *(u32x4*)(Mx + 8) = w;
    }
    __syncthreads();
}

#define XB_TMO      128
#define XB_XCNT(j)  (256  + 64 * (j))
#define XB_XSUB(j)  (1280 + 64 * (j))
#define XB_XGEN(j)  (2304 + 64 * (j))
#define XB_TOP      3328
#define XB_TOPGEN   3392
#define XCD_BAR_WORDS 3456
#define XB_SPIN_CAP (1u << 18)

__device__ __forceinline__ unsigned xb_ld(unsigned* p)              { return __hip_atomic_load(p, __ATOMIC_RELAXED, __HIP_MEMORY_SCOPE_AGENT); }
__device__ __forceinline__ unsigned xb_add(unsigned* p, unsigned v) { return __hip_atomic_fetch_add(p, v, __ATOMIC_RELAXED, __HIP_MEMORY_SCOPE_AGENT); }
__device__ __forceinline__ unsigned xb_xcc_id() { return (unsigned)__builtin_amdgcn_s_getreg((3 << 11) | 20) & 0xFu; }
#define XB_SPIN(cond, bar) do { unsigned _sp = 0; while (cond) { __builtin_amdgcn_s_sleep(1); \
    if ((++_sp & 255u) == 0u) { if (xb_ld(&(bar)[XB_TMO])) break; if (_sp > XB_SPIN_CAP) { atomicAdd(&(bar)[XB_TMO], 1u); break; } } } } while (0)

struct XcdBarrier {
    unsigned* bar; unsigned x;
    volatile LAS unsigned* st;
};

__device__ __forceinline__ XcdBarrier xcd_barrier_post(unsigned* bar, volatile LAS unsigned* st) {
    XcdBarrier b; b.bar = bar; b.x = xb_xcc_id(); b.st = st;
    if (threadIdx.x == 0) (void)xb_add(&bar[XB_XCNT(b.x)], 1u);
    return b;
}
__device__ __forceinline__ void xcd_barrier_complete(unsigned* bar, unsigned x, unsigned& nloc, unsigned& nx) {
    const unsigned G = gridDim.x * gridDim.y * gridDim.z;
    unsigned sum, cnt, mine, sp = 0u;
    for (;;) {
        sum = 0u; cnt = 0u; mine = 0u;
#pragma unroll
        for (unsigned j = 0; j < 16; ++j) { const unsigned c = xb_ld(&bar[XB_XCNT(j)]); sum += c; cnt += (c > 0u) ? 1u : 0u; mine = (j == x) ? c : mine; }
        if (sum == G) break;
        __builtin_amdgcn_s_sleep(1);
        if ((++sp & 255u) == 0u) { if (xb_ld(&bar[XB_TMO])) break; if (sp > XB_SPIN_CAP) { atomicAdd(&bar[XB_TMO], 1u); break; } }
    }
    nloc = mine > 0u ? mine : 1u; nx = cnt > 0u ? cnt : 1u;
}

__device__ __forceinline__ void xcd_barrier(const XcdBarrier& b) {
    asm volatile("s_waitcnt vmcnt(0)" ::: "memory");
    __syncthreads();
    if (threadIdx.x == 0) {
        unsigned* bar = b.bar;
        __builtin_amdgcn_s_waitcnt(0);
        unsigned nloc = b.st[0], nx = b.st[1];
        if (nloc == 0u) { xcd_barrier_complete(bar, b.x, nloc, nx); b.st[0] = nloc; b.st[1] = nx; }
        const unsigned old = xb_add(&bar[XB_XSUB(b.x)], 1u);
        const unsigned gen = old / nloc;
        if (old + 1u == (gen + 1u) * nloc) {
            __builtin_amdgcn_fence(__ATOMIC_RELEASE, "agent");
            asm volatile("s_waitcnt vmcnt(0)" ::: "memory");
            const unsigned og = xb_add(&bar[XB_TOP], 1u);
            const unsigned tg = og / nx;
            if (og + 1u == (tg + 1u) * nx) xb_add(&bar[XB_TOPGEN], 1u);
            else XB_SPIN(xb_ld(&bar[XB_TOPGEN]) == tg, bar);
            __builtin_amdgcn_fence(__ATOMIC_ACQUIRE, "agent");
            xb_add(&bar[XB_XGEN(b.x)], 1u);
            asm volatile("s_waitcnt vmcnt(0)" ::: "memory");
        } else {
            XB_SPIN(xb_ld(&bar[XB_XGEN(b.x)]) == gen, bar);
            __builtin_amdgcn_fence(__ATOMIC_ACQUIRE, "agent");
            asm volatile("s_waitcnt vmcnt(0)" ::: "memory");
        }
    }
    __syncthreads();
}

__global__ void __launch_bounds__(512, 2) fwd_megakernel(Args a) {
    extern __shared__ __attribute__((aligned(16))) unsigned char lds[];
    cg::grid_group grid = cg::this_grid();
    const int tid = threadIdx.x, wave = __builtin_amdgcn_readfirstlane(tid >> 6), lane = tid & 63;
    const int G = gridDim.x;
    unsigned char* ws = a.ws;
    LAS unsigned char* ldsl = (LAS unsigned char*)lds;
    char* ldsc = (char*)lds;
    const int lo = a.ph_lo, hi = a.ph_hi;
#ifndef SKIPMASK
#define SKIPMASK 0
#endif
#ifndef REPMASK
#define REPMASK 0
#endif
#define REPN(k) (((REPMASK >> (k)) & 1) ? 2 : 1)
#define IN(k) (!((SKIPMASK >> (k)) & 1) && lo <= (k) && (k) < hi)
#define SEAM(k) do { if (lo <= (k) && (k) + 1 < hi) { if ((k) == 0) grid.sync(); else xcd_barrier(xbar); } } while (0)
    volatile LAS unsigned* xst = (volatile LAS unsigned*)(ldsl + LDS_BYTES - 16);
    if (tid < 4) xst[tid] = 0u;
    __syncthreads();
    XcdBarrier xbar; xbar.bar = (unsigned*)(ws + WS_BAR); xbar.x = 0; xbar.st = xst;
    if (hi - lo > 1) xbar = xcd_barrier_post((unsigned*)(ws + WS_BAR), xst);
    float* MOD = (float*)(ws + WS_MOD);
    float* RSS = (float*)(ws + WS_RSSP);
    const float* RC = (const float*)(ws + WS_RCOS); const float* RS = (const float*)(ws + WS_RSIN);
    bf16_t* Hb = (bf16_t*)(ws + WS_A);
    bf16_t* Qb = (bf16_t*)a.out;
    bf16_t* Kb = (bf16_t*)((char*)a.out + 48 * MiB);
    bf16_t* Vb = (bf16_t*)(ws + WS_V);
    bf16_t* MIX = (bf16_t*)(ws + WS_MIX);
    const int gw = blockIdx.x * 8 + wave, NGW = G * 8;

    if (IN(0)) { p0_prologue(a, ldsc, G); }
    SEAM(0);
    if (IN(1)) {
        if (G == 256) {
            f32x4 A[4], B[4]; const int bb = gw >> 8, rw = gw & 255;
            load_mod_params(a.g_mix, MOD + (size_t)bb * 6144, 0, A, B, lane);
#pragma unroll 1
            for (int it = 0; it < 4; ++it) { const float* src[4]; bf16_t* dst[4];
#pragma unroll
                for (int i = 0; i < 4; ++i) { const int r = bb * 4096 + rw + 256 * (4 * it + i); src[i] = a.x + (size_t)r * 1024; dst[i] = Hb + (size_t)r * 1024; }
                rows_norm_mod_pre<4>(src, A, B, dst, lane); }
            load_mod_params(a.g_mix, MOD + (size_t)8 * 6144, 0, A, B, lane);
            { const float* src[1] = {a.ctx + (size_t)gw * 1024}; bf16_t* dst[1] = {Hb + (size_t)(ML + gw) * 1024}; rows_norm_mod_pre<1>(src, A, B, dst, lane); }
        } else
        for (int r0 = gw; r0 < MT; r0 += 4 * NGW) {
            const float* src[4]; const float* md[4]; bf16_t* dst[4]; bool ok[4];
#pragma unroll
            for (int i = 0; i < 4; ++i) { const int r = r0 + i * NGW; ok[i] = r < MT; const int rr = ok[i] ? r : r0; const bool lat = rr < ML;
                src[i] = lat ? a.x + (size_t)rr * 1024 : a.ctx + (size_t)(rr - ML) * 1024; md[i] = MOD + (size_t)(lat ? (rr >> 12) : 8) * 6144; dst[i] = Hb + (size_t)rr * 1024; }
            rows_norm_mod_bf16<4>(src, a.g_mix, md, 0, dst, ok, lane);
        }
    }
#ifdef ZERO_MIX
    if (IN(1)) { u32x4* mz = (u32x4*)(ws + WS_MIX); const u32x4 z = {0u, 0u, 0u, 0u}; for (size_t i = (size_t)blockIdx.x * 512 + tid; i < (size_t)ML * 1024 * 2 / 16; i += (size_t)G * 512) mz[i] = z; }
#endif
    SEAM(1);
    if (IN(2)) {
        pg8::Gemm g{Hb, (const bf16_t*)(ws + WS_WIN), MT, NINP, 1024}; pg8::StaticOrder S; S.init(MT, NINP, G, (int)blockIdx.x);
        EpiInProj E{ws, Kb};
        pg8::gemm_phase<EpiInProj, pg8::StaticOrder, true, true>(ldsl, g, S, E);
    }
    SEAM(2);
    if (IN(3)) {
#ifndef SKIP3A
        { pg8::Gemm g{(const bf16_t*)(ws + WS_CQ), (const bf16_t*)(ws + WS_WUQ), ML, 768, 256}; pg8::StaticOrder S; S.init(ML, 768, G, (int)blockIdx.x);
          EpiQ E{Qb, RSS, RC, RS};
          pg8::gemm_phase<EpiQ, pg8::StaticOrder, true, true>(ldsl, g, S, E); }
#endif
#ifndef SKIP3B
        { pg8::Gemm g{(const bf16_t*)(ws + WS_CKV), (const bf16_t*)(ws + WS_WUKV), MT, 1024, 256}; pg8::StaticOrder S; S.init(MT, 1024, G, (int)blockIdx.x);
          EpiKV E{Kb, Vb, RSS};
          pg8::gemm_phase<EpiKV, pg8::StaticOrder, true, true>(ldsl, g, S, E); }
#endif
#ifndef SKIP3C
        hgrn_passA_loop(a, ldsc, G);
#endif
    }
#ifdef EXPJ
    if (IN(3)) {
        const u32x4* srcA = (const u32x4*)(ws + EXPJ_A); const u32x4* srcB = (const u32x4*)(ws + EXPJ_B); u32x4* dst = (u32x4*)MIX;
        for (size_t i = (size_t)blockIdx.x * 512 + tid; i < (size_t)ML * 64; i += (size_t)G * 512) { const size_t r = i >> 6, c = i & 63; dst[r * 128 + c] = srcA[r * 64 + c]; dst[r * 128 + 64 + c] = srcB[r * 64 + c]; }
    }
#endif
    SEAM(3);
    if (IN(4)) { hgrn_passB(a, G); }
    SEAM(4);
    if (IN(5)) {
#ifndef SKIP5A
        for (int u = blockIdx.x; u < 512; u += G) {
            int bh, qb;
            if (G == 256) { const int xcd = blockIdx.x & 7, cu = blockIdx.x >> 3, i = u >> 8; bh = xcd * 4 + i * 2 + (cu >> 4); qb = cu & 15; }
            else { bh = u >> 4; qb = u & 15; }
            const int b = bh >> 2, h = bh & 3;
            att::attn_body(Qb + ((size_t)bh * SEQ + qb * 256) * 192, Kb + (size_t)bh * KVL * 192, Vb + (size_t)bh * KVL * 128,
                           MIX + ((size_t)b * SEQ + qb * 256) * 1024 + h * 128, KVL, ldsc);
        }
#endif
#ifndef SKIP5B
        for (int it = blockIdx.x; it < 2048; it += G) hgrn_passC(a, ldsc, it);
#endif
    }
#ifdef EXPM
    if (IN(5)) { const u32x4* src = (const u32x4*)(ws + WS_A); u32x4* dst = (u32x4*)MIX;
        for (size_t i = (size_t)blockIdx.x * 512 + tid; i < (size_t)ML * 128; i += (size_t)G * 512) dst[i] = src[i]; }
#endif
    SEAM(5);
    if (IN(6)) {
        pg8::Gemm g{MIX, (const bf16_t*)(ws + WS_WOUT), ML, 1024, 1024}; pg8::StaticOrder S; S.init(ML, 1024, G, (int)blockIdx.x);
        EpiRes E{a.x, a.out, MOD + 2048};
        pg8::gemm_phase<EpiRes, pg8::StaticOrder, true, true>(ldsl, g, S, E);
    }
    SEAM(6);
    if (IN(7)) {
        if (G == 256) {
            f32x4 A[4], B[4]; const int bb = gw >> 8, rw = gw & 255;
            load_mod_params(a.g_ffn, MOD + (size_t)bb * 6144, 3072, A, B, lane);
#pragma unroll 1
            for (int it = 0; it < 4; ++it) { const float* src[4]; bf16_t* dst[4];
#pragma unroll
                for (int i = 0; i < 4; ++i) { const int r = bb * 4096 + rw + 256 * (4 * it + i); src[i] = a.out + (size_t)r * 1024; dst[i] = Hb + (size_t)r * 1024; }
                rows_norm_mod_pre<4>(src, A, B, dst, lane); }
        } else
        for (int r0 = gw; r0 < ML; r0 += 4 * NGW) {
            const float* src[4]; const float* md[4]; bf16_t* dst[4]; bool ok[4];
#pragma unroll
            for (int i = 0; i < 4; ++i) { const int r = r0 + i * NGW; ok[i] = r < ML; const int rr = ok[i] ? r : r0;
                src[i] = a.out + (size_t)rr * 1024; md[i] = MOD + (size_t)(rr >> 12) * 6144; dst[i] = Hb + (size_t)rr * 1024; }
            rows_norm_mod_bf16<4>(src, a.g_ffn, md, 3072, dst, ok, lane);
        }
    }
    SEAM(7);
    if (IN(8)) {
        pg8::Gemm g{Hb, (const bf16_t*)(ws + WS_WGU), ML, 2 * DFF, 1024}; pg8::StaticOrder S; S.init(ML, 2 * DFF, G, (int)blockIdx.x);
        EpiSwiglu E{(bf16_t*)(ws + WS_ACT)};
        pg8::gemm_phase<EpiSwiglu, pg8::StaticOrder, true, true>(ldsl, g, S, E);
    }
    SEAM(8);
    if (IN(9)) {
        pg8::Gemm g{(const bf16_t*)(ws + WS_ACT), (const bf16_t*)(ws + WS_WDN), ML, 1024, DFF}; pg8::StaticOrder S; S.init(ML, 1024, G, (int)blockIdx.x);
        EpiRes E{a.out, a.out, MOD + 5120};
        pg8::gemm_phase<EpiRes, pg8::StaticOrder, true, true>(ldsl, g, S, E);
    }
    SEAM(9);
    if (IN(10)) {
        if (ML % (4 * NGW) == 0) { for (int r0 = gw; r0 < ML; r0 += 4 * NGW) { float* rows[4];
#pragma unroll
            for (int i = 0; i < 4; ++i) rows[i] = a.out + (size_t)(r0 + i * NGW) * 1024;
            rows_norm_f32<4>(rows, a.g_final, lane); } }
        else { for (int r = gw; r < ML; r += NGW) { float* rows[1] = {a.out + (size_t)r * 1024}; rows_norm_f32<1>(rows, a.g_final, lane); } }
    }
#ifdef EXTRA_SYNCS
    if (hi - lo > 5) { for (int i_ = 0; i_ < EXTRA_SYNCS; ++i_) grid.sync(); }
#endif
#ifdef PROBE_PHASE
    if (a.ph_lo == 11) {
        for (int u = blockIdx.x; u < 512; u += G) {
            int bh, qb;
            if (G == 256) { const int xcd = blockIdx.x & 7, cu = blockIdx.x >> 3, i = u >> 8; bh = xcd * 4 + i * 2 + (cu >> 4); qb = cu & 15; }
            else { bh = u >> 4; qb = u & 15; }
            const int b = bh >> 2, h = bh & 3;
            att::attn_body(Qb + ((size_t)bh * SEQ + qb * 256) * 192, Kb + (size_t)bh * KVL * 192, Vb + (size_t)bh * KVL * 128,
                           MIX + ((size_t)b * SEQ + qb * 256) * 1024 + h * 128, KVL, ldsc);
        }
    }
    if (a.ph_lo == 12) { for (int it = blockIdx.x; it < 2048; it += G) hgrn_passC(a, ldsc, it); }
    if (a.ph_lo == 13) { hgrn_passA_loop(a, ldsc, G); }
#endif
#undef IN
#undef SEAM
}

#ifndef PROBE_REPS
#define PROBE_REPS 1
#endif
#ifndef MK_PER_PHASE
#define MK_PER_PHASE 0
#endif
extern "C" void kernel_launch(void* const* d_in, const int* in_sizes, int n_in, void* d_out, int out_size, void* d_ws, size_t ws_size, hipStream_t stream) {
    static int grid = 0;
    if (grid == 0) {
        if (n_in != 21 || out_size != ML * DM || ws_size < WS_END) { fprintf(stderr, "kernel_launch: unexpected shapes (n_in %d out %d ws %zu)\n", n_in, out_size, ws_size); grid = -1; return; }
        int dev = 0, cus = 0, per_cu = 0;
        hipGetDevice(&dev); hipDeviceGetAttribute(&cus, hipDeviceAttributeMultiprocessorCount, dev);
        if (hipFuncSetAttribute((const void*)fwd_megakernel, hipFuncAttributeMaxDynamicSharedMemorySize, LDS_BYTES) != hipSuccess) { fprintf(stderr, "kernel_launch: hipFuncSetAttribute failed\n"); grid = -1; return; }
        if (hipOccupancyMaxActiveBlocksPerMultiprocessor(&per_cu, (const void*)fwd_megakernel, 512, LDS_BYTES) != hipSuccess || per_cu < 1) { fprintf(stderr, "kernel_launch: occupancy query says %d\n", per_cu); per_cu = 1; }
        (void)hipGetLastError();
        grid = cus * 1;
        fprintf(stderr, "kernel_launch: grid %d (per_cu %d)\n", grid, per_cu);
    }
    if (grid < 0) return;
    (void)hipMemsetAsync((char*)d_ws + WS_BAR, 0, 16384, stream);
    Args a{};
    const float** ap = (const float**)&a;
    for (int i = 0; i < 21; ++i) ap[i] = (const float*)d_in[i];
    a.out = (float*)d_out; a.ws = (unsigned char*)d_ws;
#if MK_PER_PHASE
    for (int ph = 0; ph < 11; ++ph) {
        a.ph_lo = ph; a.ph_hi = ph + 1;
        hipLaunchKernelGGL(fwd_megakernel, dim3(grid), dim3(512), LDS_BYTES, stream, a);
    }
#else
#ifdef PROBE_PHASE
    for (int pr_ = 0; pr_ < PROBE_REPS; ++pr_) { a.ph_lo = PROBE_PHASE; a.ph_hi = PROBE_PHASE + 1; hipLaunchKernelGGL(fwd_megakernel, dim3(grid), dim3(512), LDS_BYTES, stream, a); }
#endif
    a.ph_lo = 0; a.ph_hi = 11;
    void* args[] = {&a};
    hipError_t e = hipLaunchCooperativeKernel((const void*)fwd_megakernel, dim3(grid), dim3(512), args, LDS_BYTES, stream);
    if (e != hipSuccess) fprintf(stderr, "cooperative launch failed: %s (grid %d)\n", hipGetErrorString(e), grid);
#endif
}
```

```cpp
#include <hip/hip_runtime.h>
#include <hip/hip_cooperative_groups.h>
#include <hip/hip_bf16.h>
#include <cstdio>
#include <cstdint>
namespace cg = cooperative_groups;
namespace pg8 {
#define PG8_LAS __attribute__((address_space(3)))
typedef unsigned short bf16_t;
typedef short bf16x8 __attribute__((ext_vector_type(8)));
typedef float f32x4 __attribute__((ext_vector_type(4)));
typedef unsigned u32x4 __attribute__((ext_vector_type(4)));
constexpr int BM = 256, BK = 64, HALF = 128, HTB = HALF * BK * 2  , STAGE_BYTES = 8 * HTB, NXCD = 8, WGM = 8;

__host__ __device__ __forceinline__ int lds_byte(int r, int c) { const int st = (r >> 4) * 2 + (c >> 5), rr = r & 15, cc = c & 31, ob = rr * 64 + cc * 2; return st * 1024 + (ob ^ (((ob >> 9) & 1) << 5)); }
__host__ __device__ __forceinline__ void stage_rc(int b, int& R, int& C) { const int st = b / 1024, sb = b % 1024, swz = sb ^ (((sb >> 9) & 1) << 5); R = (st >> 1) * 16 + swz / 64; C = (st & 1) * 32 + (swz % 64) / 2; }
__host__ __device__ __forceinline__ int perm32(int rho) { const int n = rho >> 4, i = rho & 15; return 8 * (i >> 2) + 4 * n + (i & 3); }

struct Unit { int pm, pn; };
struct Gemm { const bf16_t* A; const bf16_t* Bt; int M, N, K; };

struct StaticOrder {
    int nM, nN, nwg, G, c;
    __host__ __device__ void init(int M, int N, int G_, int c_) { nM = M / BM; nN = N / BM; nwg = nM * nN; G = G_; c = c_; }
    __host__ __device__ bool next(int i, Unit& u) const {
        const long L = (long)i * G + c; if (L >= nwg) return false;
        int wgid = (int)L; { const int q = nwg / NXCD, r = nwg % NXCD, xcd = wgid % NXCD, off = wgid / NXCD; wgid = (xcd < r ? xcd * (q + 1) : r * (q + 1) + (xcd - r) * q) + off; }
        const int nig = WGM * nN, gid = wgid / nig, fm = gid * WGM, gsz = (nM - fm) < WGM ? (nM - fm) : WGM;
        u.pm = fm + ((wgid % nig) % gsz); u.pn = (wgid % nig) / gsz; return true;
    }
    __device__ __forceinline__ void a_ready(const Unit&) const {}
    __device__ __forceinline__ void done(const Unit&) const {}
};

__device__ __forceinline__ unsigned cvt_pk_bf16(float lo, float hi) { unsigned r; asm volatile("v_cvt_pk_bf16_f32 %0, %1, %2" : "=v"(r) : "v"(lo), "v"(hi)); return r; }
typedef float f32x2 __attribute__((ext_vector_type(2)));
template <class Epi, class Sched, bool ALIGN_EPI = false, bool SP2 = false>
__device__ __forceinline__ void gemm_phase(PG8_LAS unsigned char* lds, const Gemm g, const Sched& S, const Epi& E) {
    const int tid = threadIdx.x, wid = __builtin_amdgcn_readfirstlane(tid >> 6), lane = tid & 63, wr = wid >> 2, wc = wid & 3, fr = lane & 15, fq = lane >> 4;
    const int K = g.K, nt = K / BK;
    unsigned voffA[2], voffB[2];
#pragma unroll
    for (int i = 0; i < 2; ++i) { int R, C; stage_rc(tid * 16 + i * 8192, R, C); const int Rb = Epi::PERM ? ((R & ~31) + perm32(R & 31)) : R;
        voffA[i] = (unsigned)(R * K + C) * 2u; voffB[i] = (unsigned)(Rb * K + C) * 2u; }
    const size_t kstep = (size_t)(BK * 2);
    const size_t hstep = (size_t)HALF * K * 2;
    const size_t tstep = 2 * hstep;
    const unsigned ldsw = (unsigned)wid * 1024u;
    const int aoff = lds_byte(wr * 64 + fr, fq * 8), boff = lds_byte(wc * 32 + fr, fq * 8);
#define PG8_SA(b, h) (((b) * 2 + (h)) * HTB)
#define PG8_SB(b, h) ((4 + (b) * 2 + (h)) * HTB)
#define PG8_STAGE(bufoff, gbase, voff) do { _Pragma("unroll") for (int _i = 0; _i < 2; ++_i) \
        __builtin_amdgcn_global_load_lds((const unsigned*)((const char*)(gbase) + (voff)[_i]), (PG8_LAS unsigned*)(lds + (bufoff) + ldsw + _i * 8192), 16, 0, 0); } while (0)
#define PG8_LDA(dst, b, h) do { _Pragma("unroll") for (int m = 0; m < 4; ++m) _Pragma("unroll") for (int k = 0; k < 2; ++k) dst[m][k] = *(const PG8_LAS bf16x8*)(lds + PG8_SA(b, h) + aoff + m * 2048 + k * 1024); } while (0)
#define PG8_LDB(dst, b, h) do { _Pragma("unroll") for (int n = 0; n < 2; ++n) _Pragma("unroll") for (int k = 0; k < 2; ++k) dst[n][k] = *(const PG8_LAS bf16x8*)(lds + PG8_SB(b, h) + boff + n * 2048 + k * 1024); } while (0)
#define PG8_MMA(ai, bj, At, Bt) do { __builtin_amdgcn_s_setprio(1); _Pragma("unroll") for (int m = 0; m < 4; ++m) _Pragma("unroll") for (int n = 0; n < 2; ++n) _Pragma("unroll") for (int k = 0; k < 2; ++k) \
        acc[ai][bj][m][n] = __builtin_amdgcn_mfma_f32_16x16x32_bf16(Bt[n][k], At[m][k], acc[ai][bj][m][n], 0, 0, 0); __builtin_amdgcn_s_setprio(0); } while (0)
#define PG8_WAIT_V(n) asm volatile("s_waitcnt vmcnt(" #n ")" ::: "memory")
#define PG8_WAIT_L(n) asm volatile("s_waitcnt lgkmcnt(" #n ")" ::: "memory")
#define PG8_BAR __builtin_amdgcn_s_barrier()
#define PG8_SCHED __builtin_amdgcn_sched_barrier(0)
    Unit cur, nxt; int ui = 0;
    if (!S.next(0, cur)) return;
    f32x4 acc[2][2][4][2];
#pragma unroll
    for (int a = 0; a < 2; ++a)
#pragma unroll
        for (int b = 0; b < 2; ++b)
#pragma unroll
            for (int m = 0; m < 4; ++m)
#pragma unroll
                for (int n = 0; n < 2; ++n) acc[a][b][m][n] = (f32x4){0.f, 0.f, 0.f, 0.f};
    bf16x8 At[4][2], B0[2][2], B1[2][2];
    const char* cA = (const char*)g.A + (size_t)cur.pm * tstep; const char* cB = (const char*)g.Bt + (size_t)cur.pn * tstep;
    S.a_ready(cur);
    if constexpr (SP2) {
        PG8_STAGE(PG8_SB(0, 0), cB, voffB); PG8_STAGE(PG8_SB(0, 1), cB + hstep, voffB); PG8_STAGE(PG8_SA(0, 0), cA, voffA); PG8_STAGE(PG8_SA(0, 1), cA + hstep, voffA);
        if (wr == 1) PG8_BAR;
        PG8_WAIT_V(2); PG8_BAR;
        PG8_STAGE(PG8_SB(1, 0), cB + kstep, voffB); PG8_STAGE(PG8_SA(1, 0), cA + kstep, voffA); PG8_STAGE(PG8_SB(1, 1), cB + hstep + kstep, voffB);
        PG8_WAIT_V(6); PG8_BAR;
    } else {
        PG8_STAGE(PG8_SB(0, 0), cB, voffB); PG8_STAGE(PG8_SA(0, 0), cA, voffA); PG8_STAGE(PG8_SB(0, 1), cB + hstep, voffB); PG8_STAGE(PG8_SA(0, 1), cA + hstep, voffA);
        if (wr == 1) PG8_BAR;
        PG8_WAIT_V(4); PG8_BAR;
        PG8_STAGE(PG8_SB(1, 0), cB + kstep, voffB); PG8_STAGE(PG8_SA(1, 0), cA + kstep, voffA); PG8_STAGE(PG8_SB(1, 1), cB + hstep + kstep, voffB);
        PG8_WAIT_V(6); PG8_BAR;
    }
    for (;;) {
        const bool has_next = S.next(ui + 1, nxt);
        const char* nA = has_next ? (const char*)g.A + (size_t)nxt.pm * tstep : cA; const char* nB = has_next ? (const char*)g.Bt + (size_t)nxt.pn * tstep : cB;
#pragma unroll 1
        for (int t = 0; t < nt; t += 2) {
            const bool last = (t == nt - 2);
            const char* a1 = cA + (size_t)(t + 1) * kstep;
            const char* a2 = last ? nA : cA + (size_t)(t + 2) * kstep; const char* b2 = last ? nB : cB + (size_t)(t + 2) * kstep;
            const char* a3 = a2 + kstep; const char* b3 = b2 + kstep;
            if (last && has_next) S.a_ready(nxt);
            if constexpr (SP2) {
            PG8_LDB(B0, 0, 0); PG8_LDB(B1, 0, 1); PG8_SCHED; PG8_LDA(At, 0, 0); PG8_STAGE(PG8_SA(1, 1), a1 + hstep, voffA);
            PG8_WAIT_V(8); PG8_WAIT_L(0); PG8_BAR; PG8_MMA(0, 0, At, B0); PG8_MMA(0, 1, At, B1); PG8_BAR; PG8_SCHED;
            PG8_LDA(At, 0, 1); PG8_STAGE(PG8_SB(0, 0), b2, voffB); PG8_STAGE(PG8_SB(0, 1), b2 + hstep, voffB); PG8_STAGE(PG8_SA(0, 0), a2, voffA);
            PG8_WAIT_V(8); PG8_WAIT_L(0); PG8_BAR; PG8_MMA(1, 0, At, B0); PG8_MMA(1, 1, At, B1); PG8_BAR; PG8_SCHED;
            PG8_LDB(B0, 1, 0); PG8_LDB(B1, 1, 1); PG8_SCHED; PG8_LDA(At, 1, 0); PG8_STAGE(PG8_SA(0, 1), a2 + hstep, voffA);
            PG8_WAIT_V(8); PG8_WAIT_L(0); PG8_BAR; PG8_MMA(0, 0, At, B0); PG8_MMA(0, 1, At, B1); PG8_BAR; PG8_SCHED;
            PG8_LDA(At, 1, 1); PG8_STAGE(PG8_SB(1, 0), b3, voffB); PG8_STAGE(PG8_SB(1, 1), b3 + hstep, voffB); PG8_STAGE(PG8_SA(1, 0), a3, voffA);
            PG8_WAIT_V(8); PG8_WAIT_L(0); PG8_BAR; PG8_MMA(1, 0, At, B0); PG8_MMA(1, 1, At, B1); PG8_BAR; PG8_SCHED;
            } else {
            PG8_LDB(B0, 0, 0); PG8_SCHED; PG8_LDA(At, 0, 0); PG8_STAGE(PG8_SA(1, 1), a1 + hstep, voffA);
            PG8_WAIT_L(8); PG8_BAR; PG8_WAIT_L(0); PG8_MMA(0, 0, At, B0); PG8_BAR; PG8_SCHED;
            PG8_LDB(B1, 0, 1); PG8_STAGE(PG8_SB(0, 0), b2, voffB);
            PG8_BAR; PG8_WAIT_L(0); PG8_MMA(0, 1, At, B1); PG8_BAR;
            PG8_LDA(At, 0, 1); PG8_STAGE(PG8_SA(0, 0), a2, voffA);
            PG8_BAR; PG8_WAIT_L(0); PG8_MMA(1, 0, At, B0); PG8_BAR; PG8_SCHED;
            PG8_STAGE(PG8_SB(0, 1), b2 + hstep, voffB);
            PG8_WAIT_V(6); PG8_BAR; PG8_MMA(1, 1, At, B1); PG8_BAR;
            PG8_LDB(B0, 1, 0); PG8_SCHED; PG8_LDA(At, 1, 0); PG8_STAGE(PG8_SA(0, 1), a2 + hstep, voffA);
            PG8_WAIT_L(8); PG8_BAR; PG8_WAIT_L(0); PG8_MMA(0, 0, At, B0); PG8_BAR; PG8_SCHED;
            PG8_LDB(B1, 1, 1); PG8_STAGE(PG8_SB(1, 0), b3, voffB);
            PG8_BAR; PG8_WAIT_L(0); PG8_MMA(0, 1, At, B1); PG8_BAR;
            PG8_LDA(At, 1, 1); PG8_STAGE(PG8_SA(1, 0), a3, voffA);
            PG8_BAR; PG8_WAIT_L(0); PG8_MMA(1, 0, At, B0); PG8_BAR; PG8_SCHED;
            PG8_STAGE(PG8_SB(1, 1), b3 + hstep, voffB);
            PG8_WAIT_V(6); PG8_BAR; PG8_MMA(1, 1, At, B1); PG8_BAR;
            }
        }
        if constexpr (ALIGN_EPI) { if (wr == 0) PG8_BAR; }
        if constexpr (!Epi::AFTER_DRAIN) { E(acc, cur, wr, wc, fr, fq); S.done(cur); }
        if (!has_next) break;
#pragma unroll
        for (int a = 0; a < 2; ++a)
#pragma unroll
            for (int b = 0; b < 2; ++b)
#pragma unroll
                for (int m = 0; m < 4; ++m)
#pragma unroll
                    for (int n = 0; n < 2; ++n) acc[a][b][m][n] = (f32x4){0.f, 0.f, 0.f, 0.f};
        cur = nxt; cA = nA; cB = nB; ++ui;
        if constexpr (ALIGN_EPI) { if (wr == 1) PG8_BAR; }
    }
    PG8_WAIT_V(0);
    if constexpr (!ALIGN_EPI) { if (wr == 0) PG8_BAR; }
    PG8_BAR;
    if constexpr (Epi::AFTER_DRAIN) { E.fused(acc, cur, wr, wc, fr, fq, lds, wid, lane); S.done(cur); }
#undef PG8_SA
#undef PG8_SB
#undef PG8_STAGE
#undef PG8_LDA
#undef PG8_LDB
#undef PG8_MMA
#undef PG8_WAIT_V
#undef PG8_WAIT_L
#undef PG8_BAR
#undef PG8_SCHED
}
}

#define LAS __attribute__((address_space(3)))
typedef unsigned short bf16_t;
typedef short bf16x8 __attribute__((ext_vector_type(8)));
typedef short s16x4 __attribute__((ext_vector_type(4)));
typedef float f32x4 __attribute__((ext_vector_type(4)));
typedef float f32x16 __attribute__((ext_vector_type(16)));
typedef unsigned u32x4 __attribute__((ext_vector_type(4)));
typedef unsigned u32x2 __attribute__((ext_vector_type(2)));

constexpr int NB = 8, SEQ = 4096, DM = 1024, CTXL = 256;
constexpr int ML = NB * SEQ, MC = NB * CTXL, MT = ML + MC;
constexpr int NIN = 3136, NINP = 3328, DFF = 2816, KVL = CTXL + SEQ;
constexpr int NCH = 68;
constexpr float EPS = 1e-6f;
constexpr size_t MiB = 1u << 20;
constexpr size_t WS_MOD = 0, WS_LBF = 256 * 1024, WS_LBB = 258 * 1024, WS_RCOS = 260 * 1024, WS_RSIN = 264 * 1024, WS_ROWSS = 512 * 1024;
constexpr size_t WS_WIN = 1 * MiB, WS_WUQ = 8 * MiB, WS_WUKV = 8 * MiB + 512 * 1024, WS_WOUT = 9 * MiB, WS_WGU = 11 * MiB, WS_WDN = 22 * MiB, WS_DG = 28 * MiB;
constexpr size_t WS_A = 32 * MiB;
constexpr size_t WS_CQ = 169 * MiB, WS_CKV = 186 * MiB, WS_HQ = 203 * MiB, WS_HI = 237 * MiB, WS_HG = 271 * MiB, WS_GF = 305 * MiB, WS_GB = 339 * MiB;
constexpr size_t WS_V = 373 * MiB, WS_MIX = 407 * MiB, WS_ACT = 169 * MiB, WS_RSSP = 471 * MiB, WS_BAR = 480 * MiB, WS_END = 481 * MiB;
constexpr int LDS_BYTES = 147456;

__device__ __forceinline__ unsigned f2bf(float f) { unsigned u = __builtin_bit_cast(unsigned, f); return (u + 0x7fffu + ((u >> 16) & 1u)) >> 16; }
__device__ __forceinline__ float bf2f(unsigned h) { return __builtin_bit_cast(float, h << 16); }
typedef __bf16 bf16v2_t __attribute__((ext_vector_type(2)));
__device__ __forceinline__ unsigned pk2(float lo, float hi) { bf16v2_t v; v.x = (__bf16)lo; v.y = (__bf16)hi; return __builtin_bit_cast(unsigned, v); }
__device__ __forceinline__ float wave_sum(float v) {
#pragma unroll
    for (int o = 1; o < 64; o <<= 1) v += __shfl_xor(v, o);
    return v;
}
__device__ __forceinline__ float sigmoidf_(float x) { return 1.f / (1.f + __expf(-x)); }
#define LDS_WAIT() asm volatile("s_waitcnt lgkmcnt(0)" ::: "memory")

struct Args {
    const float *x, *c, *ctx, *c_ctx, *w_mod, *b_mod, *g_mix, *g_ffn, *w_in, *g_qn, *w_uq, *g_kvn, *w_ukv, *lb_fwd, *lb_bwd, *g_on, *w_out, *w_gate, *w_up, *w_down, *g_final;
    float* out; unsigned char* ws; int ph_lo, ph_hi;
};

__device__ __forceinline__ void p0_mod_item(const Args& a, char* ldsc, int item) {
    float* sl = (float*)ldsc;
    float* red = sl + 9216;
    const int tid = threadIdx.x, wave = tid >> 6, lane = tid & 63;
    for (int i = tid; i < 9216; i += 512) { const float v = (i < 8192) ? a.c[i] : a.c_ctx[i - 8192]; sl[i] = v * sigmoidf_(v); }
    __syncthreads();
    float acc[9];
#pragma unroll
    for (int r = 0; r < 9; ++r) acc[r] = 0.f;
    const float* wp = a.w_mod + (size_t)(wave * 128) * 6144 + item * 64 + lane;
#pragma unroll 4
    for (int k = 0; k < 128; ++k) {
        const float w = wp[(size_t)k * 6144];
#pragma unroll
        for (int r = 0; r < 9; ++r) acc[r] += sl[r * 1024 + wave * 128 + k] * w;
    }
#pragma unroll
    for (int r = 0; r < 9; ++r) red[(wave * 9 + r) * 64 + lane] = acc[r];
    __syncthreads();
    float* MOD = (float*)(a.ws + WS_MOD);
    for (int i = tid; i < 576; i += 512) {
        const int r = i >> 6, l = i & 63; float s = 0.f;
#pragma unroll
        for (int w = 0; w < 8; ++w) s += red[(w * 9 + r) * 64 + l];
        MOD[r * 6144 + item * 64 + l] = s + a.b_mod[item * 64 + l];
    }
    __syncthreads();
}
__device__ __forceinline__ void p0_transpose_item(const float* W, int N, bf16_t* WT, int Kd, int drow0, const float* kscale, float* scr, int k0, int n0, int lane) {
#pragma unroll 8
    for (int i = 0; i < 32; ++i) { const int kk = 2 * i + (lane >> 5); float v = W[(size_t)(k0 + kk) * N + n0 + (lane & 31)]; if (kscale) v *= kscale[k0 + kk]; scr[kk * 33 + (lane & 31)] = v; }
    LDS_WAIT(); asm volatile("" ::: "memory");
    const int c = lane & 7;
#pragma unroll
    for (int j = 0; j < 4; ++j) { const int n = (lane >> 3) + 8 * j; const float* s = scr + (8 * c) * 33 + n;
        u32x4 o; o.x = pk2(s[0 * 33], s[1 * 33]); o.y = pk2(s[2 * 33], s[3 * 33]); o.z = pk2(s[4 * 33], s[5 * 33]); o.w = pk2(s[6 * 33], s[7 * 33]);
        *(u32x4*)(WT + (size_t)(drow0 + n) * Kd + k0 + 8 * c) = o; }
    LDS_WAIT(); asm volatile("" ::: "memory");
}
__device__ __forceinline__ void p0_prologue(const Args& a, char* ldsc, int G) {
    const int tid = threadIdx.x, wave = tid >> 6, lane = tid & 63;
    unsigned char* ws = a.ws;
    if (blockIdx.x < 96) p0_mod_item(a, ldsc, blockIdx.x);
    if ((int)blockIdx.x == G - 1) {
        float* LBF = (float*)(ws + WS_LBF); float* LBB = (float*)(ws + WS_LBB);
        LBF[tid] = 1.f / (1.f + __expf(a.lb_fwd[512 + tid] - a.lb_fwd[tid]));
        LBB[tid] = 1.f / (1.f + __expf(a.lb_bwd[512 + tid] - a.lb_bwd[tid]));
        float* RC = (float*)(ws + WS_RCOS); float* RS = (float*)(ws + WS_RSIN);
        for (int i = tid; i < 1024; i += 512) {
            const int pos = i >> 4, fi = i & 15;
            const float inv = exp2f(-(float)fi * (13.287712379549449f / 16.f));
            const float ang = (float)pos * inv;
            const float kq = rintf(ang * 0.15915494309189535f);
            float r = fmaf(-kq, 6.28125f, ang); r = fmaf(-kq, 0.0019353071795864769f, r);
            RC[i] = __cosf(r); RS[i] = __sinf(r);
        }
    }
    { u32x4* pz = (u32x4*)(ws + WS_WIN + (size_t)NIN * 1024 * 2); const u32x4 z = {0u, 0u, 0u, 0u};
      for (int i = blockIdx.x * 512 + tid; i < (NINP - NIN) * 1024 * 2 / 16; i += G * 512) pz[i] = z; }
    float* scr = (float*)(ldsc + wave * 16384);
    const int gw = blockIdx.x * 8 + wave, NGW = G * 8;
    constexpr int I_IN = 16 * 98, I_UQ = 4 * 24, I_UKV = 4 * 32, I_OUT = 16 * 32, I_G = 16 * 88, I_DN = 44 * 32;
    constexpr int NITEMS = I_IN + I_UQ + I_UKV + I_OUT + 2 * I_G + I_DN;
    for (int it = gw; it < NITEMS; it += NGW) {
        int r = it;
        if (r < I_IN) { const int kb = r / 98, nb = r % 98; p0_transpose_item(a.w_in, NIN, (bf16_t*)(ws + WS_WIN), 1024, 32 * nb, nullptr, scr, 64 * kb, 32 * nb, lane); continue; } r -= I_IN;
        if (r < I_UQ) { const int kb = r / 24, nb = r % 24; p0_transpose_item(a.w_uq, 768, (bf16_t*)(ws + WS_WUQ), 256, 32 * nb, a.g_qn, scr, 64 * kb, 32 * nb, lane); continue; } r -= I_UQ;
        if (r < I_UKV) { const int kb = r / 32, nb = r % 32; p0_transpose_item(a.w_ukv, 1024, (bf16_t*)(ws + WS_WUKV), 256, 32 * nb, a.g_kvn, scr, 64 * kb, 32 * nb, lane); continue; } r -= I_UKV;
        if (r < I_OUT) { const int kb = r / 32, nb = r % 32; p0_transpose_item(a.w_out, 1024, (bf16_t*)(ws + WS_WOUT), 1024, 32 * nb, nullptr, scr, 64 * kb, 32 * nb, lane); continue; } r -= I_OUT;
        if (r < 2 * I_G) { const int up = r >= I_G; if (up) r -= I_G; const int kb = r / 88, nb = r % 88, n0 = 32 * nb;
            const int drow = (n0 >> 7) * 256 + (n0 & 127) + (up ? 128 : 0);
            p0_transpose_item(up ? a.w_up : a.w_gate, DFF, (bf16_t*)(ws + WS_WGU), 1024, drow, nullptr, scr, 64 * kb, n0, lane); continue; } r -= 2 * I_G;
        { const int kb = r / 32, nb = r % 32; p0_transpose_item(a.w_down, 1024, (bf16_t*)(ws + WS_WDN), DFF, 32 * nb, nullptr, scr, 64 * kb, 32 * nb, lane); }
    }
}

template <int NR>
__device__ __forceinline__ void rows_norm_mod_bf16(const float* const (&src)[NR], const float* g, const float* const (&md)[NR], int shoff, bf16_t* const (&dst)[NR], const bool (&ok)[NR], int lane) {
    f32x4 v[NR][4]; float s[NR];
#pragma unroll
    for (int i = 0; i < NR; ++i) { s[i] = 0.f; if (ok[i]) {
#pragma unroll
        for (int j = 0; j < 4; ++j) v[i][j] = ((const f32x4*)src[i])[lane + 64 * j]; } }
#pragma unroll
    for (int i = 0; i < NR; ++i) if (ok[i]) {
#pragma unroll
        for (int j = 0; j < 4; ++j) s[i] += (v[i][j].x * v[i][j].x + v[i][j].y * v[i][j].y) + (v[i][j].z * v[i][j].z + v[i][j].w * v[i][j].w); }
#pragma unroll
    for (int o = 1; o < 64; o <<= 1) {
#pragma unroll
        for (int i = 0; i < NR; ++i) s[i] += __shfl_xor(s[i], o); }
#pragma unroll
    for (int i = 0; i < NR; ++i) if (ok[i]) {
        const float rstd = rsqrtf(s[i] * (1.f / 1024.f) + EPS);
        u32x2* o8 = (u32x2*)dst[i] + lane;
#pragma unroll
        for (int j = 0; j < 4; ++j) {
            const f32x4 gg = ((const f32x4*)g)[lane + 64 * j], s1 = ((const f32x4*)(md[i] + shoff + 1024))[lane + 64 * j], s0 = ((const f32x4*)(md[i] + shoff))[lane + 64 * j];
            const f32x4 y = v[i][j] * rstd * gg * (s1 + 1.f) + s0;
            u32x2 w; w.x = pk2(y.x, y.y); w.y = pk2(y.z, y.w); o8[64 * j] = w;
        }
    }
}
template <int NR>
__device__ __forceinline__ void rows_norm_mod_pre(const float* const (&src)[NR], const f32x4 (&A)[4], const f32x4 (&B)[4], bf16_t* const (&dst)[NR], int lane) {
    f32x4 v[NR][4]; float s[NR];
#pragma unroll
    for (int i = 0; i < NR; ++i) { s[i] = 0.f;
#pragma unroll
        for (int j = 0; j < 4; ++j) v[i][j] = ((const f32x4*)src[i])[lane + 64 * j]; }
#pragma unroll
    for (int i = 0; i < NR; ++i) {
#pragma unroll
        for (int j = 0; j < 4; ++j) s[i] += (v[i][j].x * v[i][j].x + v[i][j].y * v[i][j].y) + (v[i][j].z * v[i][j].z + v[i][j].w * v[i][j].w); }
#pragma unroll
    for (int o = 1; o < 64; o <<= 1) {
#pragma unroll
        for (int i = 0; i < NR; ++i) s[i] += __shfl_xor(s[i], o); }
#pragma unroll
    for (int i = 0; i < NR; ++i) {
        const float rstd = rsqrtf(s[i] * (1.f / 1024.f) + EPS);
        u32x2* o8 = (u32x2*)dst[i] + lane;
#pragma unroll
        for (int j = 0; j < 4; ++j) { const f32x4 y = v[i][j] * rstd * A[j] + B[j]; u32x2 w; w.x = pk2(y.x, y.y); w.y = pk2(y.z, y.w); o8[64 * j] = w; }
    }
}
__device__ __forceinline__ void load_mod_params(const float* g, const float* md, int shoff, f32x4 (&A)[4], f32x4 (&B)[4], int lane) {
#pragma unroll
    for (int j = 0; j < 4; ++j) { const f32x4 gg = ((const f32x4*)g)[lane + 64 * j], s1 = ((const f32x4*)(md + shoff + 1024))[lane + 64 * j]; A[j] = gg * (s1 + 1.f); B[j] = ((const f32x4*)(md + shoff))[lane + 64 * j]; }
}
template <int NR>
__device__ __forceinline__ void rows_norm_f32(float* const (&row)[NR], const float* g, int lane) {
    f32x4 v[NR][4]; float s[NR];
#pragma unroll
    for (int i = 0; i < NR; ++i) { s[i] = 0.f;
#pragma unroll
        for (int j = 0; j < 4; ++j) v[i][j] = ((const f32x4*)row[i])[lane + 64 * j]; }
#pragma unroll
    for (int i = 0; i < NR; ++i) {
#pragma unroll
        for (int j = 0; j < 4; ++j) s[i] += (v[i][j].x * v[i][j].x + v[i][j].y * v[i][j].y) + (v[i][j].z * v[i][j].z + v[i][j].w * v[i][j].w); }
#pragma unroll
    for (int o = 1; o < 64; o <<= 1) {
#pragma unroll
        for (int i = 0; i < NR; ++i) s[i] += __shfl_xor(s[i], o); }
#pragma unroll
    for (int i = 0; i < NR; ++i) {
        const float rstd = rsqrtf(s[i] * (1.f / 1024.f) + EPS);
#pragma unroll
        for (int j = 0; j < 4; ++j) { f32x4 o = v[i][j] * rstd * ((const f32x4*)g)[lane + 64 * j];
#ifdef SANITIZE
            o.x = __builtin_isfinite(o.x) ? o.x : 1000.f; o.y = __builtin_isfinite(o.y) ? o.y : 1000.f; o.z = __builtin_isfinite(o.z) ? o.z : 1000.f; o.w = __builtin_isfinite(o.w) ? o.w : 1000.f;
#endif
            ((f32x4*)row[i])[lane + 64 * j] = o; }
    }
}

__device__ __forceinline__ void rope8(float (&v)[8], int fq, const float* rc, const float* rs, int pos, bool apply) {
    const int ib = pos * 16 + 8 * (fq & 1);
#pragma unroll
    for (int e = 0; e < 8; ++e) {
        const float partner = __shfl_xor(v[e], 32);
        const float cs = rc[ib + e], sn = rs[ib + e];
        const float r = (fq < 2) ? (v[e] * cs - partner * sn) : (v[e] * cs + partner * sn);
        v[e] = apply ? r : v[e];
    }
}
__device__ __forceinline__ u32x4 pack8(const float (&v)[8]) { u32x4 w; w.x = pk2(v[0], v[1]); w.y = pk2(v[2], v[3]); w.z = pk2(v[4], v[5]); w.w = pk2(v[6], v[7]); return w; }

struct EpiInProj {
    static constexpr bool PERM = true, AFTER_DRAIN = false;
    unsigned char* ws; bf16_t* Kb;
    __device__ __forceinline__ void operator()(const pg8::f32x4 (&acc)[2][2][4][2], const pg8::Unit& u, int wr, int wc, int fr, int fq) const {
        float* RSS = (float*)(ws + WS_RSSP); const float* RC = (const float*)(ws + WS_RCOS); const float* RS = (const float*)(ws + WS_RSIN);
#pragma unroll
        for (int bj = 0; bj < 2; ++bj) {
            const int cbase = u.pn * 256 + bj * 128 + wc * 32;
            if (cbase >= NIN) continue;
            const int c0 = cbase + 8 * fq;
#pragma unroll
            for (int ai = 0; ai < 2; ++ai)
#pragma unroll
                for (int m = 0; m < 4; ++m) {
                    const int row = u.pm * 256 + ai * 128 + wr * 64 + m * 16 + fr;
                    float v[8];
#pragma unroll
                    for (int e = 0; e < 4; ++e) { v[e] = acc[ai][bj][m][0][e]; v[4 + e] = acc[ai][bj][m][1][e]; }
                    if (cbase < 512) {
                        bf16_t* dst = (bf16_t*)(ws + WS_CQ + (cbase < 256 ? (size_t)0 : (WS_CKV - WS_CQ))) + (size_t)row * 256 + (c0 & 255);
                        *(u32x4*)dst = pack8(v);
                        float ss = 0.f;
#pragma unroll
                        for (int e = 0; e < 8; ++e) ss += v[e] * v[e];
                        ss += __shfl_xor(ss, 16); ss += __shfl_xor(ss, 32);
                        if (fq == 0) RSS[((size_t)row * 2 + (cbase < 256 ? 0 : 1)) * 8 + bj * 4 + wc] = ss;
                    } else if (cbase < 576) {
                        const int axis = (cbase - 512) >> 5;
                        const bool lat = row < ML;
                        const int n = row & 4095;
                        const int pos = axis ? (n & 63) : (n >> 6);
                        rope8(v, fq, RC, RS, lat ? pos : 0, lat);
                        const int b = lat ? (row >> 12) : ((row - ML) >> 8);
                        const int kvpos = lat ? (CTXL + n) : ((row - ML) & 255);
                        const u32x4 w = pack8(v);
#pragma unroll
                        for (int h = 0; h < 4; ++h) *(u32x4*)(Kb + ((size_t)(b * 4 + h) * KVL + kvpos) * 192 + 128 + axis * 32 + 8 * fq) = w;
                    } else if (cbase < 2112) {
                        const int seg = (cbase - 576) >> 9;
                        bf16_t* base = (bf16_t*)(ws + WS_HQ + (size_t)seg * (WS_HI - WS_HQ));
                        *(u32x4*)(base + (size_t)row * 512 + (c0 - 576 - seg * 512)) = pack8(v);
                    } else {
                        const int dirn = (cbase - 2112) >> 9, j = c0 - 2112 - dirn * 512;
                        const float* lbp = (const float*)(ws + WS_LBF + (size_t)dirn * (WS_LBB - WS_LBF)) + j;
                        typedef _Float16 h8 __attribute__((ext_vector_type(8)));
                        h8 o;
#pragma unroll
                        for (int e = 0; e < 8; ++e) { const float lb = lbp[e]; const float f = lb + (1.f - lb) * sigmoidf_(v[e]); o[e] = (_Float16)__logf(f); }
                        *(h8*)((_Float16*)(ws + WS_GF + (size_t)dirn * (WS_GB - WS_GF)) + (size_t)row * 512 + j) = o;
                    }
                }
        }
    }
};
struct EpiQ {
    static constexpr bool PERM = true, AFTER_DRAIN = false;
    bf16_t* Q; const float* RSS; const float *RC, *RS;
    __device__ __forceinline__ void operator()(const pg8::f32x4 (&acc)[2][2][4][2], const pg8::Unit& u, int wr, int wc, int fr, int fq) const {
#pragma unroll
        for (int bj = 0; bj < 2; ++bj) {
            const int cbase = u.pn * 256 + bj * 128 + wc * 32;
            const int h = cbase / 192, d0 = cbase - h * 192;
            const bool rope = d0 >= 128; const int axis = (d0 - 128) >> 5;
#pragma unroll
            for (int ai = 0; ai < 2; ++ai)
#pragma unroll
                for (int m = 0; m < 4; ++m) {
                    const int row = u.pm * 256 + ai * 128 + wr * 64 + m * 16 + fr;
                    const f32x4 s0 = *(const f32x4*)(RSS + (size_t)row * 16), s1 = *(const f32x4*)(RSS + (size_t)row * 16 + 4);
                    const float rstd = rsqrtf((((s0.x + s0.y) + (s0.z + s0.w)) + ((s1.x + s1.y) + (s1.z + s1.w))) * (1.f / 256.f) + EPS);
                    float v[8];
#pragma unroll
                    for (int e = 0; e < 4; ++e) { v[e] = acc[ai][bj][m][0][e] * rstd; v[4 + e] = acc[ai][bj][m][1][e] * rstd; }
                    const int b = row >> 12, n = row & 4095;
                    if (rope) { const int pos = axis ? (n & 63) : (n >> 6); rope8(v, fq, RC, RS, pos, true); }
                    *(u32x4*)(Q + ((size_t)(b * 4 + h) * SEQ + n) * 192 + d0 + 8 * fq) = pack8(v);
                    asm volatile("" ::: "memory");
                }
        }
    }
};
struct EpiKV {
    static constexpr bool PERM = true, AFTER_DRAIN = false;
    bf16_t *Kb, *Vb; const float* RSS;
    __device__ __forceinline__ void operator()(const pg8::f32x4 (&acc)[2][2][4][2], const pg8::Unit& u, int wr, int wc, int fr, int fq) const {
#pragma unroll
        for (int bj = 0; bj < 2; ++bj) {
            const int cbase = u.pn * 256 + bj * 128 + wc * 32;
            const int h = cbase >> 8, j0 = cbase & 255;
#pragma unroll
            for (int ai = 0; ai < 2; ++ai)
#pragma unroll
                for (int m = 0; m < 4; ++m) {
                    const int row = u.pm * 256 + ai * 128 + wr * 64 + m * 16 + fr;
                    const f32x4 s0 = *(const f32x4*)(RSS + (size_t)row * 16 + 8), s1 = *(const f32x4*)(RSS + (size_t)row * 16 + 12);
                    const float rstd = rsqrtf((((s0.x + s0.y) + (s0.z + s0.w)) + ((s1.x + s1.y) + (s1.z + s1.w))) * (1.f / 256.f) + EPS);
                    float v[8];
#pragma unroll
                    for (int e = 0; e < 4; ++e) { v[e] = acc[ai][bj][m][0][e] * rstd; v[4 + e] = acc[ai][bj][m][1][e] * rstd; }
                    const bool lat = row < ML;
                    const int b = lat ? (row >> 12) : ((row - ML) >> 8);
                    const int kvpos = lat ? (CTXL + (row & 4095)) : ((row - ML) & 255);
                    const size_t r = (size_t)(b * 4 + h) * KVL + kvpos;
                    if (j0 < 128) *(u32x4*)(Kb + r * 192 + j0 + 8 * fq) = pack8(v);
                    else          *(u32x4*)(Vb + r * 128 + (j0 - 128) + 8 * fq) = pack8(v);
                    asm volatile("" ::: "memory");
                }
        }
    }
};
struct EpiRes {
    static constexpr bool PERM = false, AFTER_DRAIN = false;
    const float* base; float* out; const float* gate;
    __device__ __forceinline__ void operator()(const pg8::f32x4 (&acc)[2][2][4][2], const pg8::Unit& u, int wr, int wc, int fr, int fq) const {
#pragma unroll
        for (int ai = 0; ai < 2; ++ai)
#pragma unroll
            for (int m = 0; m < 4; ++m) {
                const int row = u.pm * 256 + ai * 128 + wr * 64 + m * 16 + fr;
                const float* gp = gate + (size_t)(row >> 12) * 6144;
#pragma unroll
                for (int bj = 0; bj < 2; ++bj)
#pragma unroll
                    for (int n = 0; n < 2; ++n) {
                        const int c = u.pn * 256 + bj * 128 + wc * 32 + 16 * n + 4 * fq;
                        const f32x4 g = *(const f32x4*)(gp + c), bs = *(const f32x4*)(base + (size_t)row * 1024 + c);
                        const pg8::f32x4 a4 = acc[ai][bj][m][n];
                        f32x4 o; o.x = bs.x + g.x * a4[0]; o.y = bs.y + g.y * a4[1]; o.z = bs.z + g.z * a4[2]; o.w = bs.w + g.w * a4[3];
                        *(f32x4*)(out + (size_t)row * 1024 + c) = o;
                    }
            }
    }
};
struct EpiSwiglu {
    static constexpr bool PERM = true, AFTER_DRAIN = false;
    bf16_t* ACT;
    __device__ __forceinline__ void operator()(const pg8::f32x4 (&acc)[2][2][4][2], const pg8::Unit& u, int wr, int wc, int fr, int fq) const {
#pragma unroll
        for (int ai = 0; ai < 2; ++ai)
#pragma unroll
            for (int m = 0; m < 4; ++m) {
                const int row = u.pm * 256 + ai * 128 + wr * 64 + m * 16 + fr;
                float v[8];
#pragma unroll
                for (int n = 0; n < 2; ++n)
#pragma unroll
                    for (int e = 0; e < 4; ++e) { const float g = acc[ai][0][m][n][e], uu = acc[ai][1][m][n][e]; v[4 * n + e] = g * sigmoidf_(g) * uu; }
                *(u32x4*)(ACT + (size_t)row * DFF + u.pn * 128 + wc * 32 + 8 * fq) = pack8(v);
            }
    }
};

#ifndef ATT_QREG
#define ATT_QREG 2
#endif
namespace att {
constexpr int NW = 8, QBLK = 32, KVBLK = 64;
constexpr float SCALE = 0.07216878364870322f;
constexpr float THR = 8.f;
constexpr int LDQ = 192, LDK = 192, LDV = 128, LDO = 1024;
constexpr int SHM_V = KVBLK * 128 * 2, SHM_K = KVBLK * 512, SHM_ATTN = 2 * SHM_V + 2 * SHM_K;
static_assert(SHM_ATTN <= 163840, "attention LDS");
#define KSWZ(row, colB) ((row) * 512 + ((colB) ^ (((((row) & 7) | ((((row) >> 4) & 1) << 3))) << 4)))
#define SBAR() __builtin_amdgcn_sched_barrier(0)
__device__ __forceinline__ int crow(int r, int hi) { return (r & 3) + 8 * (r >> 2) + 4 * hi; }
__device__ __forceinline__ unsigned cvtpk(float lo, float hi) { return pk2(lo, hi); }
__device__ __forceinline__ void partialSM(f32x16& p0, f32x16& p1, float& m_reg, float& mn, float& alpha) {
  constexpr float C = SCALE * 1.4426950408889634f;
  float pmax = p0[0];
#pragma unroll
  for (int r = 1; r < 16; ++r) pmax = fmaxf(pmax, p0[r]);
#pragma unroll
  for (int r = 0; r < 16; ++r) pmax = fmaxf(pmax, p1[r]);
  { auto rr = __builtin_amdgcn_permlane32_swap(__float_as_uint(pmax), __float_as_uint(pmax), false, false);
    pmax = fmaxf(__uint_as_float(rr[0]), __uint_as_float(rr[1])); }
  if (__builtin_expect(__all(pmax - m_reg <= THR / SCALE), 1)) { mn = m_reg; alpha = 1.f; }
  else { mn = fmaxf(m_reg, pmax); alpha = __builtin_amdgcn_exp2f((m_reg - mn) * C); m_reg = mn; }
  float mnC = -mn * C;
#pragma unroll
  for (int r = 0; r < 16; ++r) p0[r] = fmaf(p0[r], C, mnC);
#pragma unroll
  for (int r = 0; r < 16; ++r) p1[r] = fmaf(p1[r], C, mnC);
#pragma unroll
  for (int r = 0; r < 16; ++r) p0[r] = __builtin_amdgcn_exp2f(p0[r]);
}
__device__ __forceinline__ void finishSM(f32x16& p0, f32x16& p1, float alpha, float& l_reg, bf16x8& pa0, bf16x8& pa1, bf16x8& pa2, bf16x8& pa3) {
#pragma unroll
  for (int r = 0; r < 16; ++r) p1[r] = __builtin_amdgcn_exp2f(p1[r]);
  float ps = 0;
#pragma unroll
  for (int r = 0; r < 16; ++r) ps += p0[r];
#pragma unroll
  for (int r = 0; r < 16; ++r) ps += p1[r];
  { auto rr = __builtin_amdgcn_permlane32_swap(__float_as_uint(ps), __float_as_uint(ps), false, false);
    ps = __uint_as_float(rr[0]) + __uint_as_float(rr[1]); }
  l_reg = l_reg * alpha + ps;
#define PK4(P, BASE, OUT) do { unsigned a0 = cvtpk(P[BASE + 0], P[BASE + 1]), a1 = cvtpk(P[BASE + 2], P[BASE + 3]);   \
    unsigned b0 = cvtpk(P[BASE + 4], P[BASE + 5]), b1 = cvtpk(P[BASE + 6], P[BASE + 7]);                              \
    auto r0 = __builtin_amdgcn_permlane32_swap(a0, b0, false, false); auto r1 = __builtin_amdgcn_permlane32_swap(a1, b1, false, false); \
    u32x4 w = {r0[0], r1[0], r0[1], r1[1]}; OUT = *reinterpret_cast<bf16x8*>(&w); } while (0)
  PK4(p0, 0, pa0); PK4(p0, 8, pa1); PK4(p1, 0, pa2); PK4(p1, 8, pa3);
#undef PK4
}
__device__ __forceinline__ void qkt(f32x16& p0, f32x16& p1, const char* Ks, const bf16x8* qr, int r32, int hi) {
  p0 = f32x16{}; p1 = f32x16{};
  bf16x8 kf0[3], kf1[3];
#define QKT_LD(d0) do { const int cb_ = ((d0) * 16 + hi * 8) * 2; kf0[(d0) % 3] = *reinterpret_cast<const bf16x8*>(Ks + KSWZ(r32, cb_)); kf1[(d0) % 3] = *reinterpret_cast<const bf16x8*>(Ks + KSWZ(32 + r32, cb_)); } while (0)
  QKT_LD(0); QKT_LD(1);
  __builtin_amdgcn_sched_barrier(0);
#pragma unroll
  for (int d0 = 0; d0 < 12; ++d0) {
    if (d0 + 2 < 12) QKT_LD(d0 + 2);
    __builtin_amdgcn_sched_barrier(0);
    p0 = __builtin_amdgcn_mfma_f32_32x32x16_bf16(kf0[d0 % 3], qr[d0], p0, 0, 0, 0);
    p1 = __builtin_amdgcn_mfma_f32_32x32x16_bf16(kf1[d0 % 3], qr[d0], p1, 0, 0, 0);
    __builtin_amdgcn_sched_barrier(0);
  }
#undef QKT_LD
}
__device__ __forceinline__ int v_st(int k, int c) { const int kk = (k & ~0xC) | ((k & 4) << 1) | ((k & 8) >> 1); return ((kk >> 3) * 4 + (c >> 5)) * 512 + ((kk & 7) * 32 + (c & 31)) * 2; }
__device__ __forceinline__ int v_rd_base(int lane) { return ((lane & 3) << 3) | (((lane >> 2) & 3) << 6) | (((lane >> 4) & 1) << 5) | (((lane >> 5) & 1) << 8); }
constexpr int v_rd_off(int d0, int ks, int half) { return d0 * 512 + ks * 4096 + half * 2048; }
template <int OFF> __device__ __forceinline__ s16x4 tr_read(int vb) {
  s16x4 r; asm volatile("ds_read_b64_tr_b16 %0, %1 offset:%2" : "=&v"(r) : "v"(vb), "i"(OFF) : "memory"); return r;
}
template <int D0> __device__ __forceinline__ void pv_one(f32x16& od, int vb, bf16x8 pa0, bf16x8 pa1, bf16x8 pa2, bf16x8 pa3) {
  const s16x4 l0 = tr_read<v_rd_off(D0, 0, 0)>(vb), h0 = tr_read<v_rd_off(D0, 0, 1)>(vb), l1 = tr_read<v_rd_off(D0, 1, 0)>(vb), h1 = tr_read<v_rd_off(D0, 1, 1)>(vb);
  const s16x4 l2 = tr_read<v_rd_off(D0, 2, 0)>(vb), h2 = tr_read<v_rd_off(D0, 2, 1)>(vb), l3 = tr_read<v_rd_off(D0, 3, 0)>(vb), h3 = tr_read<v_rd_off(D0, 3, 1)>(vb);
  asm volatile("s_waitcnt lgkmcnt(0)" ::: "memory"); SBAR();
#define PK(L, H) (bf16x8){L[0], L[1], L[2], L[3], H[0], H[1], H[2], H[3]}
  od = __builtin_amdgcn_mfma_f32_32x32x16_bf16(pa0, PK(l0, h0), od, 0, 0, 0);
  od = __builtin_amdgcn_mfma_f32_32x32x16_bf16(pa1, PK(l1, h1), od, 0, 0, 0);
  od = __builtin_amdgcn_mfma_f32_32x32x16_bf16(pa2, PK(l2, h2), od, 0, 0, 0);
  od = __builtin_amdgcn_mfma_f32_32x32x16_bf16(pa3, PK(l3, h3), od, 0, 0, 0);
#undef PK
}
__device__ __forceinline__ void pv_d0(f32x16* o, int vb, bf16x8 pa0, bf16x8 pa1, bf16x8 pa2, bf16x8 pa3) {
  pv_one<0>(o[0], vb, pa0, pa1, pa2, pa3); pv_one<1>(o[1], vb, pa0, pa1, pa2, pa3); pv_one<2>(o[2], vb, pa0, pa1, pa2, pa3); pv_one<3>(o[3], vb, pa0, pa1, pa2, pa3);
}
__device__ __forceinline__ void attn_body(const bf16_t* __restrict__ Qb, const bf16_t* __restrict__ Kh, const bf16_t* __restrict__ Vh, bf16_t* __restrict__ Ob, int seq, char* lds) {
  const int tid = threadIdx.x, wid = tid >> 6, lane = tid & 63, r32 = lane & 31, hi = lane >> 5;
  char* V_lds = lds; char* K_lds = lds + 2 * SHM_V;
  float m_reg = -1e30f, l_reg = 0; f32x16 o[4] = {}; bf16x8 qr[12];
  const bf16_t* Qw = Qb + (long)(wid * QBLK + r32) * LDQ + hi * 8;
#pragma unroll
  for (int d0 = 0; d0 < 12; ++d0) qr[d0] = *reinterpret_cast<const bf16x8*>(Qw + d0 * 16);
  const int sr = tid >> 4, sc = (tid & 15) * 8, vst0 = v_st(sr, sc), vst1 = v_st(32 + sr, sc);
  const int kid0 = tid, kid1 = tid + 512, kid2 = tid + 1024;
  const int kr0 = kid0 / 24, kc0 = kid0 % 24, kr1 = kid1 / 24, kc1 = kid1 % 24, kr2 = kid2 / 24, kc2 = kid2 % 24;
  const int kg0 = kr0 * LDK + kc0 * 8, kg1 = kr1 * LDK + kc1 * 8, kg2 = kr2 * LDK + kc2 * 8;
  const int kl0 = KSWZ(kr0, kc0 * 16), kl1 = KSWZ(kr1, kc1 * 16), kl2 = KSWZ(kr2, kc2 * 16);
  const int vb0 = (int)(uintptr_t)V_lds + v_rd_base(lane);
  bf16x8 sA_v0, sA_v1, sA_k0, sA_k1, sA_k2;
#define SLOADA(k0) do { sA_v0 = *(const bf16x8*)&Vh[(long)((k0) + sr) * LDV + sc]; sA_v1 = *(const bf16x8*)&Vh[(long)((k0) + 32 + sr) * LDV + sc]; \
    sA_k0 = *(const bf16x8*)&Kh[(long)(k0) * LDK + kg0]; sA_k1 = *(const bf16x8*)&Kh[(long)(k0) * LDK + kg1]; sA_k2 = *(const bf16x8*)&Kh[(long)(k0) * LDK + kg2]; } while (0)
#define SWRITEA(b) do { *(bf16x8*)(V_lds + (b) * SHM_V + vst0) = sA_v0; *(bf16x8*)(V_lds + (b) * SHM_V + vst1) = sA_v1; \
    *(bf16x8*)(K_lds + (b) * SHM_K + kl0) = sA_k0; *(bf16x8*)(K_lds + (b) * SHM_K + kl1) = sA_k1; *(bf16x8*)(K_lds + (b) * SHM_K + kl2) = sA_k2; } while (0)
#define SWAIT() asm volatile("s_waitcnt vmcnt(0)" ::: "memory")
#define RESC(a) do { if (__any((a) < 1.f)) { \
    _Pragma("unroll") for (int r = 0; r < 16; ++r) { const float al_ = __shfl((a), crow(r, hi)); _Pragma("unroll") for (int d = 0; d < 4; ++d) o[d][r] *= al_; } } } while (0)
  const int NT = seq / KVBLK;
  SLOADA(0); SWAIT(); SWRITEA(0); __syncthreads();
#pragma unroll 1
  for (int j = 0; j < NT; ++j) {
    const int b = j & 1;
    if (j + 1 < NT) SLOADA((j + 1) * KVBLK);
    f32x16 p0, p1; float mn, al; bf16x8 pa0, pa1, pa2, pa3;
    SBAR(); qkt(p0, p1, K_lds + b * SHM_K, qr, r32, hi);
    partialSM(p0, p1, m_reg, mn, al);
    RESC(al);
    finishSM(p0, p1, al, l_reg, pa0, pa1, pa2, pa3); SBAR();
    pv_d0(o, vb0 + b * SHM_V, pa0, pa1, pa2, pa3);
    if (j + 1 < NT) { SWAIT(); SWRITEA(b ^ 1); }
    __syncthreads();
  }
  float rli[16];
#pragma unroll
  for (int r = 0; r < 16; ++r) rli[r] = __builtin_amdgcn_rcpf(__shfl(l_reg, crow(r, hi)));
  bf16_t* Ow = Ob + (long)(wid * QBLK) * LDO;
#pragma unroll
  for (int r = 0; r < 16; ++r) { int orow = crow(r, hi);
#pragma unroll
    for (int d0 = 0; d0 < 4; ++d0) Ow[(long)orow * LDO + d0 * 32 + r32] = (bf16_t)f2bf(o[d0][r] * rli[r]); }
  asm volatile("s_waitcnt vmcnt(0)" ::: "memory");
  __syncthreads();
#undef SLOADA
#undef SWRITEA
#undef SWAIT
#undef RESC
}
}

__device__ __forceinline__ int hgrn_chunk_row0(int dir, int b, int p) {
    if (p < 4) return ML + b * CTXL + 64 * (dir ? 3 - p : p);
    return b * SEQ + 64 * (dir ? 63 - (p - 4) : p - 4);
}
__device__ __forceinline__ void passA_ptrs(const Args& a, int item, int& dir, int& bh, int& p, size_t& goff) {
    dir = item / (32 * NCH); const int rem = item % (32 * NCH); bh = rem / NCH; p = rem % NCH;
    const int row0 = hgrn_chunk_row0(dir, bh >> 2, p);
    goff = (size_t)row0 * 512 + (bh & 3) * 128;
}
__device__ __forceinline__ void passA_load(const Args& a, int item, int k, int qd, unsigned (&graw)[16], unsigned (&vraw)[16]) {
    int dir, bh, p; size_t goff; passA_ptrs(a, item, dir, bh, p, goff);
    const unsigned short* G = (const unsigned short*)(a.ws + (dir ? WS_GB : WS_GF)) + goff;
    const bf16_t* Vp = (const bf16_t*)(a.ws + WS_HI) + goff;
#pragma unroll
    for (int i = 0; i < 16; ++i) { graw[i] = G[(size_t)(16 * qd + i) * 512 + k]; vraw[i] = Vp[(size_t)(16 * qd + i) * 512 + k]; }
}
__device__ __forceinline__ void hgrn_passA_loop(const Args& a, char* lds, int G_) {
    const int tid = threadIdx.x, wave = tid >> 6, lane = tid & 63, r32 = lane & 31, hi = lane >> 5;
    char* Kt = lds; char* Vt = lds + 128 * 144; float* qt = (float*)(lds + 2 * 128 * 144);
    const int k = tid & 127, qd = tid >> 7;
    constexpr int NIT = 2 * 32 * NCH;
    unsigned graw[16], vraw[16];
    if ((int)blockIdx.x < NIT) passA_load(a, blockIdx.x, k, qd, graw, vraw);
    for (int item = blockIdx.x; item < NIT; item += G_) {
        int dir, bh, p; size_t goff; passA_ptrs(a, item, dir, bh, p, goff);
        float gv[16], bl[16];
#pragma unroll
        for (int i = 0; i < 16; ++i) gv[i] = (float)__builtin_bit_cast(_Float16, (unsigned short)graw[i]);
        float run = 0.f;
        if (dir == 0) {
#pragma unroll
            for (int i = 0; i < 16; ++i) { run += gv[i]; bl[i] = run; }
        } else {
#pragma unroll
            for (int i = 15; i >= 0; --i) { run += gv[i]; bl[i] = run; }
        }
        qt[qd * 128 + k] = run;
        __syncthreads();
        const float q0 = qt[k], q1 = qt[128 + k], q2 = qt[256 + k], q3 = qt[384 + k];
        const float tot = (q0 + q1) + (q2 + q3);
        float off;
        if (dir == 0) off = (qd > 0 ? q0 : 0.f) + (qd > 1 ? q1 : 0.f) + (qd > 2 ? q2 : 0.f);
        else          off = (qd < 3 ? q3 : 0.f) + (qd < 2 ? q2 : 0.f) + (qd < 1 ? q1 : 0.f);
        unsigned short* Gw = (unsigned short*)(a.ws + (dir ? WS_GB : WS_GF)) + goff;
        unsigned kw[8], vw[8];
#pragma unroll
        for (int i = 0; i < 16; ++i) { bl[i] += off; Gw[(size_t)(16 * qd + i) * 512 + k] = (unsigned short)fminf(65535.f, rintf(bl[i] * -1024.f)); }
#pragma unroll
        for (int i = 0; i < 8; ++i) {
            const float k0 = (1.f - __expf(gv[2 * i])) * __expf(tot - bl[2 * i]), k1 = (1.f - __expf(gv[2 * i + 1])) * __expf(tot - bl[2 * i + 1]);
            kw[i] = pk2(k0, k1);
            vw[i] = vraw[2 * i] | (vraw[2 * i + 1] << 16);
        }
        *(u32x4*)(Kt + k * 144 + qd * 32) = (u32x4){kw[0], kw[1], kw[2], kw[3]}; *(u32x4*)(Kt + k * 144 + qd * 32 + 16) = (u32x4){kw[4], kw[5], kw[6], kw[7]};
        *(u32x4*)(Vt + k * 144 + qd * 32) = (u32x4){vw[0], vw[1], vw[2], vw[3]}; *(u32x4*)(Vt + k * 144 + qd * 32 + 16) = (u32x4){vw[4], vw[5], vw[6], vw[7]};
        const size_t slot = (size_t)(dir * 32 + bh) * NCH + p;
        if (qd == 0) ((float*)(a.ws + WS_DG))[slot * 128 + k] = __expf(tot);
        if (item + G_ < NIT) passA_load(a, item + G_, k, qd, graw, vraw);
        __syncthreads();
        const int kb = wave >> 1, vb0 = (wave & 1) * 2;
        f32x16 acc0 = {}, acc1 = {};
#pragma unroll
        for (int ks = 0; ks < 4; ++ks) {
            const bf16x8 af = *(const bf16x8*)(Kt + (32 * kb + r32) * 144 + ks * 32 + hi * 16);
            const bf16x8 b0 = *(const bf16x8*)(Vt + (32 * vb0 + r32) * 144 + ks * 32 + hi * 16);
            const bf16x8 b1 = *(const bf16x8*)(Vt + (32 * (vb0 + 1) + r32) * 144 + ks * 32 + hi * 16);
            acc0 = __builtin_amdgcn_mfma_f32_32x32x16_bf16(af, b0, acc0, 0, 0, 0);
            acc1 = __builtin_amdgcn_mfma_f32_32x32x16_bf16(af, b1, acc1, 0, 0, 0);
        }
        bf16_t* Lt = (bf16_t*)(a.ws + WS_A) + slot * 16384;
        char* Ls = lds + 40960;
#pragma unroll
        for (int rg = 0; rg < 4; ++rg) {
            const int k4 = 32 * kb + 8 * rg + 4 * hi;
            u32x2 w0, w1; w0.x = pk2(acc0[4 * rg], acc0[4 * rg + 1]); w0.y = pk2(acc0[4 * rg + 2], acc0[4 * rg + 3]);
            w1.x = pk2(acc1[4 * rg], acc1[4 * rg + 1]); w1.y = pk2(acc1[4 * rg + 2], acc1[4 * rg + 3]);
            *(u32x2*)(Ls + (32 * vb0 + r32) * 272 + k4 * 2) = w0;
            *(u32x2*)(Ls + (32 * (vb0 + 1) + r32) * 272 + k4 * 2) = w1;
        }
        __syncthreads();
#pragma unroll
        for (int i = 0; i < 4; ++i) { const int id = tid + 512 * i; *(u32x4*)(Lt + (size_t)(id >> 4) * 128 + (id & 15) * 8) = *(const u32x4*)(Ls + (id >> 4) * 272 + (id & 15) * 16); }
        __syncthreads();
    }
}
__device__ __forceinline__ void hgrn_passB(const Args& a, int G) {
    bf16_t* LS = (bf16_t*)(a.ws + WS_A); const float* DG = (const float*)(a.ws + WS_DG);
    for (int it = blockIdx.x * 512 + threadIdx.x; it < 64 * 2048; it += G * 512) {
        const int dbh = it >> 11, e8 = it & 2047, k0 = (e8 & 15) * 8;
        bf16_t* base = LS + (size_t)dbh * NCH * 16384 + e8 * 8; const float* dp = DG + (size_t)dbh * NCH * 128 + k0;
        float S[8];
#pragma unroll
        for (int e = 0; e < 8; ++e) S[e] = 0.f;
#pragma unroll 4
        for (int p = 0; p < NCH; ++p) {
            const u32x4 L = *(const u32x4*)(base + (size_t)p * 16384);
            const f32x4 d0 = *(const f32x4*)(dp + p * 128), d1 = *(const f32x4*)(dp + p * 128 + 4);
            if (p >= 4) { u32x4 w; w.x = pk2(S[0], S[1]); w.y = pk2(S[2], S[3]); w.z = pk2(S[4], S[5]); w.w = pk2(S[6], S[7]); *(u32x4*)(base + (size_t)p * 16384) = w; }
            S[0] = d0.x * S[0] + bf2f(L.x & 0xffffu); S[1] = d0.y * S[1] + bf2f(L.x >> 16);
            S[2] = d0.z * S[2] + bf2f(L.y & 0xffffu); S[3] = d0.w * S[3] + bf2f(L.y >> 16);
            S[4] = d1.x * S[4] + bf2f(L.z & 0xffffu); S[5] = d1.y * S[5] + bf2f(L.z >> 16);
            S[6] = d1.z * S[6] + bf2f(L.w & 0xffffu); S[7] = d1.w * S[7] + bf2f(L.w >> 16);
        }
    }
}
__device__ __forceinline__ float b16f(unsigned v) { return (float)v * (-1.f / 1024.f); }
__device__ __forceinline__ unsigned u16at(const u32x4 (&v)[2], int e) { const unsigned w = v[e >> 3][(e & 7) >> 1]; return (e & 1) ? (w >> 16) : (w & 0xffffu); }
struct PassCDir { u32x4 bt[2], bn[2], br[2], S[4]; };
__device__ __forceinline__ void passC_load_dir(const Args& a, int dir, int bh, int lc, int row0, int h, int tok, int ks, int tid, PassCDir& D) {
    const unsigned short* B = (const unsigned short*)(a.ws + (dir ? WS_GB : WS_GF)) + (size_t)row0 * 512 + h * 128 + ks;
    const int nb = dir ? (tok < 63 ? tok + 1 : 63) : (tok > 0 ? tok - 1 : 0), rf = dir ? 32 : 31;
    D.bt[0] = *(const u32x4*)(B + (size_t)tok * 512); D.bt[1] = *(const u32x4*)(B + (size_t)tok * 512 + 8);
    D.bn[0] = *(const u32x4*)(B + (size_t)nb * 512);  D.bn[1] = *(const u32x4*)(B + (size_t)nb * 512 + 8);
    D.br[0] = *(const u32x4*)(B + (size_t)rf * 512);  D.br[1] = *(const u32x4*)(B + (size_t)rf * 512 + 8);
    const int p = dir ? 4 + 63 - lc : 4 + lc;
    const u32x4* Sg = (const u32x4*)((const bf16_t*)(a.ws + WS_A) + ((size_t)(dir * 32 + bh) * NCH + p) * 16384);
#pragma unroll
    for (int i = 0; i < 4; ++i) D.S[i] = Sg[tid + 512 * i];
}
__device__ __forceinline__ void passC_ops(const PassCDir& D, bool has_nb, const u32x4 (&q)[2], char* St, char* Qd, char* Qd2, char* Kd2, int tok, int ks, int tid) {
    float qd_[16], qd2_[16], kd2_[16];
#pragma unroll
    for (int e = 0; e < 16; ++e) {
        const float b = b16f(u16at(D.bt, e)), nbv = has_nb ? b16f(u16at(D.bn, e)) : 0.f, bref = b16f(u16at(D.br, e));
        const float g = b - nbv, d = b - bref, qv = bf2f(u16at(q, e));
        qd_[e] = qv * __expf(b); qd2_[e] = qv * __expf(d); kd2_[e] = (1.f - __expf(g)) * __expf(-d);
    }
#pragma unroll
    for (int hlf = 0; hlf < 2; ++hlf) {
        u32x4 w;
        w.x = pk2(qd_[8 * hlf + 0], qd_[8 * hlf + 1]); w.y = pk2(qd_[8 * hlf + 2], qd_[8 * hlf + 3]); w.z = pk2(qd_[8 * hlf + 4], qd_[8 * hlf + 5]); w.w = pk2(qd_[8 * hlf + 6], qd_[8 * hlf + 7]);
        *(u32x4*)(Qd + tok * 272 + ks * 2 + hlf * 16) = w;
        w.x = pk2(qd2_[8 * hlf + 0], qd2_[8 * hlf + 1]); w.y = pk2(qd2_[8 * hlf + 2], qd2_[8 * hlf + 3]); w.z = pk2(qd2_[8 * hlf + 4], qd2_[8 * hlf + 5]); w.w = pk2(qd2_[8 * hlf + 6], qd2_[8 * hlf + 7]);
        *(u32x4*)(Qd2 + tok * 272 + ks * 2 + hlf * 16) = w;
        w.x = pk2(kd2_[8 * hlf + 0], kd2_[8 * hlf + 1]); w.y = pk2(kd2_[8 * hlf + 2], kd2_[8 * hlf + 3]); w.z = pk2(kd2_[8 * hlf + 4], kd2_[8 * hlf + 5]); w.w = pk2(kd2_[8 * hlf + 6], kd2_[8 * hlf + 7]);
        *(u32x4*)(Kd2 + tok * 272 + ks * 2 + hlf * 16) = w;
    }
#pragma unroll
    for (int i = 0; i < 4; ++i) { const int id = tid + 512 * i; *(u32x4*)(St + (id >> 4) * 272 + (id & 15) * 16) = D.S[i]; }
}
__device__ __forceinline__ void passC_mma1(f32x16& o, int dir, const char* St, const char* Qd, const char* Qd2, const char* Kd2, char* Pb, int wave, int r32, int hi) {
    const int rb = wave >> 2, cb = wave & 3, tr = (wave & 3) >> 1, tc = wave & 1;
    f32x16 pacc = {};
#pragma unroll
    for (int kk = 0; kk < 8; ++kk) {
        const bf16x8 af = *(const bf16x8*)(Qd + (32 * rb + r32) * 272 + kk * 32 + hi * 16);
        const bf16x8 bf = *(const bf16x8*)(St + (32 * cb + r32) * 272 + kk * 32 + hi * 16);
        o = __builtin_amdgcn_mfma_f32_32x32x16_bf16(af, bf, o, 0, 0, 0);
        const bf16x8 a2 = *(const bf16x8*)(Qd2 + (32 * tr + r32) * 272 + kk * 32 + hi * 16);
        const bf16x8 b2 = *(const bf16x8*)(Kd2 + (32 * tc + r32) * 272 + kk * 32 + hi * 16);
        pacc = __builtin_amdgcn_mfma_f32_32x32x16_bf16(a2, b2, pacc, 0, 0, 0);
    }
    if (wave < 4) {
#pragma unroll
        for (int r = 0; r < 16; ++r) {
            const int t = 32 * tr + att::crow(r, hi), s_ = 32 * tc + r32;
            const bool keep = dir ? (s_ >= t) : (s_ <= t);
            *(bf16_t*)(Pb + t * 144 + s_ * 2) = (bf16_t)f2bf(keep ? pacc[r] : 0.f);
        }
    }
}
__device__ __forceinline__ void passC_mma2(f32x16& o, const char* Pb, const char* Vt, int wave, int r32, int hi) {
    const int rb = wave >> 2, cb = wave & 3;
#pragma unroll
    for (int ks = 0; ks < 4; ++ks) {
        const bf16x8 af = *(const bf16x8*)(Pb + (32 * rb + r32) * 144 + ks * 32 + hi * 16);
        const bf16x8 bf = *(const bf16x8*)(Vt + (32 * cb + r32) * 144 + ks * 32 + hi * 16);
        o = __builtin_amdgcn_mfma_f32_32x32x16_bf16(af, bf, o, 0, 0, 0);
    }
}
__device__ __forceinline__ void hgrn_passC(const Args& a, char* lds, int item) {
    const int tid = threadIdx.x, wave = tid >> 6, lane = tid & 63, r32 = lane & 31, hi = lane >> 5;
    const int bh = item >> 6, lc = item & 63, b = bh >> 2, h = bh & 3;
    const int row0 = b * SEQ + 64 * lc;
    char* St = lds; char* Qd = lds + 34816; char* Qd2 = lds + 52224; char* Kd2 = lds + 69632; char* Vt = lds + 87040; char* Pb = lds + 105472; float* Os = (float*)(lds + 34816);
    const int tok = tid >> 3, ks = (tid & 7) * 16;
    const size_t roff = (size_t)(row0 + tok) * 512 + h * 128 + ks;
    u32x4 q[2], vv[2], hg[2];
    { const bf16_t* Qp = (const bf16_t*)(a.ws + WS_HQ) + roff; q[0] = *(const u32x4*)Qp; q[1] = *(const u32x4*)(Qp + 8);
      const bf16_t* Vp = (const bf16_t*)(a.ws + WS_HI) + roff; vv[0] = *(const u32x4*)Vp; vv[1] = *(const u32x4*)(Vp + 8);
      const bf16_t* Hp = (const bf16_t*)(a.ws + WS_HG) + roff; hg[0] = *(const u32x4*)Hp; hg[1] = *(const u32x4*)(Hp + 8); }
    PassCDir D0, D1;
    passC_load_dir(a, 0, bh, lc, row0, h, tok, ks, tid, D0);
    passC_load_dir(a, 1, bh, lc, row0, h, tok, ks, tid, D1);
#pragma unroll
    for (int e = 0; e < 16; ++e) *(bf16_t*)(Vt + (ks + e) * 144 + tok * 2) = (bf16_t)u16at(vv, e);
    passC_ops(D0, tok > 0, q, St, Qd, Qd2, Kd2, tok, ks, tid);
    __syncthreads();
    f32x16 o = {};
    passC_mma1(o, 0, St, Qd, Qd2, Kd2, Pb, wave, r32, hi);
    __syncthreads();
    passC_mma2(o, Pb, Vt, wave, r32, hi);
    passC_ops(D1, tok < 63, q, St, Qd, Qd2, Kd2, tok, ks, tid);
    __syncthreads();
    passC_mma1(o, 1, St, Qd, Qd2, Kd2, Pb, wave, r32, hi);
    __syncthreads();
    passC_mma2(o, Pb, Vt, wave, r32, hi);
    {
        const int rb = wave >> 2, cb = wave & 3;
#pragma unroll
        for (int r = 0; r < 16; ++r) Os[(32 * rb + att::crow(r, hi)) * 128 + 32 * cb + r32] = o[r];
    }
    __syncthreads();
    {
        float ov[16]; float ss = 0.f;
#pragma unroll
        for (int e = 0; e < 16; ++e) { ov[e] = Os[tok * 128 + ks + e]; ss += ov[e] * ov[e]; }
        ss += __shfl_xor(ss, 1); ss += __shfl_xor(ss, 2); ss += __shfl_xor(ss, 4);
        const float rstd = rsqrtf(ss * (1.f / 128.f) + EPS);
        float res[16];
#pragma unroll
        for (int e = 0; e < 16; ++e) { const float hv = bf2f(u16at(hg, e)); res[e] = ov[e] * rstd * a.g_on[ks + e] * (hv * sigmoidf_(hv)); }
        bf16_t* Mx = (bf16_t*)(a.ws + WS_MIX) + (size_t)(row0 + tok) * 1024 + 512 + h * 128 + ks;
        u32x4 w;
        w.x = pk2(res[0], res[1]); w.y = pk2(res[2], res[3]); w.z = pk2(res[4], res[5]); w.w = pk2(res[6], res[7]); *(u32x4*)Mx = w;
        w.x = pk2(res[8], res[9]); w.y = pk2(res[10], res[11]); w.z = pk2(res[12], res[13]); w.w = pk2(res[14], res[15]); *(u32x4*)(Mx + 8) = w;
    }
    __syncthreads();
}

#define XB_TMO      128
#define XB_XCNT(j)  (256  + 64 * (j))
#define XB_XSUB(j)  (1280 + 64 * (j))
#define XB_XGEN(j)  (2304 + 64 * (j))
#define XB_TOP      3328
#define XB_TOPGEN   3392
#define XCD_BAR_WORDS 3456
#define XB_SPIN_CAP (1u << 18)

__device__ __forceinline__ unsigned xb_ld(unsigned* p)              { return __hip_atomic_load(p, __ATOMIC_RELAXED, __HIP_MEMORY_SCOPE_AGENT); }
__device__ __forceinline__ unsigned xb_add(unsigned* p, unsigned v) { return __hip_atomic_fetch_add(p, v, __ATOMIC_RELAXED, __HIP_MEMORY_SCOPE_AGENT); }
__device__ __forceinline__ unsigned xb_xcc_id() { return (unsigned)__builtin_amdgcn_s_getreg((3 << 11) | 20) & 0xFu; }
#define XB_SPIN(cond, bar) do { unsigned _sp = 0; while (cond) { __builtin_amdgcn_s_sleep(1); \
    if ((++_sp & 255u) == 0u) { if (xb_ld(&(bar)[XB_TMO])) break; if (_sp > XB_SPIN_CAP) { atomicAdd(&(bar)[XB_TMO], 1u); break; } } } } while (0)

struct XcdBarrier {
    unsigned* bar; unsigned x;
    volatile LAS unsigned* st;
};

__device__ __forceinline__ XcdBarrier xcd_barrier_post(unsigned* bar, volatile LAS unsigned* st) {
    XcdBarrier b; b.bar = bar; b.x = xb_xcc_id(); b.st = st;
    if (threadIdx.x == 0) (void)xb_add(&bar[XB_XCNT(b.x)], 1u);
    return b;
}
__device__ __forceinline__ void xcd_barrier_complete(unsigned* bar, unsigned x, unsigned& nloc, unsigned& nx) {
    const unsigned G = gridDim.x * gridDim.y * gridDim.z;
    unsigned sum, cnt, mine, sp = 0u;
    for (;;) {
        sum = 0u; cnt = 0u; mine = 0u;
#pragma unroll
        for (unsigned j = 0; j < 16; ++j) { const unsigned c = xb_ld(&bar[XB_XCNT(j)]); sum += c; cnt += (c > 0u) ? 1u : 0u; mine = (j == x) ? c : mine; }
        if (sum == G) break;
        __builtin_amdgcn_s_sleep(1);
        if ((++sp & 255u) == 0u) { if (xb_ld(&bar[XB_TMO])) break; if (sp > XB_SPIN_CAP) { atomicAdd(&bar[XB_TMO], 1u); break; } }
    }
    nloc = mine > 0u ? mine : 1u; nx = cnt > 0u ? cnt : 1u;
}

__device__ __forceinline__ void xcd_barrier(const XcdBarrier& b) {
    asm volatile("s_waitcnt vmcnt(0)" ::: "memory");
    __syncthreads();
    if (threadIdx.x == 0) {
        unsigned* bar = b.bar;
        __builtin_amdgcn_s_waitcnt(0);
        unsigned nloc = b.st[0], nx = b.st[1];
        if (nloc == 0u) { xcd_barrier_complete(bar, b.x, nloc, nx); b.st[0] = nloc; b.st[1] = nx; }
        const unsigned old = xb_add(&bar[XB_XSUB(b.x)], 1u);
        const unsigned gen = old / nloc;
        if (old + 1u == (gen + 1u) * nloc) {
            __builtin_amdgcn_fence(__ATOMIC_RELEASE, "agent");
            asm volatile("s_waitcnt vmcnt(0)" ::: "memory");
            const unsigned og = xb_add(&bar[XB_TOP], 1u);
            const unsigned tg = og / nx;
            if (og + 1u == (tg + 1u) * nx) xb_add(&bar[XB_TOPGEN], 1u);
            else XB_SPIN(xb_ld(&bar[XB_TOPGEN]) == tg, bar);
            __builtin_amdgcn_fence(__ATOMIC_ACQUIRE, "agent");
            xb_add(&bar[XB_XGEN(b.x)], 1u);
            asm volatile("s_waitcnt vmcnt(0)" ::: "memory");
        } else {
            XB_SPIN(xb_ld(&bar[XB_XGEN(b.x)]) == gen, bar);
            __builtin_amdgcn_fence(__ATOMIC_ACQUIRE, "agent");
            asm volatile("s_waitcnt vmcnt(0)" ::: "memory");
        }
    }
    __syncthreads();
}

__global__ void __launch_bounds__(512, 2) fwd_megakernel(Args a) {
    extern __shared__ __attribute__((aligned(16))) unsigned char lds[];
    cg::grid_group grid = cg::this_grid();
    const int tid = threadIdx.x, wave = __builtin_amdgcn_readfirstlane(tid >> 6), lane = tid & 63;
    const int G = gridDim.x;
    unsigned char* ws = a.ws;
    LAS unsigned char* ldsl = (LAS unsigned char*)lds;
    char* ldsc = (char*)lds;
    const int lo = a.ph_lo, hi = a.ph_hi;
#ifndef SKIPMASK
#define SKIPMASK 0
#endif
#ifndef REPMASK
#define REPMASK 0
#endif
#define REPN(k) (((REPMASK >> (k)) & 1) ? 2 : 1)
#define IN(k) (!((SKIPMASK >> (k)) & 1) && lo <= (k) && (k) < hi)
#define SEAM(k) do { if (lo <= (k) && (k) + 1 < hi) { xcd_barrier(xbar); } } while (0)
    volatile LAS unsigned* xst = (volatile LAS unsigned*)(ldsl + LDS_BYTES - 16);
    if (tid < 4) xst[tid] = 0u;
    __syncthreads();
    XcdBarrier xbar; xbar.bar = (unsigned*)(ws + WS_BAR); xbar.x = 0; xbar.st = xst;
    if (hi - lo > 1) xbar = xcd_barrier_post((unsigned*)(ws + WS_BAR), xst);
    if (lo < 0) grid.sync();
    float* MOD = (float*)(ws + WS_MOD);
    float* RSS = (float*)(ws + WS_RSSP);
    const float* RC = (const float*)(ws + WS_RCOS); const float* RS = (const float*)(ws + WS_RSIN);
    bf16_t* Hb = (bf16_t*)(ws + WS_A);
    bf16_t* Qb = (bf16_t*)a.out;
    bf16_t* Kb = (bf16_t*)((char*)a.out + 48 * MiB);
    bf16_t* Vb = (bf16_t*)(ws + WS_V);
    bf16_t* MIX = (bf16_t*)(ws + WS_MIX);
    const int gw = blockIdx.x * 8 + wave, NGW = G * 8;

    if (IN(0)) { p0_prologue(a, ldsc, G); }
    SEAM(0);
    if (IN(1)) {
        if (G == 256) {
            f32x4 A[4], B[4]; const int bb = gw >> 8, rw = gw & 255;
            load_mod_params(a.g_mix, MOD + (size_t)bb * 6144, 0, A, B, lane);
#pragma unroll 1
            for (int it = 0; it < 4; ++it) { const float* src[4]; bf16_t* dst[4];
#pragma unroll
                for (int i = 0; i < 4; ++i) { const int r = bb * 4096 + rw + 256 * (4 * it + i); src[i] = a.x + (size_t)r * 1024; dst[i] = Hb + (size_t)r * 1024; }
                rows_norm_mod_pre<4>(src, A, B, dst, lane); }
            load_mod_params(a.g_mix, MOD + (size_t)8 * 6144, 0, A, B, lane);
            { const float* src[1] = {a.ctx + (size_t)gw * 1024}; bf16_t* dst[1] = {Hb + (size_t)(ML + gw) * 1024}; rows_norm_mod_pre<1>(src, A, B, dst, lane); }
        } else
        for (int r0 = gw; r0 < MT; r0 += 4 * NGW) {
            const float* src[4]; const float* md[4]; bf16_t* dst[4]; bool ok[4];
#pragma unroll
            for (int i = 0; i < 4; ++i) { const int r = r0 + i * NGW; ok[i] = r < MT; const int rr = ok[i] ? r : r0; const bool lat = rr < ML;
                src[i] = lat ? a.x + (size_t)rr * 1024 : a.ctx + (size_t)(rr - ML) * 1024; md[i] = MOD + (size_t)(lat ? (rr >> 12) : 8) * 6144; dst[i] = Hb + (size_t)rr * 1024; }
            rows_norm_mod_bf16<4>(src, a.g_mix, md, 0, dst, ok, lane);
        }
    }
#ifdef ZERO_MIX
    if (IN(1)) { u32x4* mz = (u32x4*)(ws + WS_MIX); const u32x4 z = {0u, 0u, 0u, 0u}; for (size_t i = (size_t)blockIdx.x * 512 + tid; i < (size_t)ML * 1024 * 2 / 16; i += (size_t)G * 512) mz[i] = z; }
#endif
    SEAM(1);
    if (IN(2)) {
        pg8::Gemm g{Hb, (const bf16_t*)(ws + WS_WIN), MT, NINP, 1024}; pg8::StaticOrder S; S.init(MT, NINP, G, (int)blockIdx.x);
        EpiInProj E{ws, Kb};
        pg8::gemm_phase<EpiInProj, pg8::StaticOrder, true, true>(ldsl, g, S, E);
    }
    SEAM(2);
    if (IN(3)) {
#ifndef SKIP3A
        { pg8::Gemm g{(const bf16_t*)(ws + WS_CQ), (const bf16_t*)(ws + WS_WUQ), ML, 768, 256}; pg8::StaticOrder S; S.init(ML, 768, G, (int)blockIdx.x);
          EpiQ E{Qb, RSS, RC, RS};
          pg8::gemm_phase<EpiQ, pg8::StaticOrder, true, true>(ldsl, g, S, E); }
#endif
#ifndef SKIP3B
        { pg8::Gemm g{(const bf16_t*)(ws + WS_CKV), (const bf16_t*)(ws + WS_WUKV), MT, 1024, 256}; pg8::StaticOrder S; S.init(MT, 1024, G, (int)blockIdx.x);
          EpiKV E{Kb, Vb, RSS};
          pg8::gemm_phase<EpiKV, pg8::StaticOrder, true, true>(ldsl, g, S, E); }
#endif
#ifndef SKIP3C
        hgrn_passA_loop(a, ldsc, G);
#endif
    }
#ifdef EXPJ
    if (IN(3)) {
        const u32x4* srcA = (const u32x4*)(ws + EXPJ_A); const u32x4* srcB = (const u32x4*)(ws + EXPJ_B); u32x4* dst = (u32x4*)MIX;
        for (size_t i = (size_t)blockIdx.x * 512 + tid; i < (size_t)ML * 64; i += (size_t)G * 512) { const size_t r = i >> 6, c = i & 63; dst[r * 128 + c] = srcA[r * 64 + c]; dst[r * 128 + 64 + c] = srcB[r * 64 + c]; }
    }
#endif
    SEAM(3);
    if (IN(4)) { hgrn_passB(a, G); }
    SEAM(4);
    if (IN(5)) {
#ifndef SKIP5A
        for (int u = blockIdx.x; u < 512; u += G) {
            int bh, qb;
            if (G == 256) { const int xcd = blockIdx.x & 7, cu = blockIdx.x >> 3, i = u >> 8; bh = xcd * 4 + i * 2 + (cu >> 4); qb = cu & 15; }
            else { bh = u >> 4; qb = u & 15; }
            const int b = bh >> 2, h = bh & 3;
            att::attn_body(Qb + ((size_t)bh * SEQ + qb * 256) * 192, Kb + (size_t)bh * KVL * 192, Vb + (size_t)bh * KVL * 128,
                           MIX + ((size_t)b * SEQ + qb * 256) * 1024 + h * 128, KVL, ldsc);
        }
#endif
#ifndef SKIP5B
        for (int it = blockIdx.x; it < 2048; it += G) hgrn_passC(a, ldsc, it);
#endif
    }
#ifdef EXPM
    if (IN(5)) { const u32x4* src = (const u32x4*)(ws + WS_A); u32x4* dst = (u32x4*)MIX;
        for (size_t i = (size_t)blockIdx.x * 512 + tid; i < (size_t)ML * 128; i += (size_t)G * 512) dst[i] = src[i]; }
#endif
    SEAM(5);
    if (IN(6)) {
        pg8::Gemm g{MIX, (const bf16_t*)(ws + WS_WOUT), ML, 1024, 1024}; pg8::StaticOrder S; S.init(ML, 1024, G, (int)blockIdx.x);
        EpiRes E{a.x, a.out, MOD + 2048};
        pg8::gemm_phase<EpiRes, pg8::StaticOrder, true, true>(ldsl, g, S, E);
    }
    SEAM(6);
    if (IN(7)) {
        if (G == 256) {
            f32x4 A[4], B[4]; const int bb = gw >> 8, rw = gw & 255;
            load_mod_params(a.g_ffn, MOD + (size_t)bb * 6144, 3072, A, B, lane);
#pragma unroll 1
            for (int it = 0; it < 4; ++it) { const float* src[4]; bf16_t* dst[4];
#pragma unroll
                for (int i = 0; i < 4; ++i) { const int r = bb * 4096 + rw + 256 * (4 * it + i); src[i] = a.out + (size_t)r * 1024; dst[i] = Hb + (size_t)r * 1024; }
                rows_norm_mod_pre<4>(src, A, B, dst, lane); }
        } else
        for (int r0 = gw; r0 < ML; r0 += 4 * NGW) {
            const float* src[4]; const float* md[4]; bf16_t* dst[4]; bool ok[4];
#pragma unroll
            for (int i = 0; i < 4; ++i) { const int r = r0 + i * NGW; ok[i] = r < ML; const int rr = ok[i] ? r : r0;
                src[i] = a.out + (size_t)rr * 1024; md[i] = MOD + (size_t)(rr >> 12) * 6144; dst[i] = Hb + (size_t)rr * 1024; }
            rows_norm_mod_bf16<4>(src, a.g_ffn, md, 3072, dst, ok, lane);
        }
    }
    SEAM(7);
    if (IN(8)) {
        pg8::Gemm g{Hb, (const bf16_t*)(ws + WS_WGU), ML, 2 * DFF, 1024}; pg8::StaticOrder S; S.init(ML, 2 * DFF, G, (int)blockIdx.x);
        EpiSwiglu E{(bf16_t*)(ws + WS_ACT)};
        pg8::gemm_phase<EpiSwiglu, pg8::StaticOrder, true, true>(ldsl, g, S, E);
    }
    SEAM(8);
    if (IN(9)) {
        pg8::Gemm g{(const bf16_t*)(ws + WS_ACT), (const bf16_t*)(ws + WS_WDN), ML, 1024, DFF}; pg8::StaticOrder S; S.init(ML, 1024, G, (int)blockIdx.x);
        EpiRes E{a.out, a.out, MOD + 5120};
        pg8::gemm_phase<EpiRes, pg8::StaticOrder, true, true>(ldsl, g, S, E);
    }
    SEAM(9);
    if (IN(10)) {
        if (ML % (4 * NGW) == 0) { for (int r0 = gw; r0 < ML; r0 += 4 * NGW) { float* rows[4];
#pragma unroll
            for (int i = 0; i < 4; ++i) rows[i] = a.out + (size_t)(r0 + i * NGW) * 1024;
            rows_norm_f32<4>(rows, a.g_final, lane); } }
        else { for (int r = gw; r < ML; r += NGW) { float* rows[1] = {a.out + (size_t)r * 1024}; rows_norm_f32<1>(rows, a.g_final, lane); } }
    }
#ifdef EXTRA_SYNCS
    if (hi - lo > 5) { for (int i_ = 0; i_ < EXTRA_SYNCS; ++i_) grid.sync(); }
#endif
#ifdef PROBE_PHASE
    if (a.ph_lo == 11) {
        for (int u = blockIdx.x; u < 512; u += G) {
            int bh, qb;
            if (G == 256) { const int xcd = blockIdx.x & 7, cu = blockIdx.x >> 3, i = u >> 8; bh = xcd * 4 + i * 2 + (cu >> 4); qb = cu & 15; }
            else { bh = u >> 4; qb = u & 15; }
            const int b = bh >> 2, h = bh & 3;
            att::attn_body(Qb + ((size_t)bh * SEQ + qb * 256) * 192, Kb + (size_t)bh * KVL * 192, Vb + (size_t)bh * KVL * 128,
                           MIX + ((size_t)b * SEQ + qb * 256) * 1024 + h * 128, KVL, ldsc);
        }
    }
    if (a.ph_lo == 12) { for (int it = blockIdx.x; it < 2048; it += G) hgrn_passC(a, ldsc, it); }
    if (a.ph_lo == 13) { hgrn_passA_loop(a, ldsc, G); }
#endif
#undef IN
#undef SEAM
}

#ifndef PROBE_REPS
#define PROBE_REPS 1
#endif
#ifndef MK_PER_PHASE
#define MK_PER_PHASE 0
#endif
extern "C" void kernel_launch(void* const* d_in, const int* in_sizes, int n_in, void* d_out, int out_size, void* d_ws, size_t ws_size, hipStream_t stream) {
    static int grid = 0;
    if (grid == 0) {
        if (n_in != 21 || out_size != ML * DM || ws_size < WS_END) { fprintf(stderr, "kernel_launch: unexpected shapes (n_in %d out %d ws %zu)\n", n_in, out_size, ws_size); grid = -1; return; }
        int dev = 0, cus = 0, per_cu = 0;
        hipGetDevice(&dev); hipDeviceGetAttribute(&cus, hipDeviceAttributeMultiprocessorCount, dev);
        if (hipFuncSetAttribute((const void*)fwd_megakernel, hipFuncAttributeMaxDynamicSharedMemorySize, LDS_BYTES) != hipSuccess) { fprintf(stderr, "kernel_launch: hipFuncSetAttribute failed\n"); grid = -1; return; }
        if (hipOccupancyMaxActiveBlocksPerMultiprocessor(&per_cu, (const void*)fwd_megakernel, 512, LDS_BYTES) != hipSuccess || per_cu < 1) { fprintf(stderr, "kernel_launch: occupancy query says %d\n", per_cu); per_cu = 1; }
        (void)hipGetLastError();
        grid = cus * 1;
        fprintf(stderr, "kernel_launch: grid %d (per_cu %d)\n", grid, per_cu);
    }
    if (grid < 0) return;
    (void)hipMemsetAsync((char*)d_ws + WS_BAR, 0, 16384, stream);
    Args a{};
    const float** ap = (const float**)&a;
    for (int i = 0; i < 21; ++i) ap[i] = (const float*)d_in[i];
    a.out = (float*)d_out; a.ws = (unsigned char*)d_ws;
#if MK_PER_PHASE
    for (int ph = 0; ph < 11; ++ph) {
        a.ph_lo = ph; a.ph_hi = ph + 1;
        hipLaunchKernelGGL(fwd_megakernel, dim3(grid), dim3(512), LDS_BYTES, stream, a);
    }
#else
#ifdef PROBE_PHASE
    for (int pr_ = 0; pr_ < PROBE_REPS; ++pr_) { a.ph_lo = PROBE_PHASE; a.ph_hi = PROBE_PHASE + 1; hipLaunchKernelGGL(fwd_megakernel, dim3(grid), dim3(512), LDS_BYTES, stream, a); }
#endif
    a.ph_lo = 0; a.ph_hi = 11;
    void* args[] = {&a};
    hipError_t e = hipLaunchCooperativeKernel((const void*)fwd_megakernel, dim3(grid), dim3(512), args, LDS_BYTES, stream);
    if (e != hipSuccess) fprintf(stderr, "cooperative launch failed: %s (grid %d)\n", hipGetErrorString(e), grid);
#endif
}
```

```cpp
#include <hip/hip_runtime.h>
#include <hip/hip_cooperative_groups.h>
#include <hip/hip_bf16.h>
#include <cstdio>
#include <cstdint>
namespace cg = cooperative_groups;
namespace pg8 {
#define PG8_LAS __attribute__((address_space(3)))
typedef unsigned short bf16_t;
typedef short bf16x8 __attribute__((ext_vector_type(8)));
typedef float f32x4 __attribute__((ext_vector_type(4)));
typedef unsigned u32x4 __attribute__((ext_vector_type(4)));
constexpr int BM = 256, BK = 64, HALF = 128, HTB = HALF * BK * 2  , STAGE_BYTES = 8 * HTB, NXCD = 8, WGM = 8;

__host__ __device__ __forceinline__ int lds_byte(int r, int c) { const int st = (r >> 4) * 2 + (c >> 5), rr = r & 15, cc = c & 31, ob = rr * 64 + cc * 2; return st * 1024 + (ob ^ (((ob >> 9) & 1) << 5)); }
__host__ __device__ __forceinline__ void stage_rc(int b, int& R, int& C) { const int st = b / 1024, sb = b % 1024, swz = sb ^ (((sb >> 9) & 1) << 5); R = (st >> 1) * 16 + swz / 64; C = (st & 1) * 32 + (swz % 64) / 2; }
__host__ __device__ __forceinline__ int perm32(int rho) { const int n = rho >> 4, i = rho & 15; return 8 * (i >> 2) + 4 * n + (i & 3); }

struct Unit { int pm, pn; };
struct Gemm { const bf16_t* A; const bf16_t* Bt; int M, N, K; };

struct StaticOrder {
    int nM, nN, nwg, G, c;
    __host__ __device__ void init(int M, int N, int G_, int c_) { nM = M / BM; nN = N / BM; nwg = nM * nN; G = G_; c = c_; }
    __host__ __device__ bool next(int i, Unit& u) const {
        const long L = (long)i * G + c; if (L >= nwg) return false;
        int wgid = (int)L; { const int q = nwg / NXCD, r = nwg % NXCD, xcd = wgid % NXCD, off = wgid / NXCD; wgid = (xcd < r ? xcd * (q + 1) : r * (q + 1) + (xcd - r) * q) + off; }
        const int nig = WGM * nN, gid = wgid / nig, fm = gid * WGM, gsz = (nM - fm) < WGM ? (nM - fm) : WGM;
        u.pm = fm + ((wgid % nig) % gsz); u.pn = (wgid % nig) / gsz; return true;
    }
    __device__ __forceinline__ void a_ready(const Unit&) const {}
    __device__ __forceinline__ void done(const Unit&) const {}
};

__device__ __forceinline__ unsigned cvt_pk_bf16(float lo, float hi) { unsigned r; asm volatile("v_cvt_pk_bf16_f32 %0, %1, %2" : "=v"(r) : "v"(lo), "v"(hi)); return r; }
typedef float f32x2 __attribute__((ext_vector_type(2)));
template <class Epi, class Sched, bool ALIGN_EPI = false, bool SP2 = false>
__device__ __forceinline__ void gemm_phase(PG8_LAS unsigned char* lds, const Gemm g, const Sched& S, const Epi& E) {
    const int tid = threadIdx.x, wid = __builtin_amdgcn_readfirstlane(tid >> 6), lane = tid & 63, wr = wid >> 2, wc = wid & 3, fr = lane & 15, fq = lane >> 4;
    const int K = g.K, nt = K / BK;
    unsigned voffA[2], voffB[2];
#pragma unroll
    for (int i = 0; i < 2; ++i) { int R, C; stage_rc(tid * 16 + i * 8192, R, C); const int Rb = Epi::PERM ? ((R & ~31) + perm32(R & 31)) : R;
        voffA[i] = (unsigned)(R * K + C) * 2u; voffB[i] = (unsigned)(Rb * K + C) * 2u; }
    const size_t kstep = (size_t)(BK * 2);
    const size_t hstep = (size_t)HALF * K * 2;
    const size_t tstep = 2 * hstep;
    const unsigned ldsw = (unsigned)wid * 1024u;
    const int aoff = lds_byte(wr * 64 + fr, fq * 8), boff = lds_byte(wc * 32 + fr, fq * 8);
#define PG8_SA(b, h) (((b) * 2 + (h)) * HTB)
#define PG8_SB(b, h) ((4 + (b) * 2 + (h)) * HTB)
#define PG8_STAGE(bufoff, gbase, voff) do { _Pragma("unroll") for (int _i = 0; _i < 2; ++_i) \
        __builtin_amdgcn_global_load_lds((const unsigned*)((const char*)(gbase) + (voff)[_i]), (PG8_LAS unsigned*)(lds + (bufoff) + ldsw + _i * 8192), 16, 0, 0); } while (0)
#define PG8_LDA(dst, b, h) do { _Pragma("unroll") for (int m = 0; m < 4; ++m) _Pragma("unroll") for (int k = 0; k < 2; ++k) dst[m][k] = *(const PG8_LAS bf16x8*)(lds + PG8_SA(b, h) + aoff + m * 2048 + k * 1024); } while (0)
#define PG8_LDB(dst, b, h) do { _Pragma("unroll") for (int n = 0; n < 2; ++n) _Pragma("unroll") for (int k = 0; k < 2; ++k) dst[n][k] = *(const PG8_LAS bf16x8*)(lds + PG8_SB(b, h) + boff + n * 2048 + k * 1024); } while (0)
#define PG8_MMA(ai, bj, At, Bt) do { __builtin_amdgcn_s_setprio(1); _Pragma("unroll") for (int m = 0; m < 4; ++m) _Pragma("unroll") for (int n = 0; n < 2; ++n) _Pragma("unroll") for (int k = 0; k < 2; ++k) \
        acc[ai][bj][m][n] = __builtin_amdgcn_mfma_f32_16x16x32_bf16(Bt[n][k], At[m][k], acc[ai][bj][m][n], 0, 0, 0); __builtin_amdgcn_s_setprio(0); } while (0)
#define PG8_WAIT_V(n) asm volatile("s_waitcnt vmcnt(" #n ")" ::: "memory")
#define PG8_WAIT_L(n) asm volatile("s_waitcnt lgkmcnt(" #n ")" ::: "memory")
#define PG8_BAR __builtin_amdgcn_s_barrier()
#define PG8_SCHED __builtin_amdgcn_sched_barrier(0)
    Unit cur, nxt; int ui = 0;
    if (!S.next(0, cur)) return;
    f32x4 acc[2][2][4][2];
#pragma unroll
    for (int a = 0; a < 2; ++a)
#pragma unroll
        for (int b = 0; b < 2; ++b)
#pragma unroll
            for (int m = 0; m < 4; ++m)
#pragma unroll
                for (int n = 0; n < 2; ++n) acc[a][b][m][n] = (f32x4){0.f, 0.f, 0.f, 0.f};
    bf16x8 At[4][2], B0[2][2], B1[2][2];
    const char* cA = (const char*)g.A + (size_t)cur.pm * tstep; const char* cB = (const char*)g.Bt + (size_t)cur.pn * tstep;
    S.a_ready(cur);
    if constexpr (SP2) {
        PG8_STAGE(PG8_SB(0, 0), cB, voffB); PG8_STAGE(PG8_SB(0, 1), cB + hstep, voffB); PG8_STAGE(PG8_SA(0, 0), cA, voffA); PG8_STAGE(PG8_SA(0, 1), cA + hstep, voffA);
        if (wr == 1) PG8_BAR;
        PG8_WAIT_V(2); PG8_BAR;
        PG8_STAGE(PG8_SB(1, 0), cB + kstep, voffB); PG8_STAGE(PG8_SA(1, 0), cA + kstep, voffA); PG8_STAGE(PG8_SB(1, 1), cB + hstep + kstep, voffB);
        PG8_WAIT_V(6); PG8_BAR;
    } else {
        PG8_STAGE(PG8_SB(0, 0), cB, voffB); PG8_STAGE(PG8_SA(0, 0), cA, voffA); PG8_STAGE(PG8_SB(0, 1), cB + hstep, voffB); PG8_STAGE(PG8_SA(0, 1), cA + hstep, voffA);
        if (wr == 1) PG8_BAR;
        PG8_WAIT_V(4); PG8_BAR;
        PG8_STAGE(PG8_SB(1, 0), cB + kstep, voffB); PG8_STAGE(PG8_SA(1, 0), cA + kstep, voffA); PG8_STAGE(PG8_SB(1, 1), cB + hstep + kstep, voffB);
        PG8_WAIT_V(6); PG8_BAR;
    }
    for (;;) {
        const bool has_next = S.next(ui + 1, nxt);
        const char* nA = has_next ? (const char*)g.A + (size_t)nxt.pm * tstep : cA; const char* nB = has_next ? (const char*)g.Bt + (size_t)nxt.pn * tstep : cB;
#pragma unroll 1
        for (int t = 0; t < nt; t += 2) {
            const bool last = (t == nt - 2);
            const char* a1 = cA + (size_t)(t + 1) * kstep;
            const char* a2 = last ? nA : cA + (size_t)(t + 2) * kstep; const char* b2 = last ? nB : cB + (size_t)(t + 2) * kstep;
            const char* a3 = a2 + kstep; const char* b3 = b2 + kstep;
            if (last && has_next) S.a_ready(nxt);
            if constexpr (SP2) {
            PG8_LDB(B0, 0, 0); PG8_LDB(B1, 0, 1); PG8_SCHED; PG8_LDA(At, 0, 0); PG8_STAGE(PG8_SA(1, 1), a1 + hstep, voffA);
            PG8_WAIT_V(8); PG8_WAIT_L(0); PG8_BAR; PG8_MMA(0, 0, At, B0); PG8_MMA(0, 1, At, B1); PG8_BAR; PG8_SCHED;
            PG8_LDA(At, 0, 1); PG8_STAGE(PG8_SB(0, 0), b2, voffB); PG8_STAGE(PG8_SB(0, 1), b2 + hstep, voffB); PG8_STAGE(PG8_SA(0, 0), a2, voffA);
            PG8_WAIT_V(8); PG8_WAIT_L(0); PG8_BAR; PG8_MMA(1, 0, At, B0); PG8_MMA(1, 1, At, B1); PG8_BAR; PG8_SCHED;
            PG8_LDB(B0, 1, 0); PG8_LDB(B1, 1, 1); PG8_SCHED; PG8_LDA(At, 1, 0); PG8_STAGE(PG8_SA(0, 1), a2 + hstep, voffA);
            PG8_WAIT_V(8); PG8_WAIT_L(0); PG8_BAR; PG8_MMA(0, 0, At, B0); PG8_MMA(0, 1, At, B1); PG8_BAR; PG8_SCHED;
            PG8_LDA(At, 1, 1); PG8_STAGE(PG8_SB(1, 0), b3, voffB); PG8_STAGE(PG8_SB(1, 1), b3 + hstep, voffB); PG8_STAGE(PG8_SA(1, 0), a3, voffA);
            PG8_WAIT_V(8); PG8_WAIT_L(0); PG8_BAR; PG8_MMA(1, 0, At, B0); PG8_MMA(1, 1, At, B1); PG8_BAR; PG8_SCHED;
            } else {
            PG8_LDB(B0, 0, 0); PG8_SCHED; PG8_LDA(At, 0, 0); PG8_STAGE(PG8_SA(1, 1), a1 + hstep, voffA);
            PG8_WAIT_L(8); PG8_BAR; PG8_WAIT_L(0); PG8_MMA(0, 0, At, B0); PG8_BAR; PG8_SCHED;
            PG8_LDB(B1, 0, 1); PG8_STAGE(PG8_SB(0, 0), b2, voffB);
            PG8_BAR; PG8_WAIT_L(0); PG8_MMA(0, 1, At, B1); PG8_BAR;
            PG8_LDA(At, 0, 1); PG8_STAGE(PG8_SA(0, 0), a2, voffA);
            PG8_BAR; PG8_WAIT_L(0); PG8_MMA(1, 0, At, B0); PG8_BAR; PG8_SCHED;
            PG8_STAGE(PG8_SB(0, 1), b2 + hstep, voffB);
            PG8_WAIT_V(6); PG8_BAR; PG8_MMA(1, 1, At, B1); PG8_BAR;
            PG8_LDB(B0, 1, 0); PG8_SCHED; PG8_LDA(At, 1, 0); PG8_STAGE(PG8_SA(0, 1), a2 + hstep, voffA);
            PG8_WAIT_L(8); PG8_BAR; PG8_WAIT_L(0); PG8_MMA(0, 0, At, B0); PG8_BAR; PG8_SCHED;
            PG8_LDB(B1, 1, 1); PG8_STAGE(PG8_SB(1, 0), b3, voffB);
            PG8_BAR; PG8_WAIT_L(0); PG8_MMA(0, 1, At, B1); PG8_BAR;
            PG8_LDA(At, 1, 1); PG8_STAGE(PG8_SA(1, 0), a3, voffA);
            PG8_BAR; PG8_WAIT_L(0); PG8_MMA(1, 0, At, B0); PG8_BAR; PG8_SCHED;
            PG8_STAGE(PG8_SB(1, 1), b3 + hstep, voffB);
            PG8_WAIT_V(6); PG8_BAR; PG8_MMA(1, 1, At, B1); PG8_BAR;
            }
        }
        if constexpr (ALIGN_EPI) { if (wr == 0) PG8_BAR; }
        if constexpr (!Epi::AFTER_DRAIN) { E(acc, cur, wr, wc, fr, fq); S.done(cur); }
        if (!has_next) break;
#pragma unroll
        for (int a = 0; a < 2; ++a)
#pragma unroll
            for (int b = 0; b < 2; ++b)
#pragma unroll
                for (int m = 0; m < 4; ++m)
#pragma unroll
                    for (int n = 0; n < 2; ++n) acc[a][b][m][n] = (f32x4){0.f, 0.f, 0.f, 0.f};
        cur = nxt; cA = nA; cB = nB; ++ui;
        if constexpr (ALIGN_EPI) { if (wr == 1) PG8_BAR; }
    }
    PG8_WAIT_V(0);
    if constexpr (!ALIGN_EPI) { if (wr == 0) PG8_BAR; }
    PG8_BAR;
    if constexpr (Epi::AFTER_DRAIN) { E.fused(acc, cur, wr, wc, fr, fq, lds, wid, lane); S.done(cur); }
#undef PG8_SA
#undef PG8_SB
#undef PG8_STAGE
#undef PG8_LDA
#undef PG8_LDB
#undef PG8_MMA
#undef PG8_WAIT_V
#undef PG8_WAIT_L
#undef PG8_BAR
#undef PG8_SCHED
}
}

#define LAS __attribute__((address_space(3)))
typedef unsigned short bf16_t;
typedef short bf16x8 __attribute__((ext_vector_type(8)));
typedef short s16x4 __attribute__((ext_vector_type(4)));
typedef float f32x4 __attribute__((ext_vector_type(4)));
typedef float f32x16 __attribute__((ext_vector_type(16)));
typedef unsigned u32x4 __attribute__((ext_vector_type(4)));
typedef unsigned u32x2 __attribute__((ext_vector_type(2)));

constexpr int NB = 8, SEQ = 4096, DM = 1024, CTXL = 256;
constexpr int ML = NB * SEQ, MC = NB * CTXL, MT = ML + MC;
constexpr int NIN = 3136, NINP = 3328, DFF = 2816, KVL = CTXL + SEQ;
constexpr int NCH = 68;
constexpr float EPS = 1e-6f;
constexpr size_t MiB = 1u << 20;
constexpr size_t WS_MOD = 0, WS_LBF = 256 * 1024, WS_LBB = 258 * 1024, WS_RCOS = 260 * 1024, WS_RSIN = 264 * 1024, WS_ROWSS = 512 * 1024;
constexpr size_t WS_WIN = 1 * MiB, WS_WUQ = 8 * MiB, WS_WUKV = 8 * MiB + 768 * 256 * 2, WS_WOUT = 9 * MiB, WS_WGU = 11 * MiB, WS_WDN = 22 * MiB, WS_DG = 28 * MiB;
constexpr size_t WS_A = 32 * MiB;
constexpr size_t WS_CQ = 169 * MiB, WS_CKV = 186 * MiB, WS_HQ = 203 * MiB, WS_HI = 237 * MiB, WS_HG = 271 * MiB, WS_GF = 305 * MiB, WS_GB = 339 * MiB;
constexpr size_t WS_V = 373 * MiB, WS_MIX = 407 * MiB, WS_ACT = 169 * MiB, WS_RSSP = 471 * MiB, WS_BAR = 480 * MiB, WS_END = 481 * MiB;
constexpr int LDS_BYTES = 147456;

__device__ __forceinline__ unsigned f2bf(float f) { unsigned u = __builtin_bit_cast(unsigned, f); return (u + 0x7fffu + ((u >> 16) & 1u)) >> 16; }
__device__ __forceinline__ float bf2f(unsigned h) { return __builtin_bit_cast(float, h << 16); }
typedef __bf16 bf16v2_t __attribute__((ext_vector_type(2)));
__device__ __forceinline__ unsigned pk2(float lo, float hi) { bf16v2_t v; v.x = (__bf16)lo; v.y = (__bf16)hi; return __builtin_bit_cast(unsigned, v); }
__device__ __forceinline__ float wave_sum(float v) {
#pragma unroll
    for (int o = 1; o < 64; o <<= 1) v += __shfl_xor(v, o);
    return v;
}
__device__ __forceinline__ float sigmoidf_(float x) { return 1.f / (1.f + __expf(-x)); }
#define LDS_WAIT() asm volatile("s_waitcnt lgkmcnt(0)" ::: "memory")

struct Args {
    const float *x, *c, *ctx, *c_ctx, *w_mod, *b_mod, *g_mix, *g_ffn, *w_in, *g_qn, *w_uq, *g_kvn, *w_ukv, *lb_fwd, *lb_bwd, *g_on, *w_out, *w_gate, *w_up, *w_down, *g_final;
    float* out; unsigned char* ws; int ph_lo, ph_hi;
};

__device__ __forceinline__ void p0_mod_item(const Args& a, char* ldsc, int item) {
    float* sl = (float*)ldsc;
    float* red = sl + 9216;
    const int tid = threadIdx.x, wave = tid >> 6, lane = tid & 63;
    for (int i = tid; i < 9216; i += 512) { const float v = (i < 8192) ? a.c[i] : a.c_ctx[i - 8192]; sl[i] = v * sigmoidf_(v); }
    __syncthreads();
    float acc[9];
#pragma unroll
    for (int r = 0; r < 9; ++r) acc[r] = 0.f;
    const float* wp = a.w_mod + (size_t)(wave * 128) * 6144 + item * 64 + lane;
#pragma unroll 16
    for (int k = 0; k < 128; ++k) {
        const float w = wp[(size_t)k * 6144];
#pragma unroll
        for (int r = 0; r < 9; ++r) acc[r] += sl[r * 1024 + wave * 128 + k] * w;
    }
#pragma unroll
    for (int r = 0; r < 9; ++r) red[(wave * 9 + r) * 64 + lane] = acc[r];
    __syncthreads();
    float* MOD = (float*)(a.ws + WS_MOD);
    for (int i = tid; i < 576; i += 512) {
        const int r = i >> 6, l = i & 63; float s = 0.f;
#pragma unroll
        for (int w = 0; w < 8; ++w) s += red[(w * 9 + r) * 64 + l];
        MOD[r * 6144 + item * 64 + l] = s + a.b_mod[item * 64 + l];
    }
    __syncthreads();
}
__device__ __forceinline__ void p0_transpose_item(const float* W, int N, bf16_t* WT, int Kd, int drow0, const float* kscale, float* scr, int k0, int n0, int lane) {
#pragma unroll 16
    for (int i = 0; i < 32; ++i) { const int kk = 2 * i + (lane >> 5); float v = W[(size_t)(k0 + kk) * N + n0 + (lane & 31)]; if (kscale) v *= kscale[k0 + kk]; scr[kk * 33 + (lane & 31)] = v; }
    LDS_WAIT(); asm volatile("" ::: "memory");
    const int c = lane & 7;
#pragma unroll
    for (int j = 0; j < 4; ++j) { const int n = (lane >> 3) + 8 * j; const float* s = scr + (8 * c) * 33 + n;
        u32x4 o; o.x = pk2(s[0 * 33], s[1 * 33]); o.y = pk2(s[2 * 33], s[3 * 33]); o.z = pk2(s[4 * 33], s[5 * 33]); o.w = pk2(s[6 * 33], s[7 * 33]);
        *(u32x4*)(WT + (size_t)(drow0 + n) * Kd + k0 + 8 * c) = o; }
    LDS_WAIT(); asm volatile("" ::: "memory");
}
__device__ __forceinline__ void p0_prologue(const Args& a, char* ldsc, int G) {
    const int tid = threadIdx.x, wave = tid >> 6, lane = tid & 63;
    unsigned char* ws = a.ws;
    if (blockIdx.x < 96) p0_mod_item(a, ldsc, blockIdx.x);
    if ((int)blockIdx.x == G - 1) {
        float* LBF = (float*)(ws + WS_LBF); float* LBB = (float*)(ws + WS_LBB);
        LBF[tid] = 1.f / (1.f + __expf(a.lb_fwd[512 + tid] - a.lb_fwd[tid]));
        LBB[tid] = 1.f / (1.f + __expf(a.lb_bwd[512 + tid] - a.lb_bwd[tid]));
        float* RC = (float*)(ws + WS_RCOS); float* RS = (float*)(ws + WS_RSIN);
        for (int i = tid; i < 1024; i += 512) {
            const int pos = i >> 4, fi = i & 15;
            const float inv = exp2f(-(float)fi * (13.287712379549449f / 16.f));
            const float ang = (float)pos * inv;
            const float kq = rintf(ang * 0.15915494309189535f);
            float r = fmaf(-kq, 6.28125f, ang); r = fmaf(-kq, 0.0019353071795864769f, r);
            RC[i] = __cosf(r); RS[i] = __sinf(r);
        }
    }
    { u32x4* pz = (u32x4*)(ws + WS_WIN + (size_t)NIN * 1024 * 2); const u32x4 z = {0u, 0u, 0u, 0u};
      for (int i = blockIdx.x * 512 + tid; i < (NINP - NIN) * 1024 * 2 / 16; i += G * 512) pz[i] = z; }
    float* scr = (float*)(ldsc + wave * 16384);
    const int gw = blockIdx.x * 8 + wave, NGW = G * 8;
    constexpr int I_IN = 16 * 98, I_UQ = 4 * 24, I_UKV = 4 * 32, I_OUT = 16 * 32, I_G = 16 * 88, I_DN = 44 * 32;
    constexpr int NITEMS = I_IN + I_UQ + I_UKV + I_OUT + 2 * I_G + I_DN;
    for (int it = gw; it < NITEMS; it += NGW) {
        int r = it;
        if (r < I_IN) { const int kb = r / 98, nb = r % 98; p0_transpose_item(a.w_in, NIN, (bf16_t*)(ws + WS_WIN), 1024, 32 * nb, nullptr, scr, 64 * kb, 32 * nb, lane); continue; } r -= I_IN;
        if (r < I_UQ) { const int kb = r / 24, nb = r % 24; p0_transpose_item(a.w_uq, 768, (bf16_t*)(ws + WS_WUQ), 256, 32 * nb, a.g_qn, scr, 64 * kb, 32 * nb, lane); continue; } r -= I_UQ;
        if (r < I_UKV) { const int kb = r / 32, nb = r % 32; p0_transpose_item(a.w_ukv, 1024, (bf16_t*)(ws + WS_WUKV), 256, 32 * nb, a.g_kvn, scr, 64 * kb, 32 * nb, lane); continue; } r -= I_UKV;
        if (r < I_OUT) { const int kb = r / 32, nb = r % 32; p0_transpose_item(a.w_out, 1024, (bf16_t*)(ws + WS_WOUT), 1024, 32 * nb, nullptr, scr, 64 * kb, 32 * nb, lane); continue; } r -= I_OUT;
        if (r < 2 * I_G) { const int up = r >= I_G; if (up) r -= I_G; const int kb = r / 88, nb = r % 88, n0 = 32 * nb;
            const int drow = (n0 >> 7) * 256 + (n0 & 127) + (up ? 128 : 0);
            p0_transpose_item(up ? a.w_up : a.w_gate, DFF, (bf16_t*)(ws + WS_WGU), 1024, drow, nullptr, scr, 64 * kb, n0, lane); continue; } r -= 2 * I_G;
        { const int kb = r / 32, nb = r % 32; p0_transpose_item(a.w_down, 1024, (bf16_t*)(ws + WS_WDN), DFF, 32 * nb, nullptr, scr, 64 * kb, 32 * nb, lane); }
    }
}

template <int NR>
__device__ __forceinline__ void rows_norm_mod_bf16(const float* const (&src)[NR], const float* g, const float* const (&md)[NR], int shoff, bf16_t* const (&dst)[NR], const bool (&ok)[NR], int lane) {
    f32x4 v[NR][4]; float s[NR];
#pragma unroll
    for (int i = 0; i < NR; ++i) { s[i] = 0.f; if (ok[i]) {
#pragma unroll
        for (int j = 0; j < 4; ++j) v[i][j] = ((const f32x4*)src[i])[lane + 64 * j]; } }
#pragma unroll
    for (int i = 0; i < NR; ++i) if (ok[i]) {
#pragma unroll
        for (int j = 0; j < 4; ++j) s[i] += (v[i][j].x * v[i][j].x + v[i][j].y * v[i][j].y) + (v[i][j].z * v[i][j].z + v[i][j].w * v[i][j].w); }
#pragma unroll
    for (int o = 1; o < 64; o <<= 1) {
#pragma unroll
        for (int i = 0; i < NR; ++i) s[i] += __shfl_xor(s[i], o); }
#pragma unroll
    for (int i = 0; i < NR; ++i) if (ok[i]) {
        const float rstd = rsqrtf(s[i] * (1.f / 1024.f) + EPS);
        u32x2* o8 = (u32x2*)dst[i] + lane;
#pragma unroll
        for (int j = 0; j < 4; ++j) {
            const f32x4 gg = ((const f32x4*)g)[lane + 64 * j], s1 = ((const f32x4*)(md[i] + shoff + 1024))[lane + 64 * j], s0 = ((const f32x4*)(md[i] + shoff))[lane + 64 * j];
            const f32x4 y = v[i][j] * rstd * gg * (s1 + 1.f) + s0;
            u32x2 w; w.x = pk2(y.x, y.y); w.y = pk2(y.z, y.w); o8[64 * j] = w;
        }
    }
}
template <int NR>
__device__ __forceinline__ void rows_norm_mod_pre(const float* const (&src)[NR], const f32x4 (&A)[4], const f32x4 (&B)[4], bf16_t* const (&dst)[NR], int lane) {
    f32x4 v[NR][4]; float s[NR];
#pragma unroll
    for (int i = 0; i < NR; ++i) { s[i] = 0.f;
#pragma unroll
        for (int j = 0; j < 4; ++j) v[i][j] = ((const f32x4*)src[i])[lane + 64 * j]; }
#pragma unroll
    for (int i = 0; i < NR; ++i) {
#pragma unroll
        for (int j = 0; j < 4; ++j) s[i] += (v[i][j].x * v[i][j].x + v[i][j].y * v[i][j].y) + (v[i][j].z * v[i][j].z + v[i][j].w * v[i][j].w); }
#pragma unroll
    for (int o = 1; o < 64; o <<= 1) {
#pragma unroll
        for (int i = 0; i < NR; ++i) s[i] += __shfl_xor(s[i], o); }
#pragma unroll
    for (int i = 0; i < NR; ++i) {
        const float rstd = rsqrtf(s[i] * (1.f / 1024.f) + EPS);
        u32x2* o8 = (u32x2*)dst[i] + lane;
#pragma unroll
        for (int j = 0; j < 4; ++j) { const f32x4 y = v[i][j] * rstd * A[j] + B[j]; u32x2 w; w.x = pk2(y.x, y.y); w.y = pk2(y.z, y.w); o8[64 * j] = w; }
    }
}
__device__ __forceinline__ void load_mod_params(const float* g, const float* md, int shoff, f32x4 (&A)[4], f32x4 (&B)[4], int lane) {
#pragma unroll
    for (int j = 0; j < 4; ++j) { const f32x4 gg = ((const f32x4*)g)[lane + 64 * j], s1 = ((const f32x4*)(md + shoff + 1024))[lane + 64 * j]; A[j] = gg * (s1 + 1.f); B[j] = ((const f32x4*)(md + shoff))[lane + 64 * j]; }
}
template <int NR>
__device__ __forceinline__ void rows_norm_f32(float* const (&row)[NR], const float* g, int lane) {
    f32x4 v[NR][4]; float s[NR];
#pragma unroll
    for (int i = 0; i < NR; ++i) { s[i] = 0.f;
#pragma unroll
        for (int j = 0; j < 4; ++j) v[i][j] = ((const f32x4*)row[i])[lane + 64 * j]; }
#pragma unroll
    for (int i = 0; i < NR; ++i) {
#pragma unroll
        for (int j = 0; j < 4; ++j) s[i] += (v[i][j].x * v[i][j].x + v[i][j].y * v[i][j].y) + (v[i][j].z * v[i][j].z + v[i][j].w * v[i][j].w); }
#pragma unroll
    for (int o = 1; o < 64; o <<= 1) {
#pragma unroll
        for (int i = 0; i < NR; ++i) s[i] += __shfl_xor(s[i], o); }
#pragma unroll
    for (int i = 0; i < NR; ++i) {
        const float rstd = rsqrtf(s[i] * (1.f / 1024.f) + EPS);
#pragma unroll
        for (int j = 0; j < 4; ++j) { f32x4 o = v[i][j] * rstd * ((const f32x4*)g)[lane + 64 * j];
#ifdef SANITIZE
            o.x = __builtin_isfinite(o.x) ? o.x : 1000.f; o.y = __builtin_isfinite(o.y) ? o.y : 1000.f; o.z = __builtin_isfinite(o.z) ? o.z : 1000.f; o.w = __builtin_isfinite(o.w) ? o.w : 1000.f;
#endif
            ((f32x4*)row[i])[lane + 64 * j] = o; }
    }
}

__device__ __forceinline__ void rope8(float (&v)[8], int fq, const float* rc, const float* rs, int pos, bool apply) {
    const int ib = pos * 16 + 8 * (fq & 1);
#pragma unroll
    for (int e = 0; e < 8; ++e) {
        const float partner = __shfl_xor(v[e], 32);
        const float cs = rc[ib + e], sn = rs[ib + e];
        const float r = (fq < 2) ? (v[e] * cs - partner * sn) : (v[e] * cs + partner * sn);
        v[e] = apply ? r : v[e];
    }
}
__device__ __forceinline__ u32x4 pack8(const float (&v)[8]) { u32x4 w; w.x = pk2(v[0], v[1]); w.y = pk2(v[2], v[3]); w.z = pk2(v[4], v[5]); w.w = pk2(v[6], v[7]); return w; }

struct EpiInProj {
    static constexpr bool PERM = true, AFTER_DRAIN = false;
    unsigned char* ws; bf16_t* Kb;
    __device__ __forceinline__ void operator()(const pg8::f32x4 (&acc)[2][2][4][2], const pg8::Unit& u, int wr, int wc, int fr, int fq) const {
        float* RSS = (float*)(ws + WS_RSSP); const float* RC = (const float*)(ws + WS_RCOS); const float* RS = (const float*)(ws + WS_RSIN);
#pragma unroll
        for (int bj = 0; bj < 2; ++bj) {
            const int cbase = u.pn * 256 + bj * 128 + wc * 32;
            if (cbase >= NIN) continue;
            const int c0 = cbase + 8 * fq;
#pragma unroll
            for (int ai = 0; ai < 2; ++ai)
#pragma unroll
                for (int m = 0; m < 4; ++m) {
                    const int row = u.pm * 256 + ai * 128 + wr * 64 + m * 16 + fr;
                    float v[8];
#pragma unroll
                    for (int e = 0; e < 4; ++e) { v[e] = acc[ai][bj][m][0][e]; v[4 + e] = acc[ai][bj][m][1][e]; }
                    if (cbase < 512) {
                        bf16_t* dst = (bf16_t*)(ws + WS_CQ + (cbase < 256 ? (size_t)0 : (WS_CKV - WS_CQ))) + (size_t)row * 256 + (c0 & 255);
                        *(u32x4*)dst = pack8(v);
                        float ss = 0.f;
#pragma unroll
                        for (int e = 0; e < 8; ++e) ss += v[e] * v[e];
                        ss += __shfl_xor(ss, 16); ss += __shfl_xor(ss, 32);
                        if (fq == 0) RSS[((size_t)row * 2 + (cbase < 256 ? 0 : 1)) * 8 + bj * 4 + wc] = ss;
                    } else if (cbase < 576) {
                        const int axis = (cbase - 512) >> 5;
                        const bool lat = row < ML;
                        const int n = row & 4095;
                        const int pos = axis ? (n & 63) : (n >> 6);
                        rope8(v, fq, RC, RS, lat ? pos : 0, lat);
                        const int b = lat ? (row >> 12) : ((row - ML) >> 8);
                        const int kvpos = lat ? (CTXL + n) : ((row - ML) & 255);
                        const u32x4 w = pack8(v);
#pragma unroll
                        for (int h = 0; h < 4; ++h) *(u32x4*)(Kb + ((size_t)(b * 4 + h) * KVL + kvpos) * 192 + 128 + axis * 32 + 8 * fq) = w;
                    } else if (cbase < 2112) {
                        const int seg = (cbase - 576) >> 9;
                        bf16_t* base = (bf16_t*)(ws + WS_HQ + (size_t)seg * (WS_HI - WS_HQ));
                        *(u32x4*)(base + (size_t)row * 512 + (c0 - 576 - seg * 512)) = pack8(v);
                    } else {
                        const int dirn = (cbase - 2112) >> 9, j = c0 - 2112 - dirn * 512;
                        const float* lbp = (const float*)(ws + WS_LBF + (size_t)dirn * (WS_LBB - WS_LBF)) + j;
                        typedef _Float16 h8 __attribute__((ext_vector_type(8)));
                        h8 o;
#pragma unroll
                        for (int e = 0; e < 8; ++e) { const float lb = lbp[e]; const float f = lb + (1.f - lb) * sigmoidf_(v[e]); o[e] = (_Float16)__logf(f); }
                        *(h8*)((_Float16*)(ws + WS_GF + (size_t)dirn * (WS_GB - WS_GF)) + (size_t)row * 512 + j) = o;
                    }
                }
        }
    }
};
struct EpiQ {
    static constexpr bool PERM = true, AFTER_DRAIN = false;
    bf16_t* Q; const float* RSS; const float *RC, *RS;
    __device__ __forceinline__ void operator()(const pg8::f32x4 (&acc)[2][2][4][2], const pg8::Unit& u, int wr, int wc, int fr, int fq) const {
#pragma unroll
        for (int bj = 0; bj < 2; ++bj) {
            const int cbase = u.pn * 256 + bj * 128 + wc * 32;
            const int h = cbase / 192, d0 = cbase - h * 192;
            const bool rope = d0 >= 128; const int axis = (d0 - 128) >> 5;
#pragma unroll
            for (int ai = 0; ai < 2; ++ai)
#pragma unroll
                for (int m = 0; m < 4; ++m) {
                    const int row = u.pm * 256 + ai * 128 + wr * 64 + m * 16 + fr;
                    const f32x4 s0 = *(const f32x4*)(RSS + (size_t)row * 16), s1 = *(const f32x4*)(RSS + (size_t)row * 16 + 4);
                    const float rstd = rsqrtf((((s0.x + s0.y) + (s0.z + s0.w)) + ((s1.x + s1.y) + (s1.z + s1.w))) * (1.f / 256.f) + EPS);
                    float v[8];
#pragma unroll
                    for (int e = 0; e < 4; ++e) { v[e] = acc[ai][bj][m][0][e] * rstd; v[4 + e] = acc[ai][bj][m][1][e] * rstd; }
                    const int b = row >> 12, n = row & 4095;
                    if (rope) { const int pos = axis ? (n & 63) : (n >> 6); rope8(v, fq, RC, RS, pos, true); }
                    *(u32x4*)(Q + ((size_t)(b * 4 + h) * SEQ + n) * 192 + d0 + 8 * fq) = pack8(v);
                    asm volatile("" ::: "memory");
                }
        }
    }
};
struct EpiKV {
    static constexpr bool PERM = true, AFTER_DRAIN = false;
    bf16_t *Kb, *Vb; const float* RSS;
    __device__ __forceinline__ void operator()(const pg8::f32x4 (&acc)[2][2][4][2], const pg8::Unit& u, int wr, int wc, int fr, int fq) const {
#pragma unroll
        for (int bj = 0; bj < 2; ++bj) {
            const int cbase = u.pn * 256 + bj * 128 + wc * 32;
            const int h = cbase >> 8, j0 = cbase & 255;
#pragma unroll
            for (int ai = 0; ai < 2; ++ai)
#pragma unroll
                for (int m = 0; m < 4; ++m) {
                    const int row = u.pm * 256 + ai * 128 + wr * 64 + m * 16 + fr;
                    const f32x4 s0 = *(const f32x4*)(RSS + (size_t)row * 16 + 8), s1 = *(const f32x4*)(RSS + (size_t)row * 16 + 12);
                    const float rstd = rsqrtf((((s0.x + s0.y) + (s0.z + s0.w)) + ((s1.x + s1.y) + (s1.z + s1.w))) * (1.f / 256.f) + EPS);
                    float v[8];
#pragma unroll
                    for (int e = 0; e < 4; ++e) { v[e] = acc[ai][bj][m][0][e] * rstd; v[4 + e] = acc[ai][bj][m][1][e] * rstd; }
                    const bool lat = row < ML;
                    const int b = lat ? (row >> 12) : ((row - ML) >> 8);
                    const int kvpos = lat ? (CTXL + (row & 4095)) : ((row - ML) & 255);
                    const size_t r = (size_t)(b * 4 + h) * KVL + kvpos;
                    if (j0 < 128) *(u32x4*)(Kb + r * 192 + j0 + 8 * fq) = pack8(v);
                    else          *(u32x4*)(Vb + r * 128 + (j0 - 128) + 8 * fq) = pack8(v);
                    asm volatile("" ::: "memory");
                }
        }
    }
};
struct QKVOrder {
    int G, c;
    __device__ bool next(int i, pg8::Unit& u) const {
        const int L = i * G + c;
        if (L >= 384 + 544) return false;
        if (L < 384) { u.pm = L / 3; u.pn = L % 3; } else { const int l2 = L - 384; u.pm = 136 + (l2 >> 2); u.pn = 3 + (l2 & 3); }
        return true;
    }
    __device__ __forceinline__ void a_ready(const pg8::Unit&) const {}
    __device__ __forceinline__ void done(const pg8::Unit&) const {}
};
struct EpiQKV {
    static constexpr bool PERM = true, AFTER_DRAIN = false;
    EpiQ q; EpiKV kv;
    __device__ __forceinline__ void operator()(const pg8::f32x4 (&acc)[2][2][4][2], const pg8::Unit& u, int wr, int wc, int fr, int fq) const {
        if (u.pn < 3) q(acc, u, wr, wc, fr, fq);
        else { const pg8::Unit v{u.pm - 136, u.pn - 3}; kv(acc, v, wr, wc, fr, fq); }
    }
};
struct EpiRes {
    static constexpr bool PERM = false, AFTER_DRAIN = false;
    const float* base; float* out; const float* gate;
    __device__ __forceinline__ void operator()(const pg8::f32x4 (&acc)[2][2][4][2], const pg8::Unit& u, int wr, int wc, int fr, int fq) const {
#pragma unroll
        for (int ai = 0; ai < 2; ++ai)
#pragma unroll
            for (int m = 0; m < 4; ++m) {
                const int row = u.pm * 256 + ai * 128 + wr * 64 + m * 16 + fr;
                const float* gp = gate + (size_t)(row >> 12) * 6144;
#pragma unroll
                for (int bj = 0; bj < 2; ++bj)
#pragma unroll
                    for (int n = 0; n < 2; ++n) {
                        const int c = u.pn * 256 + bj * 128 + wc * 32 + 16 * n + 4 * fq;
                        const f32x4 g = *(const f32x4*)(gp + c), bs = *(const f32x4*)(base + (size_t)row * 1024 + c);
                        const pg8::f32x4 a4 = acc[ai][bj][m][n];
                        f32x4 o; o.x = bs.x + g.x * a4[0]; o.y = bs.y + g.y * a4[1]; o.z = bs.z + g.z * a4[2]; o.w = bs.w + g.w * a4[3];
                        *(f32x4*)(out + (size_t)row * 1024 + c) = o;
                    }
            }
    }
};
struct EpiSwiglu {
    static constexpr bool PERM = true, AFTER_DRAIN = false;
    bf16_t* ACT;
    __device__ __forceinline__ void operator()(const pg8::f32x4 (&acc)[2][2][4][2], const pg8::Unit& u, int wr, int wc, int fr, int fq) const {
#pragma unroll
        for (int ai = 0; ai < 2; ++ai)
#pragma unroll
            for (int m = 0; m < 4; ++m) {
                const int row = u.pm * 256 + ai * 128 + wr * 64 + m * 16 + fr;
                float v[8];
#pragma unroll
                for (int n = 0; n < 2; ++n)
#pragma unroll
                    for (int e = 0; e < 4; ++e) { const float g = acc[ai][0][m][n][e], uu = acc[ai][1][m][n][e]; v[4 * n + e] = g * sigmoidf_(g) * uu; }
                *(u32x4*)(ACT + (size_t)row * DFF + u.pn * 128 + wc * 32 + 8 * fq) = pack8(v);
            }
    }
};

#ifndef ATT_QREG
#define ATT_QREG 2
#endif
namespace att {
constexpr int NW = 8, QBLK = 32, KVBLK = 64;
constexpr float SCALE = 0.07216878364870322f;
constexpr float THR = 8.f;
constexpr int LDQ = 192, LDK = 192, LDV = 128, LDO = 1024;
constexpr int SHM_V = KVBLK * 128 * 2, SHM_K = KVBLK * 512, SHM_ATTN = 2 * SHM_V + 2 * SHM_K;
static_assert(SHM_ATTN <= 163840, "attention LDS");
#define KSWZ(row, colB) ((row) * 512 + ((colB) ^ (((((row) & 7) | ((((row) >> 4) & 1) << 3))) << 4)))
#define SBAR() __builtin_amdgcn_sched_barrier(0)
__device__ __forceinline__ int crow(int r, int hi) { return (r & 3) + 8 * (r >> 2) + 4 * hi; }
__device__ __forceinline__ unsigned cvtpk(float lo, float hi) { return pk2(lo, hi); }
__device__ __forceinline__ void partialSM(f32x16& p0, f32x16& p1, float& m_reg, float& mn, float& alpha) {
  constexpr float C = SCALE * 1.4426950408889634f;
  float pmax = p0[0];
#pragma unroll
  for (int r = 1; r < 16; ++r) pmax = fmaxf(pmax, p0[r]);
#pragma unroll
  for (int r = 0; r < 16; ++r) pmax = fmaxf(pmax, p1[r]);
  { auto rr = __builtin_amdgcn_permlane32_swap(__float_as_uint(pmax), __float_as_uint(pmax), false, false);
    pmax = fmaxf(__uint_as_float(rr[0]), __uint_as_float(rr[1])); }
  if (__builtin_expect(__all(pmax - m_reg <= THR / SCALE), 1)) { mn = m_reg; alpha = 1.f; }
  else { mn = fmaxf(m_reg, pmax); alpha = __builtin_amdgcn_exp2f((m_reg - mn) * C); m_reg = mn; }
  float mnC = -mn * C;
#pragma unroll
  for (int r = 0; r < 16; ++r) p0[r] = fmaf(p0[r], C, mnC);
#pragma unroll
  for (int r = 0; r < 16; ++r) p1[r] = fmaf(p1[r], C, mnC);
#pragma unroll
  for (int r = 0; r < 16; ++r) p0[r] = __builtin_amdgcn_exp2f(p0[r]);
}
__device__ __forceinline__ void finishSM(f32x16& p0, f32x16& p1, float alpha, float& l_reg, bf16x8& pa0, bf16x8& pa1, bf16x8& pa2, bf16x8& pa3) {
#pragma unroll
  for (int r = 0; r < 16; ++r) p1[r] = __builtin_amdgcn_exp2f(p1[r]);
  float ps = 0;
#pragma unroll
  for (int r = 0; r < 16; ++r) ps += p0[r];
#pragma unroll
  for (int r = 0; r < 16; ++r) ps += p1[r];
  { auto rr = __builtin_amdgcn_permlane32_swap(__float_as_uint(ps), __float_as_uint(ps), false, false);
    ps = __uint_as_float(rr[0]) + __uint_as_float(rr[1]); }
  l_reg = l_reg * alpha + ps;
#define PK4(P, BASE, OUT) do { unsigned a0 = cvtpk(P[BASE + 0], P[BASE + 1]), a1 = cvtpk(P[BASE + 2], P[BASE + 3]);   \
    unsigned b0 = cvtpk(P[BASE + 4], P[BASE + 5]), b1 = cvtpk(P[BASE + 6], P[BASE + 7]);                              \
    auto r0 = __builtin_amdgcn_permlane32_swap(a0, b0, false, false); auto r1 = __builtin_amdgcn_permlane32_swap(a1, b1, false, false); \
    u32x4 w = {r0[0], r1[0], r0[1], r1[1]}; OUT = *reinterpret_cast<bf16x8*>(&w); } while (0)
  PK4(p0, 0, pa0); PK4(p0, 8, pa1); PK4(p1, 0, pa2); PK4(p1, 8, pa3);
#undef PK4
}
__device__ __forceinline__ void qkt(f32x16& p0, f32x16& p1, const char* Ks, const bf16x8* qr, int r32, int hi) {
  p0 = f32x16{}; p1 = f32x16{};
  bf16x8 kf0[3], kf1[3];
#define QKT_LD(d0) do { const int cb_ = ((d0) * 16 + hi * 8) * 2; kf0[(d0) % 3] = *reinterpret_cast<const bf16x8*>(Ks + KSWZ(r32, cb_)); kf1[(d0) % 3] = *reinterpret_cast<const bf16x8*>(Ks + KSWZ(32 + r32, cb_)); } while (0)
  QKT_LD(0); QKT_LD(1);
  __builtin_amdgcn_sched_barrier(0);
#pragma unroll
  for (int d0 = 0; d0 < 12; ++d0) {
    if (d0 + 2 < 12) QKT_LD(d0 + 2);
    __builtin_amdgcn_sched_barrier(0);
    p0 = __builtin_amdgcn_mfma_f32_32x32x16_bf16(kf0[d0 % 3], qr[d0], p0, 0, 0, 0);
    p1 = __builtin_amdgcn_mfma_f32_32x32x16_bf16(kf1[d0 % 3], qr[d0], p1, 0, 0, 0);
    __builtin_amdgcn_sched_barrier(0);
  }
#undef QKT_LD
}
__device__ __forceinline__ int v_st(int k, int c) { const int kk = (k & ~0xC) | ((k & 4) << 1) | ((k & 8) >> 1); return ((kk >> 3) * 4 + (c >> 5)) * 512 + ((kk & 7) * 32 + (c & 31)) * 2; }
__device__ __forceinline__ int v_rd_base(int lane) { return ((lane & 3) << 3) | (((lane >> 2) & 3) << 6) | (((lane >> 4) & 1) << 5) | (((lane >> 5) & 1) << 8); }
constexpr int v_rd_off(int d0, int ks, int half) { return d0 * 512 + ks * 4096 + half * 2048; }
template <int OFF> __device__ __forceinline__ s16x4 tr_read(int vb) {
  s16x4 r; asm volatile("ds_read_b64_tr_b16 %0, %1 offset:%2" : "=&v"(r) : "v"(vb), "i"(OFF) : "memory"); return r;
}
template <int D0> __device__ __forceinline__ void pv_one(f32x16& od, int vb, bf16x8 pa0, bf16x8 pa1, bf16x8 pa2, bf16x8 pa3) {
  const s16x4 l0 = tr_read<v_rd_off(D0, 0, 0)>(vb), h0 = tr_read<v_rd_off(D0, 0, 1)>(vb), l1 = tr_read<v_rd_off(D0, 1, 0)>(vb), h1 = tr_read<v_rd_off(D0, 1, 1)>(vb);
  const s16x4 l2 = tr_read<v_rd_off(D0, 2, 0)>(vb), h2 = tr_read<v_rd_off(D0, 2, 1)>(vb), l3 = tr_read<v_rd_off(D0, 3, 0)>(vb), h3 = tr_read<v_rd_off(D0, 3, 1)>(vb);
  asm volatile("s_waitcnt lgkmcnt(0)" ::: "memory"); SBAR();
#define PK(L, H) (bf16x8){L[0], L[1], L[2], L[3], H[0], H[1], H[2], H[3]}
  od = __builtin_amdgcn_mfma_f32_32x32x16_bf16(pa0, PK(l0, h0), od, 0, 0, 0);
  od = __builtin_amdgcn_mfma_f32_32x32x16_bf16(pa1, PK(l1, h1), od, 0, 0, 0);
  od = __builtin_amdgcn_mfma_f32_32x32x16_bf16(pa2, PK(l2, h2), od, 0, 0, 0);
  od = __builtin_amdgcn_mfma_f32_32x32x16_bf16(pa3, PK(l3, h3), od, 0, 0, 0);
#undef PK
}
__device__ __forceinline__ void pv_d0(f32x16* o, int vb, bf16x8 pa0, bf16x8 pa1, bf16x8 pa2, bf16x8 pa3) {
  pv_one<0>(o[0], vb, pa0, pa1, pa2, pa3); pv_one<1>(o[1], vb, pa0, pa1, pa2, pa3); pv_one<2>(o[2], vb, pa0, pa1, pa2, pa3); pv_one<3>(o[3], vb, pa0, pa1, pa2, pa3);
}
__device__ __forceinline__ void attn_body(const bf16_t* __restrict__ Qb, const bf16_t* __restrict__ Kh, const bf16_t* __restrict__ Vh, bf16_t* __restrict__ Ob, int seq, char* lds) {
  const int tid = threadIdx.x, wid = tid >> 6, lane = tid & 63, r32 = lane & 31, hi = lane >> 5;
  char* V_lds = lds; char* K_lds = lds + 2 * SHM_V;
  float m_reg = -1e30f, l_reg = 0; f32x16 o[4] = {}; bf16x8 qr[12];
  const bf16_t* Qw = Qb + (long)(wid * QBLK + r32) * LDQ + hi * 8;
#pragma unroll
  for (int d0 = 0; d0 < 12; ++d0) qr[d0] = *reinterpret_cast<const bf16x8*>(Qw + d0 * 16);
  const int sr = tid >> 4, sc = (tid & 15) * 8, vst0 = v_st(sr, sc), vst1 = v_st(32 + sr, sc);
  const int kid0 = tid, kid1 = tid + 512, kid2 = tid + 1024;
  const int kr0 = kid0 / 24, kc0 = kid0 % 24, kr1 = kid1 / 24, kc1 = kid1 % 24, kr2 = kid2 / 24, kc2 = kid2 % 24;
  const int kg0 = kr0 * LDK + kc0 * 8, kg1 = kr1 * LDK + kc1 * 8, kg2 = kr2 * LDK + kc2 * 8;
  const int kl0 = KSWZ(kr0, kc0 * 16), kl1 = KSWZ(kr1, kc1 * 16), kl2 = KSWZ(kr2, kc2 * 16);
  const int vb0 = (int)(uintptr_t)V_lds + v_rd_base(lane);
  bf16x8 sA_v0, sA_v1, sA_k0, sA_k1, sA_k2;
#define SLOADA(k0) do { sA_v0 = *(const bf16x8*)&Vh[(long)((k0) + sr) * LDV + sc]; sA_v1 = *(const bf16x8*)&Vh[(long)((k0) + 32 + sr) * LDV + sc]; \
    sA_k0 = *(const bf16x8*)&Kh[(long)(k0) * LDK + kg0]; sA_k1 = *(const bf16x8*)&Kh[(long)(k0) * LDK + kg1]; sA_k2 = *(const bf16x8*)&Kh[(long)(k0) * LDK + kg2]; } while (0)
#define SWRITEA(b) do { *(bf16x8*)(V_lds + (b) * SHM_V + vst0) = sA_v0; *(bf16x8*)(V_lds + (b) * SHM_V + vst1) = sA_v1; \
    *(bf16x8*)(K_lds + (b) * SHM_K + kl0) = sA_k0; *(bf16x8*)(K_lds + (b) * SHM_K + kl1) = sA_k1; *(bf16x8*)(K_lds + (b) * SHM_K + kl2) = sA_k2; } while (0)
#define SWAIT() asm volatile("s_waitcnt vmcnt(0)" ::: "memory")
#define RESC(a) do { if (__any((a) < 1.f)) { \
    _Pragma("unroll") for (int r = 0; r < 16; ++r) { const float al_ = __shfl((a), crow(r, hi)); _Pragma("unroll") for (int d = 0; d < 4; ++d) o[d][r] *= al_; } } } while (0)
  const int NT = seq / KVBLK;
  SLOADA(0); SWAIT(); SWRITEA(0); __syncthreads();
#pragma unroll 1
  for (int j = 0; j < NT; ++j) {
    const int b = j & 1;
    if (j + 1 < NT) SLOADA((j + 1) * KVBLK);
    f32x16 p0, p1; float mn, al; bf16x8 pa0, pa1, pa2, pa3;
    SBAR(); qkt(p0, p1, K_lds + b * SHM_K, qr, r32, hi);
    partialSM(p0, p1, m_reg, mn, al);
    RESC(al);
    finishSM(p0, p1, al, l_reg, pa0, pa1, pa2, pa3); SBAR();
    pv_d0(o, vb0 + b * SHM_V, pa0, pa1, pa2, pa3);
    if (j + 1 < NT) { SWAIT(); SWRITEA(b ^ 1); }
    __syncthreads();
  }
  float rli[16];
#pragma unroll
  for (int r = 0; r < 16; ++r) rli[r] = __builtin_amdgcn_rcpf(__shfl(l_reg, crow(r, hi)));
  bf16_t* Ow = Ob + (long)(wid * QBLK) * LDO;
#pragma unroll
  for (int r = 0; r < 16; ++r) { int orow = crow(r, hi);
#pragma unroll
    for (int d0 = 0; d0 < 4; ++d0) Ow[(long)orow * LDO + d0 * 32 + r32] = (bf16_t)f2bf(o[d0][r] * rli[r]); }
  asm volatile("s_waitcnt vmcnt(0)" ::: "memory");
  __syncthreads();
#undef SLOADA
#undef SWRITEA
#undef SWAIT
#undef RESC
}
}

__device__ __forceinline__ int hgrn_chunk_row0(int dir, int b, int p) {
    if (p < 4) return ML + b * CTXL + 64 * (dir ? 3 - p : p);
    return b * SEQ + 64 * (dir ? 63 - (p - 4) : p - 4);
}
__device__ __forceinline__ void passA_ptrs(const Args& a, int item, int& dir, int& bh, int& p, size_t& goff) {
    dir = item / (32 * NCH); const int rem = item % (32 * NCH); bh = rem / NCH; p = rem % NCH;
    const int row0 = hgrn_chunk_row0(dir, bh >> 2, p);
    goff = (size_t)row0 * 512 + (bh & 3) * 128;
}
__device__ __forceinline__ void passA_load(const Args& a, int item, int k, int qd, unsigned (&graw)[16], unsigned (&vraw)[16]) {
    int dir, bh, p; size_t goff; passA_ptrs(a, item, dir, bh, p, goff);
    const unsigned short* G = (const unsigned short*)(a.ws + (dir ? WS_GB : WS_GF)) + goff;
    const bf16_t* Vp = (const bf16_t*)(a.ws + WS_HI) + goff;
#pragma unroll
    for (int i = 0; i < 16; ++i) { graw[i] = G[(size_t)(16 * qd + i) * 512 + k]; vraw[i] = Vp[(size_t)(16 * qd + i) * 512 + k]; }
}
__device__ __forceinline__ void hgrn_passA_loop(const Args& a, char* lds, int G_) {
    const int tid = threadIdx.x, wave = tid >> 6, lane = tid & 63, r32 = lane & 31, hi = lane >> 5;
    char* Kt = lds; char* Vt = lds + 128 * 144; float* qt = (float*)(lds + 2 * 128 * 144);
    const int k = tid & 127, qd = tid >> 7;
    constexpr int NIT = 2 * 32 * NCH;
    unsigned graw[16], vraw[16];
    if ((int)blockIdx.x < NIT) passA_load(a, blockIdx.x, k, qd, graw, vraw);
    for (int item = blockIdx.x; item < NIT; item += G_) {
        int dir, bh, p; size_t goff; passA_ptrs(a, item, dir, bh, p, goff);
        float gv[16], bl[16];
#pragma unroll
        for (int i = 0; i < 16; ++i) gv[i] = (float)__builtin_bit_cast(_Float16, (unsigned short)graw[i]);
        float run = 0.f;
        if (dir == 0) {
#pragma unroll
            for (int i = 0; i < 16; ++i) { run += gv[i]; bl[i] = run; }
        } else {
#pragma unroll
            for (int i = 15; i >= 0; --i) { run += gv[i]; bl[i] = run; }
        }
        qt[qd * 128 + k] = run;
        __syncthreads();
        const float q0 = qt[k], q1 = qt[128 + k], q2 = qt[256 + k], q3 = qt[384 + k];
        const float tot = (q0 + q1) + (q2 + q3);
        float off;
        if (dir == 0) off = (qd > 0 ? q0 : 0.f) + (qd > 1 ? q1 : 0.f) + (qd > 2 ? q2 : 0.f);
        else          off = (qd < 3 ? q3 : 0.f) + (qd < 2 ? q2 : 0.f) + (qd < 1 ? q1 : 0.f);
        unsigned short* Gw = (unsigned short*)(a.ws + (dir ? WS_GB : WS_GF)) + goff;
        unsigned kw[8], vw[8];
#pragma unroll
        for (int i = 0; i < 16; ++i) { bl[i] += off; Gw[(size_t)(16 * qd + i) * 512 + k] = (unsigned short)fminf(65535.f, rintf(bl[i] * -1024.f)); }
#pragma unroll
        for (int i = 0; i < 8; ++i) {
            const float k0 = (1.f - __expf(gv[2 * i])) * __expf(tot - bl[2 * i]), k1 = (1.f - __expf(gv[2 * i + 1])) * __expf(tot - bl[2 * i + 1]);
            kw[i] = pk2(k0, k1);
            vw[i] = vraw[2 * i] | (vraw[2 * i + 1] << 16);
        }
        *(u32x4*)(Kt + k * 144 + qd * 32) = (u32x4){kw[0], kw[1], kw[2], kw[3]}; *(u32x4*)(Kt + k * 144 + qd * 32 + 16) = (u32x4){kw[4], kw[5], kw[6], kw[7]};
        *(u32x4*)(Vt + k * 144 + qd * 32) = (u32x4){vw[0], vw[1], vw[2], vw[3]}; *(u32x4*)(Vt + k * 144 + qd * 32 + 16) = (u32x4){vw[4], vw[5], vw[6], vw[7]};
        const size_t slot = (size_t)(dir * 32 + bh) * NCH + p;
        if (qd == 0) ((float*)(a.ws + WS_DG))[slot * 128 + k] = __expf(tot);
        if (item + G_ < NIT) passA_load(a, item + G_, k, qd, graw, vraw);
        __syncthreads();
        const int kb = wave >> 1, vb0 = (wave & 1) * 2;
        f32x16 acc0 = {}, acc1 = {};
#pragma unroll
        for (int ks = 0; ks < 4; ++ks) {
            const bf16x8 af = *(const bf16x8*)(Kt + (32 * kb + r32) * 144 + ks * 32 + hi * 16);
            const bf16x8 b0 = *(const bf16x8*)(Vt + (32 * vb0 + r32) * 144 + ks * 32 + hi * 16);
            const bf16x8 b1 = *(const bf16x8*)(Vt + (32 * (vb0 + 1) + r32) * 144 + ks * 32 + hi * 16);
            acc0 = __builtin_amdgcn_mfma_f32_32x32x16_bf16(af, b0, acc0, 0, 0, 0);
            acc1 = __builtin_amdgcn_mfma_f32_32x32x16_bf16(af, b1, acc1, 0, 0, 0);
        }
        bf16_t* Lt = (bf16_t*)(a.ws + WS_A) + slot * 16384;
        char* Ls = lds + 40960;
#pragma unroll
        for (int rg = 0; rg < 4; ++rg) {
            const int k4 = 32 * kb + 8 * rg + 4 * hi;
            u32x2 w0, w1; w0.x = pk2(acc0[4 * rg], acc0[4 * rg + 1]); w0.y = pk2(acc0[4 * rg + 2], acc0[4 * rg + 3]);
            w1.x = pk2(acc1[4 * rg], acc1[4 * rg + 1]); w1.y = pk2(acc1[4 * rg + 2], acc1[4 * rg + 3]);
            *(u32x2*)(Ls + (32 * vb0 + r32) * 272 + k4 * 2) = w0;
            *(u32x2*)(Ls + (32 * (vb0 + 1) + r32) * 272 + k4 * 2) = w1;
        }
        __syncthreads();
#pragma unroll
        for (int i = 0; i < 4; ++i) { const int id = tid + 512 * i; *(u32x4*)(Lt + (size_t)(id >> 4) * 128 + (id & 15) * 8) = *(const u32x4*)(Ls + (id >> 4) * 272 + (id & 15) * 16); }
        __syncthreads();
    }
}
__device__ __forceinline__ void hgrn_passB(const Args& a, int G) {
    bf16_t* LS = (bf16_t*)(a.ws + WS_A); const float* DG = (const float*)(a.ws + WS_DG);
    for (int it = blockIdx.x * 512 + threadIdx.x; it < 64 * 2048; it += G * 512) {
        const int dbh = it >> 11, e8 = it & 2047, k0 = (e8 & 15) * 8;
        bf16_t* base = LS + (size_t)dbh * NCH * 16384 + e8 * 8; const float* dp = DG + (size_t)dbh * NCH * 128 + k0;
        float S[8];
#pragma unroll
        for (int e = 0; e < 8; ++e) S[e] = 0.f;
#pragma unroll 4
        for (int p = 0; p < NCH; ++p) {
            const u32x4 L = *(const u32x4*)(base + (size_t)p * 16384);
            const f32x4 d0 = *(const f32x4*)(dp + p * 128), d1 = *(const f32x4*)(dp + p * 128 + 4);
            if (p >= 4) { u32x4 w; w.x = pk2(S[0], S[1]); w.y = pk2(S[2], S[3]); w.z = pk2(S[4], S[5]); w.w = pk2(S[6], S[7]); *(u32x4*)(base + (size_t)p * 16384) = w; }
            S[0] = d0.x * S[0] + bf2f(L.x & 0xffffu); S[1] = d0.y * S[1] + bf2f(L.x >> 16);
            S[2] = d0.z * S[2] + bf2f(L.y & 0xffffu); S[3] = d0.w * S[3] + bf2f(L.y >> 16);
            S[4] = d1.x * S[4] + bf2f(L.z & 0xffffu); S[5] = d1.y * S[5] + bf2f(L.z >> 16);
            S[6] = d1.z * S[6] + bf2f(L.w & 0xffffu); S[7] = d1.w * S[7] + bf2f(L.w >> 16);
        }
    }
}
__device__ __forceinline__ float b16f(unsigned v) { return (float)v * (-1.f / 1024.f); }
__device__ __forceinline__ unsigned u16at(const u32x4 (&v)[2], int e) { const unsigned w = v[e >> 3][(e & 7) >> 1]; return (e & 1) ? (w >> 16) : (w & 0xffffu); }
struct PassCDir { u32x4 bt[2], bn[2], br[2], S[4]; };
__device__ __forceinline__ void passC_load_dir(const Args& a, int dir, int bh, int lc, int row0, int h, int tok, int ks, int tid, PassCDir& D) {
    const unsigned short* B = (const unsigned short*)(a.ws + (dir ? WS_GB : WS_GF)) + (size_t)row0 * 512 + h * 128 + ks;
    const int nb = dir ? (tok < 63 ? tok + 1 : 63) : (tok > 0 ? tok - 1 : 0), rf = dir ? 32 : 31;
    D.bt[0] = *(const u32x4*)(B + (size_t)tok * 512); D.bt[1] = *(const u32x4*)(B + (size_t)tok * 512 + 8);
    D.bn[0] = *(const u32x4*)(B + (size_t)nb * 512);  D.bn[1] = *(const u32x4*)(B + (size_t)nb * 512 + 8);
    D.br[0] = *(const u32x4*)(B + (size_t)rf * 512);  D.br[1] = *(const u32x4*)(B + (size_t)rf * 512 + 8);
    const int p = dir ? 4 + 63 - lc : 4 + lc;
    const u32x4* Sg = (const u32x4*)((const bf16_t*)(a.ws + WS_A) + ((size_t)(dir * 32 + bh) * NCH + p) * 16384);
#pragma unroll
    for (int i = 0; i < 4; ++i) D.S[i] = Sg[tid + 512 * i];
}
__device__ __forceinline__ void passC_ops(const PassCDir& D, bool has_nb, const u32x4 (&q)[2], char* St, char* Qd, char* Qd2, char* Kd2, int tok, int ks, int tid) {
    float qd_[16], qd2_[16], kd2_[16];
#pragma unroll
    for (int e = 0; e < 16; ++e) {
        const float b = b16f(u16at(D.bt, e)), nbv = has_nb ? b16f(u16at(D.bn, e)) : 0.f, bref = b16f(u16at(D.br, e));
        const float g = b - nbv, d = b - bref, qv = bf2f(u16at(q, e));
        qd_[e] = qv * __expf(b); qd2_[e] = qv * __expf(d); kd2_[e] = (1.f - __expf(g)) * __expf(-d);
    }
#pragma unroll
    for (int hlf = 0; hlf < 2; ++hlf) {
        u32x4 w;
        w.x = pk2(qd_[8 * hlf + 0], qd_[8 * hlf + 1]); w.y = pk2(qd_[8 * hlf + 2], qd_[8 * hlf + 3]); w.z = pk2(qd_[8 * hlf + 4], qd_[8 * hlf + 5]); w.w = pk2(qd_[8 * hlf + 6], qd_[8 * hlf + 7]);
        *(u32x4*)(Qd + tok * 272 + ks * 2 + hlf * 16) = w;
        w.x = pk2(qd2_[8 * hlf + 0], qd2_[8 * hlf + 1]); w.y = pk2(qd2_[8 * hlf + 2], qd2_[8 * hlf + 3]); w.z = pk2(qd2_[8 * hlf + 4], qd2_[8 * hlf + 5]); w.w = pk2(qd2_[8 * hlf + 6], qd2_[8 * hlf + 7]);
        *(u32x4*)(Qd2 + tok * 272 + ks * 2 + hlf * 16) = w;
        w.x = pk2(kd2_[8 * hlf + 0], kd2_[8 * hlf + 1]); w.y = pk2(kd2_[8 * hlf + 2], kd2_[8 * hlf + 3]); w.z = pk2(kd2_[8 * hlf + 4], kd2_[8 * hlf + 5]); w.w = pk2(kd2_[8 * hlf + 6], kd2_[8 * hlf + 7]);
        *(u32x4*)(Kd2 + tok * 272 + ks * 2 + hlf * 16) = w;
    }
#pragma unroll
    for (int i = 0; i < 4; ++i) { const int id = tid + 512 * i; *(u32x4*)(St + (id >> 4) * 272 + (id & 15) * 16) = D.S[i]; }
}
__device__ __forceinline__ void passC_mma1(f32x16& o, int dir, const char* St, const char* Qd, const char* Qd2, const char* Kd2, char* Pb, int wave, int r32, int hi) {
    const int rb = wave >> 2, cb = wave & 3, tr = (wave & 3) >> 1, tc = wave & 1;
    f32x16 pacc = {};
#pragma unroll
    for (int kk = 0; kk < 8; ++kk) {
        const bf16x8 af = *(const bf16x8*)(Qd + (32 * rb + r32) * 272 + kk * 32 + hi * 16);
        const bf16x8 bf = *(const bf16x8*)(St + (32 * cb + r32) * 272 + kk * 32 + hi * 16);
        o = __builtin_amdgcn_mfma_f32_32x32x16_bf16(af, bf, o, 0, 0, 0);
        const bf16x8 a2 = *(const bf16x8*)(Qd2 + (32 * tr + r32) * 272 + kk * 32 + hi * 16);
        const bf16x8 b2 = *(const bf16x8*)(Kd2 + (32 * tc + r32) * 272 + kk * 32 + hi * 16);
        pacc = __builtin_amdgcn_mfma_f32_32x32x16_bf16(a2, b2, pacc, 0, 0, 0);
    }
    if (wave < 4) {
#pragma unroll
        for (int r = 0; r < 16; ++r) {
            const int t = 32 * tr + att::crow(r, hi), s_ = 32 * tc + r32;
            const bool keep = dir ? (s_ >= t) : (s_ <= t);
            *(bf16_t*)(Pb + t * 144 + s_ * 2) = (bf16_t)f2bf(keep ? pacc[r] : 0.f);
        }
    }
}
__device__ __forceinline__ void passC_mma2(f32x16& o, const char* Pb, const char* Vt, int wave, int r32, int hi) {
    const int rb = wave >> 2, cb = wave & 3;
#pragma unroll
    for (int ks = 0; ks < 4; ++ks) {
        const bf16x8 af = *(const bf16x8*)(Pb + (32 * rb + r32) * 144 + ks * 32 + hi * 16);
        const bf16x8 bf = *(const bf16x8*)(Vt + (32 * cb + r32) * 144 + ks * 32 + hi * 16);
        o = __builtin_amdgcn_mfma_f32_32x32x16_bf16(af, bf, o, 0, 0, 0);
    }
}
__device__ __forceinline__ void hgrn_passC(const Args& a, char* lds, int item) {
    const int tid = threadIdx.x, wave = tid >> 6, lane = tid & 63, r32 = lane & 31, hi = lane >> 5;
    const int bh = item >> 6, lc = item & 63, b = bh >> 2, h = bh & 3;
    const int row0 = b * SEQ + 64 * lc;
    char* St = lds; char* Qd = lds + 34816; char* Qd2 = lds + 52224; char* Kd2 = lds + 69632; char* Vt = lds + 87040; char* Pb = lds + 105472; float* Os = (float*)(lds + 34816);
    const int tok = tid >> 3, ks = (tid & 7) * 16;
    const size_t roff = (size_t)(row0 + tok) * 512 + h * 128 + ks;
    u32x4 q[2], vv[2], hg[2];
    { const bf16_t* Qp = (const bf16_t*)(a.ws + WS_HQ) + roff; q[0] = *(const u32x4*)Qp; q[1] = *(const u32x4*)(Qp + 8);
      const bf16_t* Vp = (const bf16_t*)(a.ws + WS_HI) + roff; vv[0] = *(const u32x4*)Vp; vv[1] = *(const u32x4*)(Vp + 8);
      const bf16_t* Hp = (const bf16_t*)(a.ws + WS_HG) + roff; hg[0] = *(const u32x4*)Hp; hg[1] = *(const u32x4*)(Hp + 8); }
    PassCDir D0, D1;
    passC_load_dir(a, 0, bh, lc, row0, h, tok, ks, tid, D0);
    passC_load_dir(a, 1, bh, lc, row0, h, tok, ks, tid, D1);
#pragma unroll
    for (int e = 0; e < 16; ++e) *(bf16_t*)(Vt + (ks + e) * 144 + tok * 2) = (bf16_t)u16at(vv, e);
    passC_ops(D0, tok > 0, q, St, Qd, Qd2, Kd2, tok, ks, tid);
    __syncthreads();
    f32x16 o = {};
    passC_mma1(o, 0, St, Qd, Qd2, Kd2, Pb, wave, r32, hi);
    __syncthreads();
    passC_mma2(o, Pb, Vt, wave, r32, hi);
    passC_ops(D1, tok < 63, q, St, Qd, Qd2, Kd2, tok, ks, tid);
    __syncthreads();
    passC_mma1(o, 1, St, Qd, Qd2, Kd2, Pb, wave, r32, hi);
    __syncthreads();
    passC_mma2(o, Pb, Vt, wave, r32, hi);
    {
        const int rb = wave >> 2, cb = wave & 3;
#pragma unroll
        for (int r = 0; r < 16; ++r) Os[(32 * rb + att::crow(r, hi)) * 128 + 32 * cb + r32] = o[r];
    }
    __syncthreads();
    {
        float ov[16]; float ss = 0.f;
#pragma unroll
        for (int e = 0; e < 16; ++e) { ov[e] = Os[tok * 128 + ks + e]; ss += ov[e] * ov[e]; }
        ss += __shfl_xor(ss, 1); ss += __shfl_xor(ss, 2); ss += __shfl_xor(ss, 4);
        const float rstd = rsqrtf(ss * (1.f / 128.f) + EPS);
        float res[16];
#pragma unroll
        for (int e = 0; e < 16; ++e) { const float hv = bf2f(u16at(hg, e)); res[e] = ov[e] * rstd * a.g_on[ks + e] * (hv * sigmoidf_(hv)); }
        bf16_t* Mx = (bf16_t*)(a.ws + WS_MIX) + (size_t)(row0 + tok) * 1024 + 512 + h * 128 + ks;
        u32x4 w;
        w.x = pk2(res[0], res[1]); w.y = pk2(res[2], res[3]); w.z = pk2(res[4], res[5]); w.w = pk2(res[6], res[7]); *(u32x4*)Mx = w;
        w.x = pk2(res[8], res[9]); w.y = pk2(res[10], res[11]); w.z = pk2(res[12], res[13]); w.w = pk2(res[14], res[15]); *(u32x4*)(Mx + 8) = w;
    }
    __syncthreads();
}

#define XB_TMO      128
#define XB_XCNT(j)  (256  + 64 * (j))
#define XB_XSUB(j)  (1280 + 64 * (j))
#define XB_XGEN(j)  (2304 + 64 * (j))
#define XB_TOP      3328
#define XB_TOPGEN   3392
#define XCD_BAR_WORDS 3456
#define XB_SPIN_CAP (1u << 18)

__device__ __forceinline__ unsigned xb_ld(unsigned* p)              { return __hip_atomic_load(p, __ATOMIC_RELAXED, __HIP_MEMORY_SCOPE_AGENT); }
__device__ __forceinline__ unsigned xb_add(unsigned* p, unsigned v) { return __hip_atomic_fetch_add(p, v, __ATOMIC_RELAXED, __HIP_MEMORY_SCOPE_AGENT); }
__device__ __forceinline__ unsigned xb_xcc_id() { return (unsigned)__builtin_amdgcn_s_getreg((3 << 11) | 20) & 0xFu; }
#define XB_SPIN(cond, bar) do { unsigned _sp = 0; while (cond) { __builtin_amdgcn_s_sleep(1); \
    if ((++_sp & 255u) == 0u) { if (xb_ld(&(bar)[XB_TMO])) break; if (_sp > XB_SPIN_CAP) { atomicAdd(&(bar)[XB_TMO], 1u); break; } } } } while (0)

struct XcdBarrier {
    unsigned* bar; unsigned x;
    volatile LAS unsigned* st;
};

__device__ __forceinline__ XcdBarrier xcd_barrier_post(unsigned* bar, volatile LAS unsigned* st) {
    XcdBarrier b; b.bar = bar; b.x = xb_xcc_id(); b.st = st;
    if (threadIdx.x == 0) (void)xb_add(&bar[XB_XCNT(b.x)], 1u);
    return b;
}
__device__ __forceinline__ void xcd_barrier_complete(unsigned* bar, unsigned x, unsigned& nloc, unsigned& nx) {
    const unsigned G = gridDim.x * gridDim.y * gridDim.z;
    unsigned sum, cnt, mine, sp = 0u;
    for (;;) {
        sum = 0u; cnt = 0u; mine = 0u;
#pragma unroll
        for (unsigned j = 0; j < 16; ++j) { const unsigned c = xb_ld(&bar[XB_XCNT(j)]); sum += c; cnt += (c > 0u) ? 1u : 0u; mine = (j == x) ? c : mine; }
        if (sum == G) break;
        __builtin_amdgcn_s_sleep(1);
        if ((++sp & 255u) == 0u) { if (xb_ld(&bar[XB_TMO])) break; if (sp > XB_SPIN_CAP) { atomicAdd(&bar[XB_TMO], 1u); break; } }
    }
    nloc = mine > 0u ? mine : 1u; nx = cnt > 0u ? cnt : 1u;
}

__device__ __forceinline__ void xcd_barrier(const XcdBarrier& b) {
    asm volatile("s_waitcnt vmcnt(0)" ::: "memory");
    __syncthreads();
    if (threadIdx.x == 0) {
        unsigned* bar = b.bar;
        __builtin_amdgcn_s_waitcnt(0);
        unsigned nloc = b.st[0], nx = b.st[1];
        if (nloc == 0u) { xcd_barrier_complete(bar, b.x, nloc, nx); b.st[0] = nloc; b.st[1] = nx; }
        const unsigned old = xb_add(&bar[XB_XSUB(b.x)], 1u);
        const unsigned gen = old / nloc;
        if (old + 1u == (gen + 1u) * nloc) {
            __builtin_amdgcn_fence(__ATOMIC_RELEASE, "agent");
            asm volatile("s_waitcnt vmcnt(0)" ::: "memory");
            const unsigned og = xb_add(&bar[XB_TOP], 1u);
            const unsigned tg = og / nx;
            if (og + 1u == (tg + 1u) * nx) xb_add(&bar[XB_TOPGEN], 1u);
            else XB_SPIN(xb_ld(&bar[XB_TOPGEN]) == tg, bar);
            __builtin_amdgcn_fence(__ATOMIC_ACQUIRE, "agent");
            xb_add(&bar[XB_XGEN(b.x)], 1u);
            asm volatile("s_waitcnt vmcnt(0)" ::: "memory");
        } else {
            XB_SPIN(xb_ld(&bar[XB_XGEN(b.x)]) == gen, bar);
            __builtin_amdgcn_fence(__ATOMIC_ACQUIRE, "agent");
            asm volatile("s_waitcnt vmcnt(0)" ::: "memory");
        }
    }
    __syncthreads();
}

__global__ void __launch_bounds__(512, 2) fwd_megakernel(Args a) {
    extern __shared__ __attribute__((aligned(16))) unsigned char lds[];
    cg::grid_group grid = cg::this_grid();
    const int tid = threadIdx.x, wave = __builtin_amdgcn_readfirstlane(tid >> 6), lane = tid & 63;
    const int G = gridDim.x;
    unsigned char* ws = a.ws;
    LAS unsigned char* ldsl = (LAS unsigned char*)lds;
    char* ldsc = (char*)lds;
    const int lo = a.ph_lo, hi = a.ph_hi;
#ifndef SKIPMASK
#define SKIPMASK 0
#endif
#ifndef REPMASK
#define REPMASK 0
#endif
#define REPN(k) (((REPMASK >> (k)) & 1) ? 2 : 1)
#define IN(k) (!((SKIPMASK >> (k)) & 1) && lo <= (k) && (k) < hi)
#define SEAM(k) do { if (lo <= (k) && (k) + 1 < hi) { xcd_barrier(xbar); } } while (0)
    volatile LAS unsigned* xst = (volatile LAS unsigned*)(ldsl + LDS_BYTES - 16);
    if (tid < 4) xst[tid] = 0u;
    __syncthreads();
    XcdBarrier xbar; xbar.bar = (unsigned*)(ws + WS_BAR); xbar.x = 0; xbar.st = xst;
    if (hi - lo > 1) xbar = xcd_barrier_post((unsigned*)(ws + WS_BAR), xst);
    if (lo < 0) grid.sync();
    float* MOD = (float*)(ws + WS_MOD);
    float* RSS = (float*)(ws + WS_RSSP);
    const float* RC = (const float*)(ws + WS_RCOS); const float* RS = (const float*)(ws + WS_RSIN);
    bf16_t* Hb = (bf16_t*)(ws + WS_A);
    bf16_t* Qb = (bf16_t*)a.out;
    bf16_t* Kb = (bf16_t*)((char*)a.out + 48 * MiB);
    bf16_t* Vb = (bf16_t*)(ws + WS_V);
    bf16_t* MIX = (bf16_t*)(ws + WS_MIX);
    const int gw = blockIdx.x * 8 + wave, NGW = G * 8;

    if (IN(0)) { p0_prologue(a, ldsc, G); }
    SEAM(0);
    if (IN(1)) {
        if (G == 256) {
            f32x4 A[4], B[4]; const int bb = gw >> 8, rw = gw & 255;
            load_mod_params(a.g_mix, MOD + (size_t)bb * 6144, 0, A, B, lane);
#pragma unroll 1
            for (int it = 0; it < 4; ++it) { const float* src[4]; bf16_t* dst[4];
#pragma unroll
                for (int i = 0; i < 4; ++i) { const int r = bb * 4096 + rw + 256 * (4 * it + i); src[i] = a.x + (size_t)r * 1024; dst[i] = Hb + (size_t)r * 1024; }
                rows_norm_mod_pre<4>(src, A, B, dst, lane); }
            load_mod_params(a.g_mix, MOD + (size_t)8 * 6144, 0, A, B, lane);
            { const float* src[1] = {a.ctx + (size_t)gw * 1024}; bf16_t* dst[1] = {Hb + (size_t)(ML + gw) * 1024}; rows_norm_mod_pre<1>(src, A, B, dst, lane); }
        } else
        for (int r0 = gw; r0 < MT; r0 += 4 * NGW) {
            const float* src[4]; const float* md[4]; bf16_t* dst[4]; bool ok[4];
#pragma unroll
            for (int i = 0; i < 4; ++i) { const int r = r0 + i * NGW; ok[i] = r < MT; const int rr = ok[i] ? r : r0; const bool lat = rr < ML;
                src[i] = lat ? a.x + (size_t)rr * 1024 : a.ctx + (size_t)(rr - ML) * 1024; md[i] = MOD + (size_t)(lat ? (rr >> 12) : 8) * 6144; dst[i] = Hb + (size_t)rr * 1024; }
            rows_norm_mod_bf16<4>(src, a.g_mix, md, 0, dst, ok, lane);
        }
    }
#ifdef ZERO_MIX
    if (IN(1)) { u32x4* mz = (u32x4*)(ws + WS_MIX); const u32x4 z = {0u, 0u, 0u, 0u}; for (size_t i = (size_t)blockIdx.x * 512 + tid; i < (size_t)ML * 1024 * 2 / 16; i += (size_t)G * 512) mz[i] = z; }
#endif
    SEAM(1);
    if (IN(2)) {
        pg8::Gemm g{Hb, (const bf16_t*)(ws + WS_WIN), MT, NINP, 1024}; pg8::StaticOrder S; S.init(MT, NINP, G, (int)blockIdx.x);
        EpiInProj E{ws, Kb};
        pg8::gemm_phase<EpiInProj, pg8::StaticOrder, true, true>(ldsl, g, S, E);
    }
    SEAM(2);
    if (IN(3)) {
#ifndef SKIP3A
        { pg8::Gemm g{(const bf16_t*)(ws + WS_CQ), (const bf16_t*)(ws + WS_WUQ), 2 * MT, 768 + 1024, 256}; QKVOrder S{G, (int)blockIdx.x};
          EpiQKV E{EpiQ{Qb, RSS, RC, RS}, EpiKV{Kb, Vb, RSS}};
          pg8::gemm_phase<EpiQKV, QKVOrder, true, true>(ldsl, g, S, E); }
#endif
#ifndef SKIP3C
        hgrn_passA_loop(a, ldsc, G);
#endif
    }
#ifdef EXPJ
    if (IN(3)) {
        const u32x4* srcA = (const u32x4*)(ws + EXPJ_A); const u32x4* srcB = (const u32x4*)(ws + EXPJ_B); u32x4* dst = (u32x4*)MIX;
        for (size_t i = (size_t)blockIdx.x * 512 + tid; i < (size_t)ML * 64; i += (size_t)G * 512) { const size_t r = i >> 6, c = i & 63; dst[r * 128 + c] = srcA[r * 64 + c]; dst[r * 128 + 64 + c] = srcB[r * 64 + c]; }
    }
#endif
    SEAM(3);
    if (IN(4)) { hgrn_passB(a, G); }
    SEAM(4);
    if (IN(5)) {
#ifndef SKIP5A
        for (int u = blockIdx.x; u < 512; u += G) {
            int bh, qb;
            if (G == 256) { const int xcd = blockIdx.x & 7, cu = blockIdx.x >> 3, i = u >> 8; bh = xcd * 4 + i * 2 + (cu >> 4); qb = cu & 15; }
            else { bh = u >> 4; qb = u & 15; }
            const int b = bh >> 2, h = bh & 3;
            att::attn_body(Qb + ((size_t)bh * SEQ + qb * 256) * 192, Kb + (size_t)bh * KVL * 192, Vb + (size_t)bh * KVL * 128,
                           MIX + ((size_t)b * SEQ + qb * 256) * 1024 + h * 128, KVL, ldsc);
        }
#endif
#ifndef SKIP5B
        for (int it = blockIdx.x; it < 2048; it += G) hgrn_passC(a, ldsc, it);
#endif
    }
#ifdef EXPM
    if (IN(5)) { const u32x4* src = (const u32x4*)(ws + WS_A); u32x4* dst = (u32x4*)MIX;
        for (size_t i = (size_t)blockIdx.x * 512 + tid; i < (size_t)ML * 128; i += (size_t)G * 512) dst[i] = src[i]; }
#endif
    SEAM(5);
    if (IN(6)) {
        pg8::Gemm g{MIX, (const bf16_t*)(ws + WS_WOUT), ML, 1024, 1024}; pg8::StaticOrder S; S.init(ML, 1024, G, (int)blockIdx.x);
        EpiRes E{a.x, a.out, MOD + 2048};
        pg8::gemm_phase<EpiRes, pg8::StaticOrder, true, true>(ldsl, g, S, E);
    }
    SEAM(6);
    if (IN(7)) {
        if (G == 256) {
            f32x4 A[4], B[4]; const int bb = gw >> 8, rw = gw & 255;
            load_mod_params(a.g_ffn, MOD + (size_t)bb * 6144, 3072, A, B, lane);
#pragma unroll 1
            for (int it = 0; it < 4; ++it) { const float* src[4]; bf16_t* dst[4];
#pragma unroll
                for (int i = 0; i < 4; ++i) { const int r = bb * 4096 + rw + 256 * (4 * it + i); src[i] = a.out + (size_t)r * 1024; dst[i] = Hb + (size_t)r * 1024; }
                rows_norm_mod_pre<4>(src, A, B, dst, lane); }
        } else
        for (int r0 = gw; r0 < ML; r0 += 4 * NGW) {
            const float* src[4]; const float* md[4]; bf16_t* dst[4]; bool ok[4];
#pragma unroll
            for (int i = 0; i < 4; ++i) { const int r = r0 + i * NGW; ok[i] = r < ML; const int rr = ok[i] ? r : r0;
                src[i] = a.out + (size_t)rr * 1024; md[i] = MOD + (size_t)(rr >> 12) * 6144; dst[i] = Hb + (size_t)rr * 1024; }
            rows_norm_mod_bf16<4>(src, a.g_ffn, md, 3072, dst, ok, lane);
        }
    }
    SEAM(7);
    if (IN(8)) {
        pg8::Gemm g{Hb, (const bf16_t*)(ws + WS_WGU), ML, 2 * DFF, 1024}; pg8::StaticOrder S; S.init(ML, 2 * DFF, G, (int)blockIdx.x);
        EpiSwiglu E{(bf16_t*)(ws + WS_ACT)};
        pg8::gemm_phase<EpiSwiglu, pg8::StaticOrder, true, true>(ldsl, g, S, E);
    }
    SEAM(8);
    if (IN(9)) {
        pg8::Gemm g{(const bf16_t*)(ws + WS_ACT), (const bf16_t*)(ws + WS_WDN), ML, 1024, DFF}; pg8::StaticOrder S; S.init(ML, 1024, G, (int)blockIdx.x);
        EpiRes E{a.out, a.out, MOD + 5120};
        pg8::gemm_phase<EpiRes, pg8::StaticOrder, true, true>(ldsl, g, S, E);
    }
    SEAM(9);
    if (IN(10)) {
        if (ML % (4 * NGW) == 0) { for (int r0 = gw; r0 < ML; r0 += 4 * NGW) { float* rows[4];
#pragma unroll
            for (int i = 0; i < 4; ++i) rows[i] = a.out + (size_t)(r0 + i * NGW) * 1024;
            rows_norm_f32<4>(rows, a.g_final, lane); } }
        else { for (int r = gw; r < ML; r += NGW) { float* rows[1] = {a.out + (size_t)r * 1024}; rows_norm_f32<1>(rows, a.g_final, lane); } }
    }
#ifdef EXTRA_SYNCS
    if (hi - lo > 5) { for (int i_ = 0; i_ < EXTRA_SYNCS; ++i_) grid.sync(); }
#endif
#ifdef PROBE_PHASE
    if (a.ph_lo == 11) {
        for (int u = blockIdx.x; u < 512; u += G) {
            int bh, qb;
            if (G == 256) { const int xcd = blockIdx.x & 7, cu = blockIdx.x >> 3, i = u >> 8; bh = xcd * 4 + i * 2 + (cu >> 4); qb = cu & 15; }
            else { bh = u >> 4; qb = u & 15; }
            const int b = bh >> 2, h = bh & 3;
            att::attn_body(Qb + ((size_t)bh * SEQ + qb * 256) * 192, Kb + (size_t)bh * KVL * 192, Vb + (size_t)bh * KVL * 128,
                           MIX + ((size_t)b * SEQ + qb * 256) * 1024 + h * 128, KVL, ldsc);
        }
    }
    if (a.ph_lo == 12) { for (int it = blockIdx.x; it < 2048; it += G) hgrn_passC(a, ldsc, it); }
    if (a.ph_lo == 13) { hgrn_passA_loop(a, ldsc, G); }
#endif
#undef IN
#undef SEAM
}

#ifndef PROBE_REPS
#define PROBE_REPS 1
#endif
#ifndef MK_PER_PHASE
#define MK_PER_PHASE 0
#endif
extern "C" void kernel_launch(void* const* d_in, const int* in_sizes, int n_in, void* d_out, int out_size, void* d_ws, size_t ws_size, hipStream_t stream) {
    static int grid = 0;
    if (grid == 0) {
        if (n_in != 21 || out_size != ML * DM || ws_size < WS_END) { fprintf(stderr, "kernel_launch: unexpected shapes (n_in %d out %d ws %zu)\n", n_in, out_size, ws_size); grid = -1; return; }
        int dev = 0, cus = 0, per_cu = 0;
        hipGetDevice(&dev); hipDeviceGetAttribute(&cus, hipDeviceAttributeMultiprocessorCount, dev);
        if (hipFuncSetAttribute((const void*)fwd_megakernel, hipFuncAttributeMaxDynamicSharedMemorySize, LDS_BYTES) != hipSuccess) { fprintf(stderr, "kernel_launch: hipFuncSetAttribute failed\n"); grid = -1; return; }
        if (hipOccupancyMaxActiveBlocksPerMultiprocessor(&per_cu, (const void*)fwd_megakernel, 512, LDS_BYTES) != hipSuccess || per_cu < 1) { fprintf(stderr, "kernel_launch: occupancy query says %d\n", per_cu); per_cu = 1; }
        (void)hipGetLastError();
        grid = cus * 1;
        fprintf(stderr, "kernel_launch: grid %d (per_cu %d)\n", grid, per_cu);
    }
    if (grid < 0) return;
    (void)hipMemsetAsync((char*)d_ws + WS_BAR, 0, 16384, stream);
    Args a{};
    const float** ap = (const float**)&a;
    for (int i = 0; i < 21; ++i) ap[i] = (const float*)d_in[i];
    a.out = (float*)d_out; a.ws = (unsigned char*)d_ws;
#if MK_PER_PHASE
    for (int ph = 0; ph < 11; ++ph) {
        a.ph_lo = ph; a.ph_hi = ph + 1;
        hipLaunchKernelGGL(fwd_megakernel, dim3(grid), dim3(512), LDS_BYTES, stream, a);
    }
#else
#ifdef PROBE_PHASE
    for (int pr_ = 0; pr_ < PROBE_REPS; ++pr_) { a.ph_lo = PROBE_PHASE; a.ph_hi = PROBE_PHASE + 1; hipLaunchKernelGGL(fwd_megakernel, dim3(grid), dim3(512), LDS_BYTES, stream, a); }
#endif
    a.ph_lo = 0; a.ph_hi = 11;
    void* args[] = {&a};
    hipError_t e = hipLaunchCooperativeKernel((const void*)fwd_megakernel, dim3(grid), dim3(512), args, LDS_BYTES, stream);
    if (e != hipSuccess) fprintf(stderr, "cooperative launch failed: %s (grid %d)\n", hipGetErrorString(e), grid);
#endif
}
```
